# Optimizing an MI355X kernel written in HIP

```python
import math
import jax, jax.numpy as jnp
from jax import lax
import numpy as np

D_MODEL = 1024
BATCH = 32
SEQ = 256
DEPTH = 2
DEC_BATCH = 8
DEC_SEQ = 4096
PAST_LEN = 512

GRID_W = 64
N_BRANCH = 4
BRANCH_W = 256
CONV_W = 3
GQA_HEADS = 4
GQA_KV_HEADS = 2
GQA_GROUP = GQA_HEADS // GQA_KV_HEADS
GQA_HEAD_DIM = 64
RET_HEADS = 4
RET_KEY_DIM = 64
RET_VAL_DIM = 64
RET_CHUNK = 128
DIFF_HEADS = 4
DIFF_HEAD_DIM = 32
Q_BLOCK = 128
ROPE_THETA = 10000.0
EPS = 1e-6
GQA_Q_W = GQA_HEADS * GQA_HEAD_DIM
GQA_KV_W = GQA_KV_HEADS * GQA_HEAD_DIM
RET_QK_W = RET_HEADS * RET_KEY_DIM
RET_V_W = RET_HEADS * RET_VAL_DIM
DIFF_QK_W = DIFF_HEADS * 2 * DIFF_HEAD_DIM
DIFF_V_W = DIFF_HEADS * 2 * DIFF_HEAD_DIM
IN_WIDTHS = (
    BRANCH_W, BRANCH_W, BRANCH_W, BRANCH_W,
    GQA_Q_W, GQA_KV_W, GQA_KV_W, BRANCH_W,
    RET_QK_W, RET_QK_W, RET_V_W, BRANCH_W,
    DIFF_QK_W, DIFF_QK_W, DIFF_V_W, BRANCH_W,
)
IN_W = sum(IN_WIDTHS)

kernel_name = "hybrid_prefix_diffusion_step"


def split_points():
    return [int(s) for s in np.cumsum(IN_WIDTHS)[:-1]]


def rms_norm(x, gain=None):
    xf = x.astype(jnp.float32)
    y = xf * lax.rsqrt(jnp.mean(xf * xf, axis=-1, keepdims=True) + EPS)
    if gain is not None:
        y = y * gain.astype(jnp.float32)
    return y.astype(x.dtype)


def axial_rope_tables(n_tokens, head_dim):
    rows = n_tokens // GRID_W
    row = jnp.repeat(jnp.arange(rows, dtype=jnp.float32), GRID_W)
    col = jnp.tile(jnp.arange(GRID_W, dtype=jnp.float32), rows)
    n_axis = head_dim // 4
    inv_freq = ROPE_THETA ** (-jnp.arange(n_axis, dtype=jnp.float32) / n_axis)
    ang = jnp.concatenate([row[:, None] * inv_freq, col[:, None] * inv_freq], axis=-1)
    return jnp.cos(ang), jnp.sin(ang)


def apply_rope(x, cos, sin):
    half = x.shape[-1] // 2
    shape = (1, x.shape[1]) + (1,) * (x.ndim - 3) + (half,)
    cos = cos.reshape(shape).astype(x.dtype)
    sin = sin.reshape(shape).astype(x.dtype)
    x1, x2 = x[..., :half], x[..., half:]
    return jnp.concatenate([x1 * cos - x2 * sin, x1 * sin + x2 * cos], axis=-1)


def map_query_blocks(fn, q):
    B, T = q.shape[:2]
    nb = T // Q_BLOCK
    qb = jnp.moveaxis(q.reshape((B, nb, Q_BLOCK) + q.shape[2:]), 1, 0)
    out = lax.map(fn, qb)
    return jnp.moveaxis(out, 0, 1).reshape((B, T) + out.shape[3:])


def gqa_attention(q, k, v):
    scale = GQA_HEAD_DIM ** -0.5

    def block(qb):
        s = jnp.einsum("bqhgd,bshd->bhgqs", qb, k).astype(jnp.float32) * scale
        p = jax.nn.softmax(s, axis=-1).astype(v.dtype)
        return jnp.einsum("bhgqs,bshd->bqhgd", p, v)

    return map_query_blocks(block, q)


def diff_attention(q, k, v, lam):
    scale = DIFF_HEAD_DIM ** -0.5

    def block(qb):
        s = jnp.einsum("bqhcd,bshcd->bhcqs", qb, k).astype(jnp.float32) * scale
        p = jax.nn.softmax(s, axis=-1)
        a = (p[:, :, 0] - lam * p[:, :, 1]).astype(v.dtype)
        return jnp.einsum("bhqs,bshe->bqhe", a, v)

    return map_query_blocks(block, q)


def short_conv_mixer(b_gate, c_gate, u, conv_w):
    g = c_gate * u
    gp = jnp.pad(g, ((0, 0), (1, 1), (0, 0)))
    y = gp[:, :-2] * conv_w[0] + gp[:, 1:-1] * conv_w[1] + gp[:, 2:] * conv_w[2]
    return b_gate * y


def retention_chunkwise(q, k, v, log_gamma, s0):
    B, T, H, _ = q.shape
    dv = v.shape[-1]
    n_chunks = T // RET_CHUNK
    pos = jnp.arange(RET_CHUNK, dtype=jnp.float32)
    lg = log_gamma.astype(jnp.float32)
    rel = pos[:, None] - pos[None, :]
    decay_mask = jnp.where(rel >= 0, jnp.exp(lg[:, None, None] * jnp.maximum(rel, 0.0)), 0.0)
    q_decay = jnp.exp(lg[None, :] * (pos[:, None] + 1.0))
    k_decay = jnp.exp(lg[None, :] * (RET_CHUNK - 1.0 - pos[:, None]))
    chunk_decay = jnp.exp(lg * RET_CHUNK)

    def to_chunks(a):
        a = a.astype(jnp.float32)
        return jnp.moveaxis(a.reshape(B, n_chunks, RET_CHUNK, H, a.shape[-1]), 1, 0)

    def step(S, blk):
        qc, kc, vc = blk
        scores = jnp.einsum("bihd,bjhd->bhij", qc, kc) * decay_mask
        o = jnp.einsum("bhij,bjhe->bihe", scores, vc)
        o = o + jnp.einsum("bihd,bhde->bihe", qc, S) * q_decay[None, :, :, None]
        S = S * chunk_decay[None, :, None, None] + jnp.einsum(
            "bjhd,bjhe->bhde", kc * k_decay[None, :, :, None], vc)
        return S, o

    s_final, o = lax.scan(step, s0.astype(jnp.float32), (to_chunks(q), to_chunks(k), to_chunks(v)))
    o = jnp.moveaxis(o, 0, 1).reshape(B, T, H, dv)
    return o, s_final


def mixer_sublayer(h, p, lambda_init, rope_gqa, rope_diff, cached):
    latent = cached is not None
    B, T, _ = h.shape
    z = h @ p["w_in"]
    (a_bg, a_cg, a_in, a_gate, g_q, g_k, g_v, g_gate,
     r_q, r_k, r_v, r_gate, d_q, d_k, d_v, d_gate) = jnp.split(z, split_points(), axis=-1)

    y_a = short_conv_mixer(a_bg, a_cg, a_in, p["conv_w"])

    gq = rms_norm(g_q.reshape(B, T, GQA_KV_HEADS, GQA_GROUP, GQA_HEAD_DIM), p["gqa_q_gain"])
    gk = rms_norm(g_k.reshape(B, T, GQA_KV_HEADS, GQA_HEAD_DIM), p["gqa_k_gain"])
    gv = g_v.reshape(B, T, GQA_KV_HEADS, GQA_HEAD_DIM)
    if latent:
        gq = apply_rope(gq, *rope_gqa)
        gk_all = jnp.concatenate([cached[0].astype(gk.dtype), apply_rope(gk, *rope_gqa)], axis=1)
        gv_all = jnp.concatenate([cached[1].astype(gv.dtype), gv], axis=1)
    else:
        gk_all, gv_all = gk, gv
    y_b = gqa_attention(gq, gk_all, gv_all).reshape(B, T, GQA_Q_W)

    rq = r_q.reshape(B, T, RET_HEADS, RET_KEY_DIM)
    rk = r_k.reshape(B, T, RET_HEADS, RET_KEY_DIM) * (RET_KEY_DIM ** -0.5)
    rv = r_v.reshape(B, T, RET_HEADS, RET_VAL_DIM)
    log_g = jax.nn.log_sigmoid(p["ret_decay"].astype(jnp.float32))
    if latent:
        s_fwd, s_bwd = cached[4][:, 0], cached[4][:, 1]
    else:
        s_fwd = s_bwd = jnp.zeros((B, RET_HEADS, RET_KEY_DIM, RET_VAL_DIM), jnp.float32)
    o_f, sf_new = retention_chunkwise(rq, rk, rv, log_g[0], s_fwd)
    o_b, sb_new = retention_chunkwise(jnp.flip(rq, 1), jnp.flip(rk, 1), jnp.flip(rv, 1), log_g[1], s_bwd)
    o_r = (o_f + jnp.flip(o_b, 1)).astype(h.dtype)
    y_c = rms_norm(o_r).reshape(B, T, RET_V_W)

    dq = d_q.reshape(B, T, DIFF_HEADS, 2, DIFF_HEAD_DIM)
    dk = d_k.reshape(B, T, DIFF_HEADS, 2, DIFF_HEAD_DIM)
    dv = d_v.reshape(B, T, DIFF_HEADS, 2 * DIFF_HEAD_DIM)
    lam_p = p["diff_lambda"].astype(jnp.float32)
    lam = jnp.exp(jnp.sum(lam_p[0] * lam_p[1])) - jnp.exp(jnp.sum(lam_p[2] * lam_p[3])) + lambda_init
    if latent:
        dq = apply_rope(dq, *rope_diff)
        dk_all = jnp.concatenate([cached[2].astype(dk.dtype), apply_rope(dk, *rope_diff)], axis=1)
        dv_all = jnp.concatenate([cached[3].astype(dv.dtype), dv], axis=1)
    else:
        dk_all, dv_all = dk, dv
    o_d = diff_attention(dq, dk_all, dv_all, lam)
    y_d = (rms_norm(o_d, p["diff_norm_gain"]) * (1.0 - lambda_init)).reshape(B, T, DIFF_V_W)

    branches = (y_a * jax.nn.silu(a_gate), y_b * jax.nn.silu(g_gate),
                y_c * jax.nn.silu(r_gate), y_d * jax.nn.silu(d_gate))
    gates = jax.nn.sigmoid(h @ p["w_mgate"])
    merged = None
    for i, y in enumerate(branches):
        term = gates[..., i * D_MODEL:(i + 1) * D_MODEL] * (y @ p["w_branch"][i])
        merged = term if merged is None else merged + term
    out = merged @ p["w_out"]
    if latent:
        return out, None
    ret_state = jnp.stack([sf_new, sb_new], axis=1).astype(h.dtype)
    return out, (gk, gv, dk, dv, ret_state)


def adaln_params(cond, w_ada_l, b_ada_l):
    mod = jax.nn.silu(cond) @ w_ada_l + b_ada_l
    return jnp.split(mod, 3, axis=-1)


def setup_inputs(seed: int = 0) -> dict:
    key = jax.random.key(seed)
    ks = jax.random.split(key, 24)
    f32 = jnp.float32

    def nrm(k, shape, s):
        return s * jax.random.normal(k, shape, f32)

    ret_logit = jnp.log(2.0 ** (5.0 + jnp.arange(RET_HEADS, dtype=f32)) - 1.0)
    return {
        "x_prompt": nrm(ks[0], (BATCH, SEQ, D_MODEL), 1.0),
        "x_sample": nrm(ks[1], (DEC_BATCH, DEC_SEQ, D_MODEL), 1.0),
        "cache_gqa_k": nrm(ks[2], (DEC_BATCH, DEPTH, PAST_LEN, GQA_KV_HEADS, GQA_HEAD_DIM), 1.0),
        "cache_gqa_v": nrm(ks[3], (DEC_BATCH, DEPTH, PAST_LEN, GQA_KV_HEADS, GQA_HEAD_DIM), 1.0),
        "cache_diff_k": nrm(ks[4], (DEC_BATCH, DEPTH, PAST_LEN, DIFF_HEADS, 2, DIFF_HEAD_DIM), 1.0),
        "cache_diff_v": nrm(ks[5], (DEC_BATCH, DEPTH, PAST_LEN, DIFF_HEADS, 2 * DIFF_HEAD_DIM), 1.0),
        "state_ret": nrm(ks[6], (DEC_BATCH, DEPTH, 2, RET_HEADS, RET_KEY_DIM, RET_VAL_DIM), 0.5),
        "c": nrm(ks[7], (DEC_BATCH, D_MODEL), 1.0),
        "c_ctx": nrm(ks[8], (D_MODEL,), 1.0),
        "w_ada": nrm(ks[9], (DEPTH, D_MODEL, 3 * D_MODEL), 0.3 * D_MODEL ** -0.5),
        "b_ada": nrm(ks[10], (DEPTH, 3 * D_MODEL), 0.01),
        "norm_gain": 1.0 + nrm(ks[11], (DEPTH, D_MODEL), 0.05),
        "w_in": nrm(ks[12], (DEPTH, D_MODEL, IN_W), D_MODEL ** -0.5),
        "conv_w": nrm(ks[13], (DEPTH, CONV_W, BRANCH_W), CONV_W ** -0.5),
        "gqa_q_gain": 1.0 + nrm(ks[14], (DEPTH, GQA_HEAD_DIM), 0.05),
        "gqa_k_gain": 1.0 + nrm(ks[15], (DEPTH, GQA_HEAD_DIM), 0.05),
        "ret_decay": ret_logit + nrm(ks[16], (DEPTH, 2, RET_HEADS), 0.1),
        "diff_lambda": nrm(ks[17], (DEPTH, 4, DIFF_HEAD_DIM), 0.1),
        "diff_norm_gain": 1.0 + nrm(ks[18], (DEPTH, 2 * DIFF_HEAD_DIM), 0.05),
        "w_branch": nrm(ks[19], (DEPTH, N_BRANCH, BRANCH_W, D_MODEL), BRANCH_W ** -0.5),
        "w_mgate": nrm(ks[20], (DEPTH, D_MODEL, N_BRANCH * D_MODEL), D_MODEL ** -0.5),
        "w_out": nrm(ks[21], (DEPTH, D_MODEL, D_MODEL), D_MODEL ** -0.5),
        "final_gain": 1.0 + nrm(ks[22], (D_MODEL,), 0.05),
    }


def reference(x_prompt, x_sample, cache_gqa_k, cache_gqa_v, cache_diff_k, cache_diff_v, state_ret,
              c, c_ctx, w_ada, b_ada, norm_gain, w_in, conv_w, gqa_q_gain, gqa_k_gain, ret_decay,
              diff_lambda, diff_norm_gain, w_branch, w_mgate, w_out, final_gain):
    n_lat = x_sample.shape[1]
    rope_gqa = axial_rope_tables(n_lat, GQA_HEAD_DIM)
    rope_diff = axial_rope_tables(n_lat, DIFF_HEAD_DIM)
    xp, xs = x_prompt, x_sample
    ctx_lists = ([], [], [], [], [])
    for l in range(DEPTH):
        p = dict(w_in=w_in[l], conv_w=conv_w[l], gqa_q_gain=gqa_q_gain[l], gqa_k_gain=gqa_k_gain[l],
                 ret_decay=ret_decay[l], diff_lambda=diff_lambda[l], diff_norm_gain=diff_norm_gain[l],
                 w_branch=w_branch[l], w_mgate=w_mgate[l], w_out=w_out[l])
        lambda_init = 0.8 - 0.6 * math.exp(-0.3 * l)
        shift, scale, gate = adaln_params(c_ctx, w_ada[l], b_ada[l])
        h = rms_norm(xp, norm_gain[l]) * (1.0 + scale) + shift
        out, ctx_tensors = mixer_sublayer(h, p, lambda_init, None, None, None)
        xp = xp + gate * out
        for lst, t in zip(ctx_lists, ctx_tensors):
            lst.append(t)
        shift, scale, gate = adaln_params(c, w_ada[l], b_ada[l])
        h = rms_norm(xs, norm_gain[l]) * (1.0 + scale[:, None]) + shift[:, None]
        cached = (cache_gqa_k[:, l], cache_gqa_v[:, l], cache_diff_k[:, l], cache_diff_v[:, l], state_ret[:, l])
        out, _ = mixer_sublayer(h, p, lambda_init, rope_gqa, rope_diff, cached)
        xs = xs + gate[:, None] * out
    y_prompt = rms_norm(xp, final_gain)
    y_sample = rms_norm(xs, final_gain)
    new_cache_gqa_k = jnp.stack(ctx_lists[0], axis=1)
    new_cache_gqa_v = jnp.stack(ctx_lists[1], axis=1)
    new_cache_diff_k = jnp.stack(ctx_lists[2], axis=1)
    new_cache_diff_v = jnp.stack(ctx_lists[3], axis=1)
    new_state_ret = jnp.stack(ctx_lists[4], axis=1)
    return (y_prompt, y_sample, new_cache_gqa_k, new_cache_gqa_v, new_cache_diff_k, new_cache_diff_v, new_state_ret)
```

```cpp
#include <hip/hip_runtime.h>
#include <hip/hip_bf16.h>
#include <hip/hip_cooperative_groups.h>
#include <cstdio>
namespace cg = cooperative_groups;

typedef unsigned short u16;
using bf16x8 = __attribute__((ext_vector_type(8))) short;
using f32x16 = __attribute__((ext_vector_type(16))) float;
using u32x4 = __attribute__((ext_vector_type(4))) unsigned;
using u32x2 = __attribute__((ext_vector_type(2))) unsigned;

#define DI __device__ __forceinline__
#define MFMA32(a, b, c) __builtin_amdgcn_mfma_f32_32x32x16_bf16((a), (b), (c), 0, 0, 0)

constexpr int DM = 1024;
constexpr int INW = 3840;
constexpr int MC = 8192;
constexpr int MT = 40960;
constexpr int NKL = 4608;
constexpr int LSTR = 72;
constexpr float EPSN = 1e-6f;
constexpr int SMEM_BYTES = 2 * 2 * 128 * LSTR * 2;

constexpr size_t OUT_GK = 41943040ull;
constexpr size_t OUT_GV = 44040192ull;
constexpr size_t OUT_DK = 46137344ull;
constexpr size_t OUT_DV = 50331648ull;
constexpr size_t OUT_ST = 54525952ull;

struct Params {
  const float *x_prompt, *x_sample, *cache_gk, *cache_gv, *cache_dk, *cache_dv, *state_ret, *c, *c_ctx, *w_ada, *b_ada,
      *norm_gain, *w_in, *conv_w, *q_gain, *k_gain, *ret_decay, *diff_lambda, *diff_gain, *w_branch, *w_mgate, *w_out, *final_gain;
  float* out;
  u16 *WinT, *WgT, *WbT, *WoT;
  float* mod;
  float* rope;
  u16 *H, *Z, *KG, *VtG, *KD, *VtD, *VtGc, *VtDc, *VtRc, *VtRl;
  float* U;
  u16* SinT;
  u16* Y;
};

DI unsigned pack2(float a, float b) {
  __hip_bfloat162 h = __float22bfloat162_rn(make_float2(a, b));
  return *reinterpret_cast<unsigned*>(&h);
}
DI u16 f2bf(float a) { return (u16)(pack2(a, 0.f) & 0xffffu); }
DI float bflo(unsigned v) { return __uint_as_float(v << 16); }
DI float bfhi(unsigned v) { return __uint_as_float(v & 0xffff0000u); }
DI float silu_f(float x) { return x / (1.f + __expf(-x)); }
DI float sigmoid_f(float x) { return 1.f / (1.f + __expf(-x)); }
DI f32x16 zero16() { f32x16 z; _Pragma("unroll") for (int i = 0; i < 16; ++i) z[i] = 0.f; return z; }
DI int otid() { int t = (int)__builtin_amdgcn_workitem_id_x(); asm volatile("" : "+v"(t)); return t; }
DI float wave_sum(float v) {
  _Pragma("unroll") for (int o = 1; o < 64; o <<= 1) v += __shfl_xor(v, o);
  return v;
}

DI void gemm_acc(const u16* __restrict__ A, int lda, const u16* __restrict__ B, int ldb, int K,
                 f32x16 (&acc)[2][2], u16* sm) {
  const int tid = otid(), lane = tid & 63, w = tid >> 6, wn = w >> 1, wt = w & 1, l31 = lane & 31, hf = lane >> 5;
  const int lr = tid >> 3, kc = tid & 7;
  const u16* ga = A + (size_t)lr * lda + kc * 8;
  const u16* gb = B + (size_t)lr * ldb + kc * 8;
  constexpr int STG = 2 * 128 * LSTR;
  u32x4 ra[4], rb[4];
  _Pragma("unroll") for (int i = 0; i < 4; ++i) {
    ra[i] = *(const u32x4*)(ga + (size_t)(32 * i) * lda);
    rb[i] = *(const u32x4*)(gb + (size_t)(32 * i) * ldb);
  }
  _Pragma("unroll") for (int i = 0; i < 4; ++i) {
    *(u32x4*)(sm + (lr + 32 * i) * LSTR + kc * 8) = ra[i];
    *(u32x4*)(sm + 128 * LSTR + (lr + 32 * i) * LSTR + kc * 8) = rb[i];
  }
  __syncthreads();
  const int nk = K >> 6;
  for (int kt = 0; kt < nk; ++kt) {
    const int st = kt & 1;
    if (kt + 1 < nk) {
      const int k0 = (kt + 1) << 6;
      _Pragma("unroll") for (int i = 0; i < 4; ++i) {
        ra[i] = *(const u32x4*)(ga + (size_t)(32 * i) * lda + k0);
        rb[i] = *(const u32x4*)(gb + (size_t)(32 * i) * ldb + k0);
      }
    }
    const u16* sa = sm + st * STG + (wn * 64 + l31) * LSTR + hf * 8;
    const u16* sb = sm + st * STG + 128 * LSTR + (wt * 64 + l31) * LSTR + hf * 8;
    _Pragma("unroll") for (int ks = 0; ks < 4; ++ks) {
      const bf16x8 a0 = *(const bf16x8*)(sa + ks * 16);
      const bf16x8 a1 = *(const bf16x8*)(sa + 32 * LSTR + ks * 16);
      const bf16x8 b0 = *(const bf16x8*)(sb + ks * 16);
      const bf16x8 b1 = *(const bf16x8*)(sb + 32 * LSTR + ks * 16);
      acc[0][0] = MFMA32(a0, b0, acc[0][0]);
      acc[0][1] = MFMA32(a0, b1, acc[0][1]);
      acc[1][0] = MFMA32(a1, b0, acc[1][0]);
      acc[1][1] = MFMA32(a1, b1, acc[1][1]);
      __builtin_amdgcn_sched_barrier(0);
    }
    if (kt + 1 < nk) {
      u16* d = sm + (st ^ 1) * STG;
      _Pragma("unroll") for (int i = 0; i < 4; ++i) {
        *(u32x4*)(d + (lr + 32 * i) * LSTR + kc * 8) = ra[i];
        *(u32x4*)(d + 128 * LSTR + (lr + 32 * i) * LSTR + kc * 8) = rb[i];
      }
    }
    __syncthreads();
  }
}

DI void phase0(const Params& p, unsigned char* smem) {
  const int tid = otid();
  float* tile = (float*)smem;
  for (int job = blockIdx.x; job < 4992; job += gridDim.x) {
    const int l = job / 2496;
    int rem = job - l * 2496;
    const float* src; u16* dst; int C;
    if (rem < 960) { src = p.w_in + (size_t)l * 1024 * 3840; dst = p.WinT + (size_t)l * 3840 * 1024; C = 3840; }
    else if (rem < 1984) { rem -= 960; src = p.w_mgate + (size_t)l * 1024 * 4096; dst = p.WgT + (size_t)l * 4096 * 1024; C = 4096; }
    else if (rem < 2240) { rem -= 1984; src = p.w_branch + (size_t)l * 1024 * 1024; dst = p.WbT + (size_t)l * 1024 * 1024; C = 1024; }
    else { rem -= 2240; src = p.w_out + (size_t)l * 1024 * 1024; dst = p.WoT + (size_t)l * 1024 * 1024; C = 1024; }
    const int tr = rem & 15, tc = rem >> 4;
    const int r0 = tr * 64, c0 = tc * 64;
    __syncthreads();
    _Pragma("unroll") for (int i = 0; i < 4; ++i) {
      const int rr = (tid >> 4) + 16 * i, cc = (tid & 15) * 4;
      const float4 v = *(const float4*)(src + (size_t)(r0 + rr) * C + c0 + cc);
      tile[rr * 65 + cc + 0] = v.x; tile[rr * 65 + cc + 1] = v.y; tile[rr * 65 + cc + 2] = v.z; tile[rr * 65 + cc + 3] = v.w;
    }
    __syncthreads();
    {
      const int n = tid >> 2, kq = (tid & 3) * 16;
      unsigned wv[8];
      _Pragma("unroll") for (int j = 0; j < 8; ++j) wv[j] = pack2(tile[(kq + 2 * j) * 65 + n], tile[(kq + 2 * j + 1) * 65 + n]);
      u16* d = dst + (size_t)(c0 + n) * 1024 + r0 + kq;
      *(uint4*)d = make_uint4(wv[0], wv[1], wv[2], wv[3]);
      *(uint4*)(d + 8) = make_uint4(wv[4], wv[5], wv[6], wv[7]);
    }
  }
  __syncthreads();
  if (blockIdx.x * 4 < 384) {
    float* sc = (float*)smem;
    for (int i = tid; i < 9 * 1024; i += 256) {
      const int j = i >> 10, k = i & 1023;
      const float cv = (j == 0) ? p.c_ctx[k] : p.c[(j - 1) * 1024 + k];
      sc[i] = silu_f(cv);
    }
    __syncthreads();
    const int item = blockIdx.x * 4 + (tid >> 6);
    if (item < 384) {
      const int lane = tid & 63;
      const int l = item / 192, n = (item % 192) * 16 + (lane & 15), ks = lane >> 4;
      float acc[9];
      _Pragma("unroll") for (int j = 0; j < 9; ++j) acc[j] = 0.f;
      const float* wp = p.w_ada + (size_t)l * 1024 * 3072 + n;
      for (int k = ks * 256; k < ks * 256 + 256; ++k) {
        const float wv = wp[(size_t)k * 3072];
        _Pragma("unroll") for (int j = 0; j < 9; ++j) acc[j] += sc[j * 1024 + k] * wv;
      }
      _Pragma("unroll") for (int j = 0; j < 9; ++j) {
        acc[j] += __shfl_xor(acc[j], 16);
        acc[j] += __shfl_xor(acc[j], 32);
      }
      if (lane < 16) {
        const float bv = p.b_ada[l * 3072 + n];
        _Pragma("unroll") for (int j = 0; j < 9; ++j) p.mod[(l * 9 + j) * 3072 + n] = acc[j] + bv;
      }
    }
    __syncthreads();
  }
  if (blockIdx.x == gridDim.x - 1) {
    for (int i = tid; i < 1024; i += 256) {
      const int pos = i >> 4, f = i & 15;
      const float inv = powf(10000.f, -(float)f / 16.f);
      const float ang = (float)pos * inv;
      p.rope[2 * i] = cosf(ang);
      p.rope[2 * i + 1] = sinf(ang);
    }
  }
}

DI void phaseA0(const Params& p, int l) {
  const int tid = otid(), lane = tid & 63;
  const int gw = blockIdx.x * 4 + (tid >> 6), nw = gridDim.x * 4;
  const float* ng = p.norm_gain + l * 1024;
  for (int row = gw; row < MT; row += nw) {
    const float* xr = (l == 0) ? (row < MC ? p.x_prompt + (size_t)row * 1024 : p.x_sample + (size_t)(row - MC) * 1024)
                               : p.out + (size_t)row * 1024;
    float4 v[4];
    float ss = 0.f;
    _Pragma("unroll") for (int i = 0; i < 4; ++i) {
      v[i] = ((const float4*)xr)[lane + 64 * i];
      ss += v[i].x * v[i].x + v[i].y * v[i].y + v[i].z * v[i].z + v[i].w * v[i].w;
    }
    ss = wave_sum(ss);
    const float rstd = rsqrtf(ss * (1.f / 1024.f) + EPSN);
    const int j = row < MC ? 0 : 1 + ((row - MC) >> 12);
    const float* shift = p.mod + (l * 9 + j) * 3072;
    const float* scale = shift + 1024;
    _Pragma("unroll") for (int i = 0; i < 4; ++i) {
      const int k = 4 * (lane + 64 * i);
      const float4 g = *(const float4*)(ng + k);
      const float4 s = *(const float4*)(scale + k);
      const float4 sh = *(const float4*)(shift + k);
      const float h0 = v[i].x * rstd * g.x * (1.f + s.x) + sh.x;
      const float h1 = v[i].y * rstd * g.y * (1.f + s.y) + sh.y;
      const float h2 = v[i].z * rstd * g.z * (1.f + s.z) + sh.z;
      const float h3 = v[i].w * rstd * g.w * (1.f + s.w) + sh.w;
      *(uint2*)(p.H + (size_t)row * 1024 + k) = make_uint2(pack2(h0, h1), pack2(h2, h3));
    }
  }
  const int gt = blockIdx.x * 256 + tid, nt = gridDim.x * 256;
  for (int idx = gt; idx < 8 * 65536; idx += nt) {
    const int b = idx >> 16, rem = idx & 65535;
    p.KG[(size_t)b * NKL * 128 + rem] = f2bf(p.cache_gk[(size_t)(b * 2 + l) * 65536 + rem]);
  }
  for (int idx = gt; idx < 8 * 131072; idx += nt) {
    const int b = idx >> 17, rem = idx & 131071;
    p.KD[(size_t)b * NKL * 256 + rem] = f2bf(p.cache_dk[(size_t)(b * 2 + l) * 131072 + rem]);
  }
  for (int idx = gt; idx < 8 * 2 * 64 * 512; idx += nt) {
    const int pk = idx & 511, dv = (idx >> 9) & 63, g = (idx >> 15) & 1, b = idx >> 16;
    p.VtG[((size_t)(b * 2 + g) * 64 + dv) * NKL + pk] = f2bf(p.cache_gv[((size_t)(b * 2 + l) * 512 + pk) * 128 + g * 64 + dv]);
  }
  for (int idx = gt; idx < 8 * 4 * 64 * 512; idx += nt) {
    const int pk = idx & 511, dv = (idx >> 9) & 63, h = (idx >> 15) & 3, b = idx >> 17;
    p.VtD[((size_t)(b * 4 + h) * 64 + dv) * NKL + pk] = f2bf(p.cache_dv[((size_t)(b * 2 + l) * 512 + pk) * 256 + h * 64 + dv]);
  }
}

#define NLOC(a, r) ((a) * 32 + 8 * ((r) >> 2) + 4 * hf + ((r) & 3))

DI void a1_epilogue(const Params& p, int l, int nbase, int m0w, f32x16 (&acc)[2][2]) {
  const int lane = otid() & 63, l31 = lane & 31, hf = lane >> 5;
  _Pragma("unroll") for (int b = 0; b < 2; ++b) {
    const int m = m0w + b * 32 + l31;
    const bool ctx = m < MC;
    int bb, t;
    if (ctx) { bb = m >> 8; t = m & 255; } else { const int ml = m - MC; bb = ml >> 12; t = ml & 4095; }
    float v[2][16];
    _Pragma("unroll") for (int a = 0; a < 2; ++a)
      _Pragma("unroll") for (int r = 0; r < 16; ++r) v[a][r] = acc[a][b][r];

    auto rmsn = [&](const float* gain) {
      float ss = 0.f;
      _Pragma("unroll") for (int a = 0; a < 2; ++a)
        _Pragma("unroll") for (int r = 0; r < 16; ++r) ss += v[a][r] * v[a][r];
      ss += __shfl_xor(ss, 32);
      const float rinv = rsqrtf(ss * (1.f / 64.f) + EPSN);
      _Pragma("unroll") for (int a = 0; a < 2; ++a)
        _Pragma("unroll") for (int i = 0; i < 4; ++i) {
          const float4 g = *(const float4*)(gain + a * 32 + 8 * i + 4 * hf);
          v[a][4 * i + 0] *= rinv * g.x; v[a][4 * i + 1] *= rinv * g.y; v[a][4 * i + 2] *= rinv * g.z; v[a][4 * i + 3] *= rinv * g.w;
        }
    };
    auto rope64 = [&]() {
      const int trow = t >> 6, tcol = t & 63;
      const float2* rp = (const float2*)p.rope;
      _Pragma("unroll") for (int r = 0; r < 16; ++r) {
        const int j = 8 * (r >> 2) + 4 * hf + (r & 3);
        const int pos = ((r >> 2) < 2) ? trow : tcol;
        const float2 cs = rp[pos * 16 + (j & 15)];
        const float x1 = v[0][r], x2 = v[1][r];
        v[0][r] = x1 * cs.x - x2 * cs.y;
        v[1][r] = x1 * cs.y + x2 * cs.x;
      }
    };
    auto rope32 = [&]() {
      const int trow = t >> 6, tcol = t & 63;
      const float2* rp = (const float2*)p.rope;
      _Pragma("unroll") for (int a = 0; a < 2; ++a)
        _Pragma("unroll") for (int r = 0; r < 8; ++r) {
          const int j = 8 * (r >> 2) + 4 * hf + (r & 3);
          const int pos = ((r >> 2) == 0) ? trow : tcol;
          const float2 cs = rp[pos * 16 + 2 * (j & 7)];
          const float x1 = v[a][r], x2 = v[a][r + 8];
          v[a][r] = x1 * cs.x - x2 * cs.y;
          v[a][r + 8] = x1 * cs.y + x2 * cs.x;
        }
    };
    auto store_nat = [&](u16* dst) {
      _Pragma("unroll") for (int a = 0; a < 2; ++a)
        _Pragma("unroll") for (int i = 0; i < 4; ++i)
          *(uint2*)(dst + a * 32 + 8 * i + 4 * hf) = make_uint2(pack2(v[a][4 * i], v[a][4 * i + 1]), pack2(v[a][4 * i + 2], v[a][4 * i + 3]));
    };
    auto store_f32 = [&](float* dst) {
      _Pragma("unroll") for (int a = 0; a < 2; ++a)
        _Pragma("unroll") for (int i = 0; i < 4; ++i)
          *(float4*)(dst + a * 32 + 8 * i + 4 * hf) = make_float4(v[a][4 * i], v[a][4 * i + 1], v[a][4 * i + 2], v[a][4 * i + 3]);
    };
    auto store_T = [&](u16* dst, int ld) {
      _Pragma("unroll") for (int a = 0; a < 2; ++a)
        _Pragma("unroll") for (int r = 0; r < 16; ++r) dst[(size_t)NLOC(a, r) * ld] = f2bf(v[a][r]);
    };

    u16* zrow = p.Z + (size_t)m * INW + nbase;
    if (nbase < 1024) {
      store_nat(zrow);
    } else if (nbase < 1280) {
      rmsn(p.q_gain + l * 64);
      if (!ctx) rope64();
      store_nat(zrow);
    } else if (nbase < 1408) {
      const int kvh = (nbase - 1280) >> 6;
      rmsn(p.k_gain + l * 64);
      if (ctx) {
        store_f32(p.out + OUT_GK + ((size_t)(bb * 2 + l) * 256 + t) * 128 + kvh * 64);
        store_nat(zrow);
      } else {
        rope64();
        store_nat(p.KG + ((size_t)bb * NKL + 512 + t) * 128 + kvh * 64);
      }
    } else if (nbase < 1536) {
      const int kvh = (nbase - 1408) >> 6;
      if (ctx) {
        store_f32(p.out + OUT_GV + ((size_t)(bb * 2 + l) * 256 + t) * 128 + kvh * 64);
        store_T(p.VtGc + ((size_t)(bb * 2 + kvh) * 64) * 256 + t, 256);
      } else {
        store_T(p.VtG + ((size_t)(bb * 2 + kvh) * 64) * NKL + 512 + t, NKL);
      }
    } else if (nbase < 2048) {
      store_nat(zrow);
    } else if (nbase < 2304) {
      _Pragma("unroll") for (int a = 0; a < 2; ++a)
        _Pragma("unroll") for (int r = 0; r < 16; ++r) v[a][r] *= 0.125f;
      store_nat(zrow);
    } else if (nbase < 2560) {
      const int hh = (nbase - 2304) >> 6;
      store_nat(zrow);
      if (ctx) store_T(p.VtRc + ((size_t)(bb * 4 + hh) * 64) * 256 + t, 256);
      else store_T(p.VtRl + ((size_t)(bb * 4 + hh) * 64) * 4096 + t, 4096);
    } else if (nbase < 2816) {
      store_nat(zrow);
    } else if (nbase < 3072) {
      if (!ctx) rope32();
      store_nat(zrow);
    } else if (nbase < 3328) {
      const int cb = nbase - 3072;
      if (ctx) {
        store_f32(p.out + OUT_DK + ((size_t)(bb * 2 + l) * 256 + t) * 256 + cb);
        store_nat(zrow);
      } else {
        rope32();
        store_nat(p.KD + ((size_t)bb * NKL + 512 + t) * 256 + cb);
      }
    } else if (nbase < 3584) {
      const int cb = nbase - 3328, hh = cb >> 6;
      if (ctx) {
        store_f32(p.out + OUT_DV + ((size_t)(bb * 2 + l) * 256 + t) * 256 + cb);
        store_T(p.VtDc + ((size_t)(bb * 4 + hh) * 64) * 256 + t, 256);
      } else {
        store_T(p.VtD + ((size_t)(bb * 4 + hh) * 64) * NKL + 512 + t, NKL);
      }
    } else {
      store_nat(zrow);
    }
  }
}

DI void phaseA1(const Params& p, int l, unsigned char* smem) {
  const int w = otid() >> 6, wn = w >> 1, wt = w & 1;
  for (int tile = blockIdx.x; tile < 30 * 320; tile += gridDim.x) {
    const int tn = tile % 30, tm = tile / 30;
    f32x16 acc[2][2];
    _Pragma("unroll") for (int a = 0; a < 2; ++a)
      _Pragma("unroll") for (int b = 0; b < 2; ++b) acc[a][b] = zero16();
    gemm_acc(p.WinT + ((size_t)l * 3840 + tn * 128) * 1024, 1024, p.H + (size_t)tm * 128 * 1024, 1024, 1024, acc, (u16*)smem);
    a1_epilogue(p, l, tn * 128 + wn * 64, tm * 128 + wt * 64, acc);
  }
}

DI void ld8(const u16* ptr, float (&f)[8]) {
  const uint4 v = *(const uint4*)ptr;
  f[0] = bflo(v.x); f[1] = bfhi(v.x); f[2] = bflo(v.y); f[3] = bfhi(v.y);
  f[4] = bflo(v.z); f[5] = bfhi(v.z); f[6] = bflo(v.w); f[7] = bfhi(v.w);
}

DI void conv_items(const Params& p, int l) {
  const int gt = blockIdx.x * 256 + otid(), nt = gridDim.x * 256;
  const float* cw = p.conv_w + l * 768;
  for (int idx = gt; idx < MT * 32; idx += nt) {
    const int m = idx >> 5, c8 = (idx & 31) * 8;
    int t, T;
    if (m < MC) { t = m & 255; T = 256; } else { t = (m - MC) & 4095; T = 4096; }
    const u16* zr = p.Z + (size_t)m * INW + c8;
    float bg[8], gt8[8], cgc[8], uc[8], gp[8], gn[8];
    ld8(zr, bg); ld8(zr + 768, gt8); ld8(zr + 256, cgc); ld8(zr + 512, uc);
    if (t > 0) { float a[8], b[8]; ld8(zr - INW + 256, a); ld8(zr - INW + 512, b); _Pragma("unroll") for (int i = 0; i < 8; ++i) gp[i] = a[i] * b[i]; }
    else { _Pragma("unroll") for (int i = 0; i < 8; ++i) gp[i] = 0.f; }
    if (t < T - 1) { float a[8], b[8]; ld8(zr + INW + 256, a); ld8(zr + INW + 512, b); _Pragma("unroll") for (int i = 0; i < 8; ++i) gn[i] = a[i] * b[i]; }
    else { _Pragma("unroll") for (int i = 0; i < 8; ++i) gn[i] = 0.f; }
    float y[8];
    _Pragma("unroll") for (int i = 0; i < 8; ++i) {
      const float w0 = cw[c8 + i], w1 = cw[256 + c8 + i], w2 = cw[512 + c8 + i];
      const float g = cgc[i] * uc[i];
      y[i] = bg[i] * (w0 * gp[i] + w1 * g + w2 * gn[i]) * silu_f(gt8[i]);
    }
    *(uint4*)(p.Y + (size_t)m * 1024 + c8) = make_uint4(pack2(y[0], y[1]), pack2(y[2], y[3]), pack2(y[4], y[5]), pack2(y[6], y[7]));
  }
}

DI float log_gamma(const Params& p, int l, int dir, int h) {
  const float x = p.ret_decay[(l * 2 + dir) * 4 + h];
  return -log1pf(expf(-x));
}

DI void ret_decode(int item, bool& ctx, int& bb, int& h, int& c, int& m0) {
  if (item < 256) { ctx = true; c = item & 1; h = (item >> 1) & 3; bb = item >> 3; m0 = bb * 256 + c * 128; }
  else { const int it = item - 256; ctx = false; c = it & 31; h = (it >> 5) & 3; bb = it >> 7; m0 = MC + bb * 4096 + c * 128; }
}

DI void r1_items(const Params& p, int l, unsigned char* smem) {
  const int tid = otid();
  u16* sK = (u16*)smem;
  u16* sV = sK + 128 * 64;
  float* wf = (float*)(sV + 128 * 64);
  float* wb = wf + 128;
  for (int item = blockIdx.x; item < 1280; item += gridDim.x) {
    bool ctx; int bb, h, c, m0;
    ret_decode(item, ctx, bb, h, c, m0);
    const float lgf = log_gamma(p, l, 0, h), lgb = log_gamma(p, l, 1, h);
    __syncthreads();
    _Pragma("unroll") for (int i = 0; i < 4; ++i) {
      const int cidx = tid + 256 * i, row = cidx >> 3, kc = cidx & 7;
      const u16* zr = p.Z + (size_t)(m0 + row) * INW + h * 64 + kc * 8;
      *(uint4*)(sK + row * 64 + kc * 8) = *(const uint4*)(zr + 2048);
      *(uint4*)(sV + row * 64 + kc * 8) = *(const uint4*)(zr + 2304);
    }
    if (tid < 128) { wf[tid] = expf(lgf * (float)(127 - tid)); wb[tid] = expf(lgb * (float)tid); }
    __syncthreads();
    const int dk0 = (tid >> 4) * 4, dv0 = (tid & 15) * 4;
    float uf[4][4], ub[4][4];
    _Pragma("unroll") for (int i = 0; i < 4; ++i)
      _Pragma("unroll") for (int j = 0; j < 4; ++j) { uf[i][j] = 0.f; ub[i][j] = 0.f; }
    for (int j = 0; j < 128; ++j) {
      const uint2 kv = *(const uint2*)(sK + j * 64 + dk0);
      const uint2 vv = *(const uint2*)(sV + j * 64 + dv0);
      const float k4[4] = {bflo(kv.x), bfhi(kv.x), bflo(kv.y), bfhi(kv.y)};
      const float v4[4] = {bflo(vv.x), bfhi(vv.x), bflo(vv.y), bfhi(vv.y)};
      const float a = wf[j], b = wb[j];
      _Pragma("unroll") for (int i = 0; i < 4; ++i) {
        const float kf = k4[i] * a, kb = k4[i] * b;
        _Pragma("unroll") for (int q = 0; q < 4; ++q) { uf[i][q] += kf * v4[q]; ub[i][q] += kb * v4[q]; }
      }
    }
    float* uo = p.U + (size_t)item * 2 * 4096;
    _Pragma("unroll") for (int i = 0; i < 4; ++i) {
      *(float4*)(uo + (dk0 + i) * 64 + dv0) = make_float4(uf[i][0], uf[i][1], uf[i][2], uf[i][3]);
      *(float4*)(uo + 4096 + (dk0 + i) * 64 + dv0) = make_float4(ub[i][0], ub[i][1], ub[i][2], ub[i][3]);
    }
  }
}

DI void r2_item(const Params& p, int l, int bi, bool ctx) {
  const int tid = otid();
  const int eb = bi & 15, dir = (bi >> 4) & 1, h = (bi >> 5) & 3, bb = bi >> 7;
  const int ep = eb * 256 + tid;
  const int dv = ep >> 6, dk = ep & 63;
  const int e = dk * 64 + dv;
  const int nch = ctx ? 2 : 32;
  const int base = ctx ? (bb * 4 + h) * 2 : 256 + (bb * 4 + h) * 32;
  const float gC = expf(log_gamma(p, l, dir, h) * 128.f);
  float S = ctx ? 0.f : p.state_ret[((((size_t)bb * 2 + l) * 2 + dir) * 4 + h) * 4096 + e];
  for (int i = 0; i < nch; ++i) {
    const int c = dir ? (nch - 1 - i) : i;
    const size_t it = (size_t)(base + c) * 2 + dir;
    p.SinT[it * 4096 + ep] = f2bf(S);
    S = S * gC + p.U[it * 4096 + e];
  }
  if (ctx) p.out[OUT_ST + ((((size_t)bb * 2 + l) * 2 + dir) * 4 + h) * 4096 + e] = S;
}

template <bool DIFF>
DI void attn_item(const Params& p, int l, bool ctx, int bb, int unit, int qb, unsigned char* smem) {
  const int tid = otid(), lane = tid & 63, w = tid >> 6, l31 = lane & 31, hf = lane >> 5;
  const int qi = w & 1, qs = w >> 1;
  const int mq = (ctx ? bb * 256 : MC + bb * 4096) + qb * 64 + qs * 32 + l31;
  const int nkeys = ctx ? 256 : NKL;
  const u16* Kp; const u16* Vt; int ldk, ldv;
  if (!DIFF) {
    if (ctx) { Kp = p.Z + (size_t)(bb * 256) * INW + 1280 + unit * 64; ldk = INW; Vt = p.VtGc + ((size_t)(bb * 2 + unit) * 64) * 256; ldv = 256; }
    else { Kp = p.KG + (size_t)bb * NKL * 128 + unit * 64; ldk = 128; Vt = p.VtG + ((size_t)(bb * 2 + unit) * 64) * NKL; ldv = NKL; }
  } else {
    if (ctx) { Kp = p.Z + (size_t)(bb * 256) * INW + 3072 + unit * 64; ldk = INW; Vt = p.VtDc + ((size_t)(bb * 4 + unit) * 64) * 256; ldv = 256; }
    else { Kp = p.KD + (size_t)bb * NKL * 256 + unit * 64; ldk = 256; Vt = p.VtD + ((size_t)(bb * 4 + unit) * 64) * NKL; ldv = NKL; }
  }
  constexpr int NS = DIFF ? 2 : 4;
  bf16x8 qf[NS];
  {
    const u16* zq = p.Z + (size_t)mq * INW + (DIFF ? 2816 + unit * 64 + qi * 32 : 1024 + (unit * 2 + qi) * 64) + hf * 8;
    _Pragma("unroll") for (int s = 0; s < NS; ++s) qf[s] = *(const bf16x8*)(zq + s * 16);
  }
  const int kcol = (DIFF ? qi * 32 : 0) + hf * 8;
  const float sc = (DIFF ? 0.17677669529663687f : 0.125f) * 1.4426950408889634f;
  f32x16 O[2];
  O[0] = zero16(); O[1] = zero16();
  float mrun = -1e30f, lsum = 0.f;

  u16* sm = (u16*)smem;
  constexpr int STG = 2 * 64 * LSTR;
  const int lr = tid >> 3, kc = tid & 7;
  const u16* gk = Kp + (size_t)lr * ldk + kc * 8;
  const u16* gv = Vt + (size_t)lr * ldv + kc * 8;
  u32x4 rk[2], rv[2];
  __syncthreads();
  _Pragma("unroll") for (int i = 0; i < 2; ++i) {
    rk[i] = *(const u32x4*)(gk + (size_t)(32 * i) * ldk);
    rv[i] = *(const u32x4*)(gv + (size_t)(32 * i) * ldv);
  }
  _Pragma("unroll") for (int i = 0; i < 2; ++i) {
    *(u32x4*)(sm + (lr + 32 * i) * LSTR + kc * 8) = rk[i];
    *(u32x4*)(sm + 64 * LSTR + (lr + 32 * i) * LSTR + kc * 8) = rv[i];
  }
  __syncthreads();
  const int nt = nkeys >> 6;
  for (int kt = 0; kt < nt; ++kt) {
    const int st = kt & 1;
    if (kt + 1 < nt) {
      const int k0 = (kt + 1) << 6;
      _Pragma("unroll") for (int i = 0; i < 2; ++i) {
        rk[i] = *(const u32x4*)(gk + (size_t)(k0 + 32 * i) * ldk);
        rv[i] = *(const u32x4*)(gv + (size_t)(32 * i) * ldv + k0);
      }
    }
    const u16* sK = sm + st * STG;
    const u16* sV = sK + 64 * LSTR;
    f32x16 S[2];
    S[0] = zero16(); S[1] = zero16();
    _Pragma("unroll") for (int s = 0; s < NS; ++s)
      _Pragma("unroll") for (int k2 = 0; k2 < 2; ++k2) {
        const bf16x8 kf = *(const bf16x8*)(sK + (k2 * 32 + l31) * LSTR + kcol + s * 16);
        S[k2] = MFMA32(kf, qf[s], S[k2]);
      }
    float mx = -1e30f;
    _Pragma("unroll") for (int k2 = 0; k2 < 2; ++k2)
      _Pragma("unroll") for (int r = 0; r < 16; ++r) mx = fmaxf(mx, S[k2][r]);
    mx = fmaxf(mx, __shfl_xor(mx, 32));
    const float mnew = fmaxf(mrun, mx * sc);
    const float alpha = __builtin_amdgcn_exp2f(mrun - mnew);
    mrun = mnew;
    float ps = 0.f;
    _Pragma("unroll") for (int k2 = 0; k2 < 2; ++k2)
      _Pragma("unroll") for (int r = 0; r < 16; ++r) {
        const float pv = __builtin_amdgcn_exp2f(S[k2][r] * sc - mnew);
        ps += pv;
        S[k2][r] = pv;
      }
    lsum = lsum * alpha + ps;
    _Pragma("unroll") for (int a = 0; a < 2; ++a)
      _Pragma("unroll") for (int r = 0; r < 16; ++r) O[a][r] *= alpha;
    bf16x8 pf[4];
    _Pragma("unroll") for (int k2 = 0; k2 < 2; ++k2)
      _Pragma("unroll") for (int u = 0; u < 2; ++u) {
        u32x4 pk;
        pk[0] = pack2(S[k2][8 * u + 0], S[k2][8 * u + 1]);
        pk[1] = pack2(S[k2][8 * u + 2], S[k2][8 * u + 3]);
        pk[2] = pack2(S[k2][8 * u + 4], S[k2][8 * u + 5]);
        pk[3] = pack2(S[k2][8 * u + 6], S[k2][8 * u + 7]);
        pf[2 * k2 + u] = __builtin_bit_cast(bf16x8, pk);
      }
    _Pragma("unroll") for (int a = 0; a < 2; ++a)
      _Pragma("unroll") for (int s2 = 0; s2 < 4; ++s2) {
        const u16* vp = sV + (a * 32 + l31) * LSTR + 16 * s2 + 4 * hf;
        u32x4 vv;
        const u32x2 lo = *(const u32x2*)vp;
        const u32x2 hi = *(const u32x2*)(vp + 8);
        vv[0] = lo[0]; vv[1] = lo[1]; vv[2] = hi[0]; vv[3] = hi[1];
        O[a] = MFMA32(__builtin_bit_cast(bf16x8, vv), pf[s2], O[a]);
      }
    if (kt + 1 < nt) {
      u16* d = sm + (st ^ 1) * STG;
      _Pragma("unroll") for (int i = 0; i < 2; ++i) {
        *(u32x4*)(d + (lr + 32 * i) * LSTR + kc * 8) = rk[i];
        *(u32x4*)(d + 64 * LSTR + (lr + 32 * i) * LSTR + kc * 8) = rv[i];
      }
    }
    __syncthreads();
  }
  const float inv = 1.f / (lsum + __shfl_xor(lsum, 32));
  const u16* zg = p.Z + (size_t)mq * INW;
  u16* yr = p.Y + (size_t)mq * 1024;
  if (!DIFF) {
    _Pragma("unroll") for (int a = 0; a < 2; ++a)
      _Pragma("unroll") for (int i = 0; i < 4; ++i) {
        const int col = (unit * 2 + qi) * 64 + a * 32 + 8 * i + 4 * hf;
        const uint2 gv2 = *(const uint2*)(zg + 1536 + col);
        const float y0 = O[a][4 * i + 0] * inv * silu_f(bflo(gv2.x));
        const float y1 = O[a][4 * i + 1] * inv * silu_f(bfhi(gv2.x));
        const float y2 = O[a][4 * i + 2] * inv * silu_f(bflo(gv2.y));
        const float y3 = O[a][4 * i + 3] * inv * silu_f(bfhi(gv2.y));
        *(uint2*)(yr + 256 + col) = make_uint2(pack2(y0, y1), pack2(y2, y3));
      }
  } else {
    float* xb = (float*)smem + qs * 32 * 64;
    if (qi == 1) {
      _Pragma("unroll") for (int a = 0; a < 2; ++a)
        _Pragma("unroll") for (int r = 0; r < 16; ++r) xb[(a * 16 + r) * 64 + lane] = O[a][r] * inv;
    }
    __syncthreads();
    if (qi == 0) {
      const float* lp = p.diff_lambda + l * 128;
      float d1 = 0.f, d2 = 0.f;
      for (int i = 0; i < 32; ++i) { d1 += lp[i] * lp[32 + i]; d2 += lp[64 + i] * lp[96 + i]; }
      const float lam_init = 0.8f - 0.6f * expf(-0.3f * (float)l);
      const float lam = expf(d1) - expf(d2) + lam_init;
      float ss = 0.f;
      _Pragma("unroll") for (int a = 0; a < 2; ++a)
        _Pragma("unroll") for (int r = 0; r < 16; ++r) {
          const float o = O[a][r] * inv - lam * xb[(a * 16 + r) * 64 + lane];
          O[a][r] = o;
          ss += o * o;
        }
      ss += __shfl_xor(ss, 32);
      const float rinv = rsqrtf(ss * (1.f / 64.f) + EPSN) * (1.f - lam_init);
      const float* gn = p.diff_gain + l * 64;
      _Pragma("unroll") for (int a = 0; a < 2; ++a)
        _Pragma("unroll") for (int i = 0; i < 4; ++i) {
          const int nl = a * 32 + 8 * i + 4 * hf;
          const int col = unit * 64 + nl;
          const uint2 gv2 = *(const uint2*)(zg + 3584 + col);
          const float4 g4 = *(const float4*)(gn + nl);
          const float y0 = O[a][4 * i + 0] * rinv * g4.x * silu_f(bflo(gv2.x));
          const float y1 = O[a][4 * i + 1] * rinv * g4.y * silu_f(bfhi(gv2.x));
          const float y2 = O[a][4 * i + 2] * rinv * g4.z * silu_f(bflo(gv2.y));
          const float y3 = O[a][4 * i + 3] * rinv * g4.w * silu_f(bfhi(gv2.y));
          *(uint2*)(yr + 768 + col) = make_uint2(pack2(y0, y1), pack2(y2, y3));
        }
    }
  }
}

DI void r3_item(const Params& p, int l, int item, unsigned char* smem) {
  const int tid = otid(), lane = tid & 63, w = tid >> 6, l31 = lane & 31, hf = lane >> 5;
  bool ctx; int bb, h, c, m0;
  ret_decode(item, ctx, bb, h, c, m0);
  const int iq = w * 32 + l31;
  const int mq = m0 + iq;
  const float LOG2E = 1.4426950408889634f;
  const float lf2 = log_gamma(p, l, 0, h) * LOG2E, lb2 = log_gamma(p, l, 1, h) * LOG2E;
  u16* sK = (u16*)smem;
  u16* sV = sK + 128 * LSTR;
  constexpr int VSTR = 136;
  const u16* Vt = ctx ? p.VtRc + ((size_t)(bb * 4 + h) * 64) * 256 + c * 128 : p.VtRl + ((size_t)(bb * 4 + h) * 64) * 4096 + c * 128;
  const int ldv = ctx ? 256 : 4096;
  __syncthreads();
  _Pragma("unroll") for (int i = 0; i < 4; ++i) {
    const int cidx = tid + 256 * i;
    { const int row = cidx >> 3, kc = cidx & 7;
      *(uint4*)(sK + row * LSTR + kc * 8) = *(const uint4*)(p.Z + (size_t)(m0 + row) * INW + 2048 + h * 64 + kc * 8); }
    { const int dv = cidx >> 4, kc = cidx & 15;
      *(uint4*)(sV + dv * VSTR + kc * 8) = *(const uint4*)(Vt + (size_t)dv * ldv + kc * 8); }
  }
  bf16x8 qf[4];
  {
    const u16* zq = p.Z + (size_t)mq * INW + 1792 + h * 64 + hf * 8;
    _Pragma("unroll") for (int s = 0; s < 4; ++s) qf[s] = *(const bf16x8*)(zq + s * 16);
  }
  __syncthreads();
  f32x16 O[2];
  O[0] = zero16(); O[1] = zero16();
  _Pragma("unroll 1") for (int kt = 0; kt < 2; ++kt) {
    f32x16 S[2];
    S[0] = zero16(); S[1] = zero16();
    _Pragma("unroll") for (int s = 0; s < 4; ++s)
      _Pragma("unroll") for (int k2 = 0; k2 < 2; ++k2) {
        const bf16x8 kf = *(const bf16x8*)(sK + (kt * 64 + k2 * 32 + l31) * LSTR + s * 16 + hf * 8);
        S[k2] = MFMA32(kf, qf[s], S[k2]);
      }
    bf16x8 pf[4];
    _Pragma("unroll") for (int k2 = 0; k2 < 2; ++k2) {
      _Pragma("unroll") for (int r = 0; r < 16; ++r) {
        const int jk = kt * 64 + k2 * 32 + 8 * (r >> 2) + 4 * hf + (r & 3);
        const int d = iq - jk;
        float wgt;
        if (d > 0) wgt = __builtin_amdgcn_exp2f(lf2 * (float)d);
        else if (d < 0) wgt = __builtin_amdgcn_exp2f(lb2 * (float)(-d));
        else wgt = 2.f;
        S[k2][r] *= wgt;
      }
      _Pragma("unroll") for (int u = 0; u < 2; ++u) {
        u32x4 pk;
        pk[0] = pack2(S[k2][8 * u + 0], S[k2][8 * u + 1]);
        pk[1] = pack2(S[k2][8 * u + 2], S[k2][8 * u + 3]);
        pk[2] = pack2(S[k2][8 * u + 4], S[k2][8 * u + 5]);
        pk[3] = pack2(S[k2][8 * u + 6], S[k2][8 * u + 7]);
        pf[2 * k2 + u] = __builtin_bit_cast(bf16x8, pk);
      }
    }
    _Pragma("unroll") for (int a = 0; a < 2; ++a)
      _Pragma("unroll") for (int s2 = 0; s2 < 4; ++s2) {
        const u16* vp = sV + (a * 32 + l31) * VSTR + kt * 64 + 16 * s2 + 4 * hf;
        u32x4 vv;
        const u32x2 lo = *(const u32x2*)vp;
        const u32x2 hi = *(const u32x2*)(vp + 8);
        vv[0] = lo[0]; vv[1] = lo[1]; vv[2] = hi[0]; vv[3] = hi[1];
        O[a] = MFMA32(__builtin_bit_cast(bf16x8, vv), pf[s2], O[a]);
      }
  }
  _Pragma("unroll") for (int dir = 0; dir < 2; ++dir) {
    const u16* st = p.SinT + ((size_t)item * 2 + dir) * 4096;
    const float dq = dir == 0 ? __builtin_amdgcn_exp2f(lf2 * (float)(iq + 1)) : __builtin_amdgcn_exp2f(lb2 * (float)(128 - iq));
    _Pragma("unroll") for (int a = 0; a < 2; ++a) {
      f32x16 X = zero16();
      _Pragma("unroll") for (int s = 0; s < 4; ++s) {
        const bf16x8 sf = *(const bf16x8*)(st + (a * 32 + l31) * 64 + s * 16 + hf * 8);
        X = MFMA32(sf, qf[s], X);
      }
      _Pragma("unroll") for (int r = 0; r < 16; ++r) O[a][r] += X[r] * dq;
    }
  }
  float ss = 0.f;
  _Pragma("unroll") for (int a = 0; a < 2; ++a)
    _Pragma("unroll") for (int r = 0; r < 16; ++r) ss += O[a][r] * O[a][r];
  ss += __shfl_xor(ss, 32);
  const float rinv = rsqrtf(ss * (1.f / 64.f) + EPSN);
  const u16* zg = p.Z + (size_t)mq * INW + 2560 + h * 64;
  u16* yr = p.Y + (size_t)mq * 1024 + 512 + h * 64;
  _Pragma("unroll") for (int a = 0; a < 2; ++a)
    _Pragma("unroll") for (int i = 0; i < 4; ++i) {
      const int nl = a * 32 + 8 * i + 4 * hf;
      const uint2 gv2 = *(const uint2*)(zg + nl);
      const float y0 = O[a][4 * i + 0] * rinv * silu_f(bflo(gv2.x));
      const float y1 = O[a][4 * i + 1] * rinv * silu_f(bfhi(gv2.x));
      const float y2 = O[a][4 * i + 2] * rinv * silu_f(bflo(gv2.y));
      const float y3 = O[a][4 * i + 3] * rinv * silu_f(bfhi(gv2.y));
      *(uint2*)(yr + nl) = make_uint2(pack2(y0, y1), pack2(y2, y3));
    }
}

DI void phaseC(const Params& p, int l, unsigned char* smem) {
  const int lane = otid() & 63, w = otid() >> 6, wn = w >> 1, wt = w & 1, l31 = lane & 31, hf = lane >> 5;
  u16* Mg = p.Z;
  for (int tile = blockIdx.x; tile < 8 * 320; tile += gridDim.x) {
    const int tn = tile & 7, tm = tile >> 3;
    unsigned mgp[2][2][8];
    _Pragma("unroll") for (int a = 0; a < 2; ++a)
      _Pragma("unroll") for (int b = 0; b < 2; ++b)
        _Pragma("unroll") for (int r = 0; r < 8; ++r) mgp[a][b][r] = 0u;
    for (int br = 0; br < 4; ++br) {
      unsigned gp[2][2][8];
      {
        f32x16 acc[2][2];
        _Pragma("unroll") for (int a = 0; a < 2; ++a)
          _Pragma("unroll") for (int b = 0; b < 2; ++b) acc[a][b] = zero16();
        gemm_acc(p.WgT + ((size_t)l * 4096 + br * 1024 + tn * 128) * 1024, 1024, p.H + (size_t)tm * 128 * 1024, 1024, 1024, acc, (u16*)smem);
        _Pragma("unroll") for (int a = 0; a < 2; ++a)
          _Pragma("unroll") for (int b = 0; b < 2; ++b)
            _Pragma("unroll") for (int r = 0; r < 8; ++r) gp[a][b][r] = pack2(sigmoid_f(acc[a][b][2 * r]), sigmoid_f(acc[a][b][2 * r + 1]));
      }
      f32x16 acc[2][2];
      _Pragma("unroll") for (int a = 0; a < 2; ++a)
        _Pragma("unroll") for (int b = 0; b < 2; ++b) acc[a][b] = zero16();
      gemm_acc(p.WbT + ((size_t)l * 1024 + tn * 128) * 1024 + br * 256, 1024, p.Y + (size_t)tm * 128 * 1024 + br * 256, 1024, 256, acc, (u16*)smem);
      _Pragma("unroll") for (int a = 0; a < 2; ++a)
        _Pragma("unroll") for (int b = 0; b < 2; ++b)
          _Pragma("unroll") for (int r = 0; r < 8; ++r)
            mgp[a][b][r] = pack2(bflo(mgp[a][b][r]) + bflo(gp[a][b][r]) * acc[a][b][2 * r], bfhi(mgp[a][b][r]) + bfhi(gp[a][b][r]) * acc[a][b][2 * r + 1]);
    }
    _Pragma("unroll") for (int b = 0; b < 2; ++b) {
      const int m = tm * 128 + wt * 64 + b * 32 + l31;
      u16* dst = Mg + (size_t)m * INW + tn * 128 + wn * 64;
      _Pragma("unroll") for (int a = 0; a < 2; ++a)
        _Pragma("unroll") for (int i = 0; i < 4; ++i)
          *(uint2*)(dst + a * 32 + 8 * i + 4 * hf) = make_uint2(mgp[a][b][2 * i], mgp[a][b][2 * i + 1]);
    }
  }
}

DI void phaseD(const Params& p, int l, unsigned char* smem) {
  const int lane = otid() & 63, w = otid() >> 6, wn = w >> 1, wt = w & 1, l31 = lane & 31, hf = lane >> 5;
  const u16* Mg = p.Z;
  for (int tile = blockIdx.x; tile < 8 * 320; tile += gridDim.x) {
    const int tn = tile & 7, tm = tile >> 3;
    f32x16 acc[2][2];
    _Pragma("unroll") for (int a = 0; a < 2; ++a)
      _Pragma("unroll") for (int b = 0; b < 2; ++b) acc[a][b] = zero16();
    gemm_acc(p.WoT + ((size_t)l * 1024 + tn * 128) * 1024, 1024, Mg + (size_t)tm * 128 * INW, INW, 1024, acc, (u16*)smem);
    _Pragma("unroll") for (int b = 0; b < 2; ++b) {
      const int m = tm * 128 + wt * 64 + b * 32 + l31;
      const int j = m < MC ? 0 : 1 + ((m - MC) >> 12);
      const float* gate = p.mod + (l * 9 + j) * 3072 + 2048 + tn * 128 + wn * 64;
      const float* xr = ((l == 0) ? (m < MC ? p.x_prompt + (size_t)m * 1024 : p.x_sample + (size_t)(m - MC) * 1024) : p.out + (size_t)m * 1024) + tn * 128 + wn * 64;
      float* xo = p.out + (size_t)m * 1024 + tn * 128 + wn * 64;
      _Pragma("unroll") for (int a = 0; a < 2; ++a)
        _Pragma("unroll") for (int i = 0; i < 4; ++i) {
          const int nl = a * 32 + 8 * i + 4 * hf;
          const float4 xv = *(const float4*)(xr + nl);
          const float4 gv = *(const float4*)(gate + nl);
          float4 o;
          o.x = xv.x + gv.x * acc[a][b][4 * i + 0];
          o.y = xv.y + gv.y * acc[a][b][4 * i + 1];
          o.z = xv.z + gv.z * acc[a][b][4 * i + 2];
          o.w = xv.w + gv.w * acc[a][b][4 * i + 3];
          *(float4*)(xo + nl) = o;
        }
    }
  }
}

DI void phaseFinal(const Params& p) {
  const int tid = otid(), lane = tid & 63;
  const int gw = blockIdx.x * 4 + (tid >> 6), nw = gridDim.x * 4;
  for (int row = gw; row < MT; row += nw) {
    float* xr = p.out + (size_t)row * 1024;
    float4 v[4];
    float ss = 0.f;
    _Pragma("unroll") for (int i = 0; i < 4; ++i) {
      v[i] = ((const float4*)xr)[lane + 64 * i];
      ss += v[i].x * v[i].x + v[i].y * v[i].y + v[i].z * v[i].z + v[i].w * v[i].w;
    }
    ss = wave_sum(ss);
    const float rstd = rsqrtf(ss * (1.f / 1024.f) + EPSN);
    _Pragma("unroll") for (int i = 0; i < 4; ++i) {
      const float4 g = *(const float4*)(p.final_gain + 4 * (lane + 64 * i));
      ((float4*)xr)[lane + 64 * i] = make_float4(v[i].x * rstd * g.x, v[i].y * rstd * g.y, v[i].z * rstd * g.z, v[i].w * rstd * g.w);
    }
  }
}

__global__ void __launch_bounds__(256, 2) hybrid_megakernel(Params p) {
  cg::grid_group grid = cg::this_grid();
  __shared__ __attribute__((aligned(16))) unsigned char smem[SMEM_BYTES];
  phase0(p, smem);
  grid.sync();
  _Pragma("unroll 1") for (int l = 0; l < 2; ++l) {
    phaseA0(p, l);
    grid.sync();
    phaseA1(p, l, smem);
    grid.sync();
    conv_items(p, l);
    r1_items(p, l, smem);
    grid.sync();
    for (int it = blockIdx.x; it < 1024 + 1024 + 2048 + 256 + 512 + 4096; it += gridDim.x) {
      if (it < 1024) r2_item(p, l, it, false);
      else if (it < 2048) { const int i = it - 1024; attn_item<false>(p, l, false, i >> 7, (i >> 6) & 1, i & 63, smem); }
      else if (it < 4096) { const int i = it - 2048; attn_item<true>(p, l, false, i >> 8, (i >> 6) & 3, i & 63, smem); }
      else if (it < 4352) { const int i = it - 4096; attn_item<false>(p, l, true, i >> 3, (i >> 2) & 1, i & 3, smem); }
      else if (it < 4864) { const int i = it - 4352; attn_item<true>(p, l, true, i >> 4, (i >> 2) & 3, i & 3, smem); }
      else r2_item(p, l, it - 4864, true);
    }
    grid.sync();
    for (int it = blockIdx.x; it < 1280; it += gridDim.x) r3_item(p, l, it, smem);
    grid.sync();
    phaseC(p, l, smem);
    grid.sync();
    phaseD(p, l, smem);
    grid.sync();
  }
  phaseFinal(p);
}

extern "C" void kernel_launch(void* const* d_in, const int* in_sizes, int n_in, void* d_out, int out_size, void* d_ws, size_t ws_size,
                              hipStream_t stream) {
  static int grid_blocks = 0;
  if (!grid_blocks) {
    int dev = 0, cus = 0, per_cu = 0;
    (void)hipGetDevice(&dev);
    (void)hipDeviceGetAttribute(&cus, hipDeviceAttributeMultiprocessorCount, dev);
    (void)hipOccupancyMaxActiveBlocksPerMultiprocessor(&per_cu, hybrid_megakernel, 256, 0);
    if (per_cu > 2) per_cu = 2;
    if (per_cu < 1) per_cu = 1;
    grid_blocks = cus * per_cu;
  }
  Params p{};
  const float** fin = (const float**)&p.x_prompt;
  for (int i = 0; i < 23; ++i) fin[i] = (const float*)d_in[i];
  p.out = (float*)d_out;
  unsigned char* wsp = (unsigned char*)d_ws;
  size_t off = 0;
  auto take = [&](size_t bytes) { void* r = wsp + off; off += (bytes + 255) & ~(size_t)255; return r; };
  p.WinT = (u16*)take(2ull * 3840 * 1024 * 2);
  p.WgT = (u16*)take(2ull * 4096 * 1024 * 2);
  p.WbT = (u16*)take(2ull * 1024 * 1024 * 2);
  p.WoT = (u16*)take(2ull * 1024 * 1024 * 2);
  p.mod = (float*)take(2ull * 9 * 3072 * 4);
  p.rope = (float*)take(64ull * 16 * 2 * 4);
  p.H = (u16*)take((size_t)MT * 1024 * 2);
  p.Z = (u16*)take((size_t)MT * INW * 2);
  p.KG = (u16*)take(8ull * NKL * 128 * 2);
  p.VtG = (u16*)take(8ull * 2 * 64 * NKL * 2);
  p.KD = (u16*)take(8ull * NKL * 256 * 2);
  p.VtD = (u16*)take(8ull * 4 * 64 * NKL * 2);
  p.VtGc = (u16*)take(32ull * 2 * 64 * 256 * 2);
  p.VtDc = (u16*)take(32ull * 4 * 64 * 256 * 2);
  p.VtRc = (u16*)take(32ull * 4 * 64 * 256 * 2);
  p.VtRl = (u16*)take(8ull * 4 * 64 * 4096 * 2);
  p.U = (float*)take(1280ull * 2 * 4096 * 4);
  p.SinT = (u16*)take(1280ull * 2 * 4096 * 2);
  p.Y = (u16*)take((size_t)MT * 1024 * 2);
  if (off > ws_size) { fprintf(stderr, "workspace too small: need %zu have %zu\n", off, ws_size); return; }
  void* args[] = {&p};
  hipError_t e = hipLaunchCooperativeKernel((void*)hybrid_megakernel, dim3(grid_blocks), dim3(256), args, 0, stream);
  if (e != hipSuccess) fprintf(stderr, "cooperative launch failed: %s (grid %d)\n", hipGetErrorString(e), grid_blocks);
}
```

```cpp
#include <hip/hip_runtime.h>
#include <hip/hip_bf16.h>
#include <hip/hip_cooperative_groups.h>
#include <cstdio>
namespace cg = cooperative_groups;

typedef unsigned short u16;
using bf16x8 = __attribute__((ext_vector_type(8))) short;
using f32x16 = __attribute__((ext_vector_type(16))) float;
using u32x4 = __attribute__((ext_vector_type(4))) unsigned;
using u32x2 = __attribute__((ext_vector_type(2))) unsigned;

#define DI __device__ __forceinline__
#define MFMA32(a, b, c) __builtin_amdgcn_mfma_f32_32x32x16_bf16((a), (b), (c), 0, 0, 0)

#ifndef REP_A1
#define REP_A1 1
#endif
#ifndef REP_B2
#define REP_B2 1
#endif
#ifndef PIPE_C
#define PIPE_C true
#endif
constexpr int DM = 1024;
constexpr int INW = 3840;
constexpr int MC = 8192;
constexpr int MT = 40960;
constexpr int NKL = 4608;
constexpr int LSTR = 72;
constexpr float EPSN = 1e-6f;
constexpr int SMEM_BYTES = 2 * 2 * 128 * LSTR * 2;

constexpr size_t OUT_GK = 41943040ull;
constexpr size_t OUT_GV = 44040192ull;
constexpr size_t OUT_DK = 46137344ull;
constexpr size_t OUT_DV = 50331648ull;
constexpr size_t OUT_ST = 54525952ull;

struct Params {
  const float *x_prompt, *x_sample, *cache_gk, *cache_gv, *cache_dk, *cache_dv, *state_ret, *c, *c_ctx, *w_ada, *b_ada,
      *norm_gain, *w_in, *conv_w, *q_gain, *k_gain, *ret_decay, *diff_lambda, *diff_gain, *w_branch, *w_mgate, *w_out, *final_gain;
  float* out;
  u16 *WinT, *WgT, *WbT, *WoT;
  float* mod;
  float* rope;
  u16 *H, *Z, *KG, *VtG, *KD, *VtD, *VtGc, *VtDc, *VtRc, *VtRl;
  float* U;
  u16* SinT;
  u16* Y;
  unsigned* bar;
};

typedef float f32x2 __attribute__((ext_vector_type(2)));
typedef __bf16 bf16x2_t __attribute__((ext_vector_type(2)));
DI unsigned pack2(float a, float b) {
  const f32x2 v = {a, b};
  return __builtin_bit_cast(unsigned, __builtin_convertvector(v, bf16x2_t));
}
DI u16 f2bf(float a) { return (u16)(pack2(a, 0.f) & 0xffffu); }
DI float bflo(unsigned v) { return __uint_as_float(v << 16); }
DI float bfhi(unsigned v) { return __uint_as_float(v & 0xffff0000u); }
DI float silu_f(float x) { return x / (1.f + __expf(-x)); }
DI float sigmoid_f(float x) { return 1.f / (1.f + __expf(-x)); }
DI f32x16 zero16() { f32x16 z; _Pragma("unroll") for (int i = 0; i < 16; ++i) z[i] = 0.f; return z; }
DI int otid() { int t = (int)__builtin_amdgcn_workitem_id_x(); asm volatile("" : "+v"(t)); return t; }
DI int vblock() { const int b = (int)blockIdx.x, g = (int)gridDim.x; return ((g & 7) == 0) ? (b & 7) * (g >> 3) + (b >> 3) : b; }
DI size_t tix(int r, int k, int ksl) { return ((size_t)((r >> 7) * ksl + (k >> 5)) << 12) + ((r & 127) << 5) + (k & 31); }
#define XB_TMO      128
#define XB_XCNT(j)  (256  + 64 * (j))
#define XB_XSUB(j)  (1280 + 64 * (j))
#define XB_XGEN(j)  (2304 + 64 * (j))
#define XB_TOP      3328
#define XB_TOPGEN   3392
#define XCD_BAR_WORDS 3456
#define XB_SPIN_CAP (1u << 18)
#define LAS __attribute__((address_space(3)))

__device__ __forceinline__ unsigned xb_ld(unsigned* p)              { return __hip_atomic_load(p, __ATOMIC_RELAXED, __HIP_MEMORY_SCOPE_AGENT); }
__device__ __forceinline__ unsigned xb_add(unsigned* p, unsigned v) { return __hip_atomic_fetch_add(p, v, __ATOMIC_RELAXED, __HIP_MEMORY_SCOPE_AGENT); }
__device__ __forceinline__ unsigned xb_xcc_id() { return (unsigned)__builtin_amdgcn_s_getreg((3 << 11) | 20) & 0xFu; }
#define XB_SPIN(cond, bar) do { unsigned _sp = 0; while (cond) { __builtin_amdgcn_s_sleep(1); \
    if ((++_sp & 255u) == 0u) { if (xb_ld(&(bar)[XB_TMO])) break; if (_sp > XB_SPIN_CAP) { atomicAdd(&(bar)[XB_TMO], 1u); break; } } } } while (0)

struct XcdBarrier {
    unsigned* bar; unsigned x;
    volatile LAS unsigned* st;
};

__device__ __forceinline__ XcdBarrier xcd_barrier_post(unsigned* bar, volatile LAS unsigned* st) {
    XcdBarrier b; b.bar = bar; b.x = xb_xcc_id(); b.st = st;
    if (threadIdx.x == 0) (void)xb_add(&bar[XB_XCNT(b.x)], 1u);
    return b;
}
__device__ __forceinline__ void xcd_barrier_complete(unsigned* bar, unsigned x, unsigned& nloc, unsigned& nx) {
    const unsigned G = gridDim.x * gridDim.y * gridDim.z;
    unsigned sum, cnt, mine, sp = 0u;
    for (;;) {
        sum = 0u; cnt = 0u; mine = 0u;
#pragma unroll
        for (unsigned j = 0; j < 16; ++j) { const unsigned c = xb_ld(&bar[XB_XCNT(j)]); sum += c; cnt += (c > 0u) ? 1u : 0u; mine = (j == x) ? c : mine; }
        if (sum == G) break;
        __builtin_amdgcn_s_sleep(1);
        if ((++sp & 255u) == 0u) { if (xb_ld(&bar[XB_TMO])) break; if (sp > XB_SPIN_CAP) { atomicAdd(&bar[XB_TMO], 1u); break; } }
    }
    nloc = mine > 0u ? mine : 1u; nx = cnt > 0u ? cnt : 1u;
}

__device__ __forceinline__ void xcd_barrier(const XcdBarrier& b) {
    asm volatile("s_waitcnt vmcnt(0)" ::: "memory");
    __syncthreads();
    if (threadIdx.x == 0) {
        unsigned* bar = b.bar;
        __builtin_amdgcn_s_waitcnt(0);
        unsigned nloc = b.st[0], nx = b.st[1];
        if (nloc == 0u) { xcd_barrier_complete(bar, b.x, nloc, nx); b.st[0] = nloc; b.st[1] = nx; }
        const unsigned old = xb_add(&bar[XB_XSUB(b.x)], 1u);
        const unsigned gen = old / nloc;
        if (old + 1u == (gen + 1u) * nloc) {
            __builtin_amdgcn_fence(__ATOMIC_RELEASE, "agent");
            asm volatile("s_waitcnt vmcnt(0)" ::: "memory");
            const unsigned og = xb_add(&bar[XB_TOP], 1u);
            const unsigned tg = og / nx;
            if (og + 1u == (tg + 1u) * nx) xb_add(&bar[XB_TOPGEN], 1u);
            else XB_SPIN(xb_ld(&bar[XB_TOPGEN]) == tg, bar);
            __builtin_amdgcn_fence(__ATOMIC_ACQUIRE, "agent");
            xb_add(&bar[XB_XGEN(b.x)], 1u);
            asm volatile("s_waitcnt vmcnt(0)" ::: "memory");
        } else {
            XB_SPIN(xb_ld(&bar[XB_XGEN(b.x)]) == gen, bar);
            __builtin_amdgcn_fence(__ATOMIC_ACQUIRE, "agent");
            asm volatile("s_waitcnt vmcnt(0)" ::: "memory");
        }
    }
    __syncthreads();
}


DI float wave_sum(float v) {
  _Pragma("unroll") for (int o = 1; o < 64; o <<= 1) v += __shfl_xor(v, o);
  return v;
}

#define VMWAIT(N) asm volatile("s_waitcnt vmcnt(" #N ")" ::: "memory")
#define RAW_BARRIER() do { asm volatile("s_waitcnt lgkmcnt(0)" ::: "memory"); __builtin_amdgcn_s_barrier(); } while (0)
template <int TB>
DI void gemm_acc(const u16* __restrict__ A, const u16* __restrict__ B, int bstride, int nk, f32x16 (&acc)[2][TB], u16* sm) {
  const int tid = otid(), lane = tid & 63, w = tid >> 6, wn = w >> 1, wt = w & 1, l31 = lane & 31, hf = lane >> 5;
  constexpr int NSTG = (TB == 2) ? 4 : 3;
  constexpr int RB = 64 * TB;
  constexpr int STGB = (128 + RB) * 64;
  constexpr int LPB = RB / 64;
  const int lr = tid >> 2, gsl = (tid & 3) ^ ((lr >> 2) & 3);
  const u16* ga = A + lr * 32 + gsl * 8;
  const u16* gb = B + lr * 32 + gsl * 8;
  char* smb = (char*)sm;
  const int wv = __builtin_amdgcn_readfirstlane(w);
  char* smw = smb + wv * 1024;
  const u16* pa[2];
  const u16* pb[LPB];
  _Pragma("unroll") for (int i = 0; i < 2; ++i) pa[i] = ga + 2048 * i;
  _Pragma("unroll") for (int i = 0; i < LPB; ++i) pb[i] = gb + (size_t)(i >> 1) * bstride + 2048 * (i & 1);
#define GEMM_STAGE(ST) do { \
    _Pragma("unroll") for (int i = 0; i < 2; ++i) { \
      __builtin_amdgcn_global_load_lds((const unsigned*)pa[i], (unsigned*)(smw + (ST) * STGB + i * 4096), 16, 0, 0); pa[i] += 4096; } \
    _Pragma("unroll") for (int i = 0; i < LPB; ++i) { \
      __builtin_amdgcn_global_load_lds((const unsigned*)pb[i], (unsigned*)(smw + (ST) * STGB + 8192 + i * 4096), 16, 0, 0); pb[i] += 4096; } \
  } while (0)
  VMWAIT(0);
  _Pragma("unroll") for (int s0 = 0; s0 < NSTG - 1; ++s0) GEMM_STAGE(s0);
  const int sw = (l31 >> 2) & 3;
  const int oa0 = (wn * 64 + l31) * 64 + ((hf ^ sw) << 4), oa1 = (wn * 64 + l31) * 64 + (((2 + hf) ^ sw) << 4);
  const int ob0 = 8192 + (wt * 32 * TB + l31) * 64 + ((hf ^ sw) << 4), ob1 = 8192 + (wt * 32 * TB + l31) * 64 + (((2 + hf) ^ sw) << 4);
  int st = 0, stn = NSTG - 1;
  for (int kt = 0; kt < nk; ++kt) {
    if (kt + NSTG - 2 < nk) { if (TB == 2) VMWAIT(8); else VMWAIT(6); }
    else if (NSTG == 4 && kt + 1 < nk) VMWAIT(4);
    else VMWAIT(0);
    RAW_BARRIER();
    if (kt + NSTG - 1 < nk) GEMM_STAGE(stn);
    __builtin_amdgcn_sched_barrier(0);
    const char* sb = smb + st * STGB;
    bf16x8 fa[2][2], fb[2][TB];
    _Pragma("unroll") for (int a = 0; a < 2; ++a) fa[0][a] = *(const bf16x8*)(sb + oa0 + a * 2048);
    _Pragma("unroll") for (int b = 0; b < TB; ++b) fb[0][b] = *(const bf16x8*)(sb + ob0 + b * 2048);
    _Pragma("unroll") for (int a = 0; a < 2; ++a) fa[1][a] = *(const bf16x8*)(sb + oa1 + a * 2048);
    _Pragma("unroll") for (int b = 0; b < TB; ++b) fb[1][b] = *(const bf16x8*)(sb + ob1 + b * 2048);
    __builtin_amdgcn_sched_barrier(0);
    _Pragma("unroll") for (int ks = 0; ks < 2; ++ks) {
      _Pragma("unroll") for (int a = 0; a < 2; ++a)
        _Pragma("unroll") for (int b = 0; b < TB; ++b) acc[a][b] = MFMA32(fa[ks][a], fb[ks][b], acc[a][b]);
      __builtin_amdgcn_sched_barrier(0);
    }
    st = (st + 1 == NSTG) ? 0 : st + 1;
    stn = (stn + 1 == NSTG) ? 0 : stn + 1;
  }
  RAW_BARRIER();
#undef GEMM_STAGE
}

DI void phase0(const Params& p, unsigned char* smem) {
  const int tid = otid();
  float* tile = (float*)smem;
  for (int job = blockIdx.x; job < 4992; job += gridDim.x) {
    const int l = job / 2496;
    int rem = job - l * 2496;
    const float* src; u16* dst; int C;
    if (rem < 960) { src = p.w_in + (size_t)l * 1024 * 3840; dst = p.WinT + (size_t)l * 3840 * 1024; C = 3840; }
    else if (rem < 1984) { rem -= 960; src = p.w_mgate + (size_t)l * 1024 * 4096; dst = p.WgT + (size_t)l * 4096 * 1024; C = 4096; }
    else if (rem < 2240) { rem -= 1984; src = p.w_branch + (size_t)l * 1024 * 1024; dst = p.WbT + (size_t)l * 1024 * 1024; C = 1024; }
    else { rem -= 2240; src = p.w_out + (size_t)l * 1024 * 1024; dst = p.WoT + (size_t)l * 1024 * 1024; C = 1024; }
    const int tr = rem & 15, tc = rem >> 4;
    const int r0 = tr * 64, c0 = tc * 64;
    __syncthreads();
    _Pragma("unroll") for (int i = 0; i < 4; ++i) {
      const int rr = (tid >> 4) + 16 * i, cc = (tid & 15) * 4;
      const float4 v = *(const float4*)(src + (size_t)(r0 + rr) * C + c0 + cc);
      tile[rr * 65 + cc + 0] = v.x; tile[rr * 65 + cc + 1] = v.y; tile[rr * 65 + cc + 2] = v.z; tile[rr * 65 + cc + 3] = v.w;
    }
    __syncthreads();
    {
      const int n = tid >> 2, kq = (tid & 3) * 16;
      unsigned wv[8];
      _Pragma("unroll") for (int j = 0; j < 8; ++j) wv[j] = pack2(tile[(kq + 2 * j) * 65 + n], tile[(kq + 2 * j + 1) * 65 + n]);
      u16* d = dst + tix(c0 + n, r0 + kq, 32);
      *(uint4*)d = make_uint4(wv[0], wv[1], wv[2], wv[3]);
      *(uint4*)(d + 8) = make_uint4(wv[4], wv[5], wv[6], wv[7]);
    }
  }
  __syncthreads();
  if (blockIdx.x < 384) {
    float* sc = (float*)smem;
    float* red = sc + 9 * 1024;
    for (int i = tid; i < 9 * 1024; i += 256) {
      const int j = i >> 10, k = i & 1023;
      const float cv = (j == 0) ? p.c_ctx[k] : p.c[(j - 1) * 1024 + k];
      sc[i] = silu_f(cv);
    }
    __syncthreads();
    const int item = blockIdx.x, lane = tid & 63, w = tid >> 6;
    const int l = item / 192, n = (item % 192) * 16 + (lane & 15);
    const int kbeg = (w * 4 + (lane >> 4)) * 64;
    float acc[9];
    _Pragma("unroll") for (int j = 0; j < 9; ++j) acc[j] = 0.f;
    const float* wp = p.w_ada + (size_t)l * 1024 * 3072 + n;
    for (int k = kbeg; k < kbeg + 64; k += 8) {
      float wv[8];
      _Pragma("unroll") for (int u = 0; u < 8; ++u) wv[u] = wp[(size_t)(k + u) * 3072];
      _Pragma("unroll") for (int u = 0; u < 8; ++u)
        _Pragma("unroll") for (int j = 0; j < 9; ++j) acc[j] += sc[j * 1024 + k + u] * wv[u];
    }
    _Pragma("unroll") for (int j = 0; j < 9; ++j) {
      acc[j] += __shfl_xor(acc[j], 16);
      acc[j] += __shfl_xor(acc[j], 32);
    }
    if (lane < 16) {
      _Pragma("unroll") for (int j = 0; j < 9; ++j) red[(w * 9 + j) * 16 + lane] = acc[j];
    }
    __syncthreads();
    if (tid < 144) {
      const int j = tid >> 4, nn = tid & 15;
      const int n2 = (item % 192) * 16 + nn;
      const float v = red[(0 * 9 + j) * 16 + nn] + red[(1 * 9 + j) * 16 + nn] + red[(2 * 9 + j) * 16 + nn] + red[(3 * 9 + j) * 16 + nn];
      p.mod[(l * 9 + j) * 3072 + n2] = v + p.b_ada[l * 3072 + n2];
    }
    __syncthreads();
  }
  if (blockIdx.x == gridDim.x - 1) {
    for (int i = tid; i < 1024; i += 256) {
      const int pos = i >> 4, f = i & 15;
      const float inv = powf(10000.f, -(float)f / 16.f);
      const float ang = (float)pos * inv;
      p.rope[2 * i] = cosf(ang);
      p.rope[2 * i + 1] = sinf(ang);
    }
  }
}

DI void phaseA0(const Params& p, int l) {
  const int tid = otid(), lane = tid & 63;
  const int gw = blockIdx.x * 4 + (tid >> 6), nw = gridDim.x * 4;
  const float* ng = p.norm_gain + l * 1024;
  for (int row = gw; row < MT; row += nw) {
    const float* xr = (l == 0) ? (row < MC ? p.x_prompt + (size_t)row * 1024 : p.x_sample + (size_t)(row - MC) * 1024)
                               : p.out + (size_t)row * 1024;
    float4 v[4];
    float ss = 0.f;
    _Pragma("unroll") for (int i = 0; i < 4; ++i) {
      v[i] = ((const float4*)xr)[lane + 64 * i];
      ss += v[i].x * v[i].x + v[i].y * v[i].y + v[i].z * v[i].z + v[i].w * v[i].w;
    }
    ss = wave_sum(ss);
    const float rstd = rsqrtf(ss * (1.f / 1024.f) + EPSN);
    const int j = row < MC ? 0 : 1 + ((row - MC) >> 12);
    const float* shift = p.mod + (l * 9 + j) * 3072;
    const float* scale = shift + 1024;
    _Pragma("unroll") for (int i = 0; i < 4; ++i) {
      const int k = 4 * (lane + 64 * i);
      const float4 g = *(const float4*)(ng + k);
      const float4 s = *(const float4*)(scale + k);
      const float4 sh = *(const float4*)(shift + k);
      const float h0 = v[i].x * rstd * g.x * (1.f + s.x) + sh.x;
      const float h1 = v[i].y * rstd * g.y * (1.f + s.y) + sh.y;
      const float h2 = v[i].z * rstd * g.z * (1.f + s.z) + sh.z;
      const float h3 = v[i].w * rstd * g.w * (1.f + s.w) + sh.w;
      *(uint2*)(p.H + tix(row, k, 32)) = make_uint2(pack2(h0, h1), pack2(h2, h3));
    }
  }
  const int gt = blockIdx.x * 256 + tid, nt = gridDim.x * 256;
  for (int idx = gt; idx < 8 * 65536; idx += nt) {
    const int b = idx >> 16, rem = idx & 65535;
    p.KG[(size_t)b * NKL * 128 + rem] = f2bf(p.cache_gk[(size_t)(b * 2 + l) * 65536 + rem]);
  }
  for (int idx = gt; idx < 8 * 131072; idx += nt) {
    const int b = idx >> 17, rem = idx & 131071;
    p.KD[(size_t)b * NKL * 256 + rem] = f2bf(p.cache_dk[(size_t)(b * 2 + l) * 131072 + rem]);
  }
  for (int idx = gt; idx < 8 * 2 * 64 * 512; idx += nt) {
    const int pk = idx & 511, dv = (idx >> 9) & 63, g = (idx >> 15) & 1, b = idx >> 16;
    p.VtG[((size_t)(b * 2 + g) * 64 + dv) * NKL + pk] = f2bf(p.cache_gv[((size_t)(b * 2 + l) * 512 + pk) * 128 + g * 64 + dv]);
  }
  for (int idx = gt; idx < 8 * 4 * 64 * 512; idx += nt) {
    const int pk = idx & 511, dv = (idx >> 9) & 63, h = (idx >> 15) & 3, b = idx >> 17;
    p.VtD[((size_t)(b * 4 + h) * 64 + dv) * NKL + pk] = f2bf(p.cache_dv[((size_t)(b * 2 + l) * 512 + pk) * 256 + h * 64 + dv]);
  }
}

#define NLOC(a, r) ((a) * 32 + 8 * ((r) >> 2) + 4 * hf + ((r) & 3))

template <int NB>
DI void a1_epilogue(const Params& p, int l, int nbase, int m0w, f32x16 (&acc)[2][NB]) {
  const int lane = otid() & 63, l31 = lane & 31, hf = lane >> 5;
  _Pragma("unroll") for (int b = 0; b < NB; ++b) {
    const int m = m0w + b * 32 + l31;
    const bool ctx = m < MC;
    int bb, t;
    if (ctx) { bb = m >> 8; t = m & 255; } else { const int ml = m - MC; bb = ml >> 12; t = ml & 4095; }
    float v[2][16];
    _Pragma("unroll") for (int a = 0; a < 2; ++a)
      _Pragma("unroll") for (int r = 0; r < 16; ++r) v[a][r] = acc[a][b][r];

    auto rmsn = [&](const float* gain) {
      float ss = 0.f;
      _Pragma("unroll") for (int a = 0; a < 2; ++a)
        _Pragma("unroll") for (int r = 0; r < 16; ++r) ss += v[a][r] * v[a][r];
      ss += __shfl_xor(ss, 32);
      const float rinv = rsqrtf(ss * (1.f / 64.f) + EPSN);
      _Pragma("unroll") for (int a = 0; a < 2; ++a)
        _Pragma("unroll") for (int i = 0; i < 4; ++i) {
          const float4 g = *(const float4*)(gain + a * 32 + 8 * i + 4 * hf);
          v[a][4 * i + 0] *= rinv * g.x; v[a][4 * i + 1] *= rinv * g.y; v[a][4 * i + 2] *= rinv * g.z; v[a][4 * i + 3] *= rinv * g.w;
        }
    };
    auto rope64 = [&]() {
      const int trow = t >> 6, tcol = t & 63;
      const float2* rp = (const float2*)p.rope;
      _Pragma("unroll") for (int r = 0; r < 16; ++r) {
        const int j = 8 * (r >> 2) + 4 * hf + (r & 3);
        const int pos = ((r >> 2) < 2) ? trow : tcol;
        const float2 cs = rp[pos * 16 + (j & 15)];
        const float x1 = v[0][r], x2 = v[1][r];
        v[0][r] = x1 * cs.x - x2 * cs.y;
        v[1][r] = x1 * cs.y + x2 * cs.x;
      }
    };
    auto rope32 = [&]() {
      const int trow = t >> 6, tcol = t & 63;
      const float2* rp = (const float2*)p.rope;
      _Pragma("unroll") for (int a = 0; a < 2; ++a)
        _Pragma("unroll") for (int r = 0; r < 8; ++r) {
          const int j = 8 * (r >> 2) + 4 * hf + (r & 3);
          const int pos = ((r >> 2) == 0) ? trow : tcol;
          const float2 cs = rp[pos * 16 + 2 * (j & 7)];
          const float x1 = v[a][r], x2 = v[a][r + 8];
          v[a][r] = x1 * cs.x - x2 * cs.y;
          v[a][r + 8] = x1 * cs.y + x2 * cs.x;
        }
    };
    auto store_nat = [&](u16* dst) {
      _Pragma("unroll") for (int a = 0; a < 2; ++a)
        _Pragma("unroll") for (int i = 0; i < 4; ++i)
          *(uint2*)(dst + a * 32 + 8 * i + 4 * hf) = make_uint2(pack2(v[a][4 * i], v[a][4 * i + 1]), pack2(v[a][4 * i + 2], v[a][4 * i + 3]));
    };
    auto store_f32 = [&](float* dst) {
      _Pragma("unroll") for (int a = 0; a < 2; ++a)
        _Pragma("unroll") for (int i = 0; i < 4; ++i)
          *(float4*)(dst + a * 32 + 8 * i + 4 * hf) = make_float4(v[a][4 * i], v[a][4 * i + 1], v[a][4 * i + 2], v[a][4 * i + 3]);
    };
    auto store_T = [&](u16* dst, int ld) {
      _Pragma("unroll") for (int a = 0; a < 2; ++a)
        _Pragma("unroll") for (int r = 0; r < 16; ++r) dst[(size_t)NLOC(a, r) * ld] = f2bf(v[a][r]);
    };

    u16* zrow = p.Z + (size_t)m * INW + nbase;
    if (nbase < 1024) {
      store_nat(zrow);
    } else if (nbase < 1280) {
      rmsn(p.q_gain + l * 64);
      if (!ctx) rope64();
      store_nat(zrow);
    } else if (nbase < 1408) {
      const int kvh = (nbase - 1280) >> 6;
      rmsn(p.k_gain + l * 64);
      if (ctx) {
        store_f32(p.out + OUT_GK + ((size_t)(bb * 2 + l) * 256 + t) * 128 + kvh * 64);
        store_nat(zrow);
      } else {
        rope64();
        store_nat(p.KG + ((size_t)bb * NKL + 512 + t) * 128 + kvh * 64);
      }
    } else if (nbase < 1536) {
      const int kvh = (nbase - 1408) >> 6;
      if (ctx) {
        store_f32(p.out + OUT_GV + ((size_t)(bb * 2 + l) * 256 + t) * 128 + kvh * 64);
        store_T(p.VtGc + ((size_t)(bb * 2 + kvh) * 64) * 256 + t, 256);
      } else {
        store_T(p.VtG + ((size_t)(bb * 2 + kvh) * 64) * NKL + 512 + t, NKL);
      }
    } else if (nbase < 2048) {
      store_nat(zrow);
    } else if (nbase < 2304) {
      _Pragma("unroll") for (int a = 0; a < 2; ++a)
        _Pragma("unroll") for (int r = 0; r < 16; ++r) v[a][r] *= 0.125f;
      store_nat(zrow);
    } else if (nbase < 2560) {
      const int hh = (nbase - 2304) >> 6;
      store_nat(zrow);
      if (ctx) store_T(p.VtRc + ((size_t)(bb * 4 + hh) * 64) * 256 + t, 256);
      else store_T(p.VtRl + ((size_t)(bb * 4 + hh) * 64) * 4096 + t, 4096);
    } else if (nbase < 2816) {
      store_nat(zrow);
    } else if (nbase < 3072) {
      if (!ctx) rope32();
      store_nat(zrow);
    } else if (nbase < 3328) {
      const int cb = nbase - 3072;
      if (ctx) {
        store_f32(p.out + OUT_DK + ((size_t)(bb * 2 + l) * 256 + t) * 256 + cb);
        store_nat(zrow);
      } else {
        rope32();
        store_nat(p.KD + ((size_t)bb * NKL + 512 + t) * 256 + cb);
      }
    } else if (nbase < 3584) {
      const int cb = nbase - 3328, hh = cb >> 6;
      if (ctx) {
        store_f32(p.out + OUT_DV + ((size_t)(bb * 2 + l) * 256 + t) * 256 + cb);
        store_T(p.VtDc + ((size_t)(bb * 4 + hh) * 64) * 256 + t, 256);
      } else {
        store_T(p.VtD + ((size_t)(bb * 4 + hh) * 64) * NKL + 512 + t, NKL);
      }
    } else {
      store_nat(zrow);
    }
  }
}

DI void phaseA1(const Params& p, int l, unsigned char* smem) {
  const int w = otid() >> 6, wn = w >> 1, wt = w & 1;
  for (int tile = vblock(); tile < 30 * 160; tile += gridDim.x) {
    const int grp = tile / 800, rem = tile - grp * 800;
    const int tm = rem / 5, tn = grp * 5 + (rem - tm * 5);
    f32x16 acc[2][4];
    _Pragma("unroll") for (int a = 0; a < 2; ++a)
      _Pragma("unroll") for (int b = 0; b < 4; ++b) acc[a][b] = zero16();
    gemm_acc<4>(p.WinT + (size_t)l * 3840 * 1024 + ((size_t)(tn * 32) << 12), p.H + ((size_t)(tm * 2 * 32) << 12), 32 * 4096, 32, acc, (u16*)smem);
    a1_epilogue<4>(p, l, tn * 128 + wn * 64, tm * 256 + wt * 128, acc);
  }
}

DI void ld8(const u16* ptr, float (&f)[8]) {
  const uint4 v = *(const uint4*)ptr;
  f[0] = bflo(v.x); f[1] = bfhi(v.x); f[2] = bflo(v.y); f[3] = bfhi(v.y);
  f[4] = bflo(v.z); f[5] = bfhi(v.z); f[6] = bflo(v.w); f[7] = bfhi(v.w);
}

DI void conv_items(const Params& p, int l) {
  const int gt = blockIdx.x * 256 + otid(), nt = gridDim.x * 256;
  const float* cw = p.conv_w + l * 768;
  for (int idx = gt; idx < MT * 32; idx += nt) {
    const int m = idx >> 5, c8 = (idx & 31) * 8;
    int t, T;
    if (m < MC) { t = m & 255; T = 256; } else { t = (m - MC) & 4095; T = 4096; }
    const u16* zr = p.Z + (size_t)m * INW + c8;
    float bg[8], gt8[8], cgc[8], uc[8], gp[8], gn[8];
    ld8(zr, bg); ld8(zr + 768, gt8); ld8(zr + 256, cgc); ld8(zr + 512, uc);
    if (t > 0) { float a[8], b[8]; ld8(zr - INW + 256, a); ld8(zr - INW + 512, b); _Pragma("unroll") for (int i = 0; i < 8; ++i) gp[i] = a[i] * b[i]; }
    else { _Pragma("unroll") for (int i = 0; i < 8; ++i) gp[i] = 0.f; }
    if (t < T - 1) { float a[8], b[8]; ld8(zr + INW + 256, a); ld8(zr + INW + 512, b); _Pragma("unroll") for (int i = 0; i < 8; ++i) gn[i] = a[i] * b[i]; }
    else { _Pragma("unroll") for (int i = 0; i < 8; ++i) gn[i] = 0.f; }
    float y[8];
    _Pragma("unroll") for (int i = 0; i < 8; ++i) {
      const float w0 = cw[c8 + i], w1 = cw[256 + c8 + i], w2 = cw[512 + c8 + i];
      const float g = cgc[i] * uc[i];
      y[i] = bg[i] * (w0 * gp[i] + w1 * g + w2 * gn[i]) * silu_f(gt8[i]);
    }
    *(uint4*)(p.Y + tix(m, c8, 32)) = make_uint4(pack2(y[0], y[1]), pack2(y[2], y[3]), pack2(y[4], y[5]), pack2(y[6], y[7]));
  }
}

DI float log_gamma(const Params& p, int l, int dir, int h) {
  const float x = p.ret_decay[(l * 2 + dir) * 4 + h];
  return -log1pf(expf(-x));
}

DI void ret_decode(int item, bool& ctx, int& bb, int& h, int& c, int& m0) {
  if (item < 256) { ctx = true; c = item & 1; h = (item >> 1) & 3; bb = item >> 3; m0 = bb * 256 + c * 128; }
  else { const int it = item - 256; ctx = false; c = it & 31; h = (it >> 5) & 3; bb = it >> 7; m0 = MC + bb * 4096 + c * 128; }
}

DI void r1_items(const Params& p, int l, unsigned char* smem) {
  const int tid = otid();
  u16* sK = (u16*)smem;
  u16* sV = sK + 128 * 64;
  float* wf = (float*)(sV + 128 * 64);
  float* wb = wf + 128;
  for (int item = blockIdx.x; item < 1280; item += gridDim.x) {
    bool ctx; int bb, h, c, m0;
    ret_decode(item, ctx, bb, h, c, m0);
    const float lgf = log_gamma(p, l, 0, h), lgb = log_gamma(p, l, 1, h);
    __syncthreads();
    _Pragma("unroll") for (int i = 0; i < 4; ++i) {
      const int cidx = tid + 256 * i, row = cidx >> 3, kc = cidx & 7;
      const u16* zr = p.Z + (size_t)(m0 + row) * INW + h * 64 + kc * 8;
      *(uint4*)(sK + row * 64 + kc * 8) = *(const uint4*)(zr + 2048);
      *(uint4*)(sV + row * 64 + kc * 8) = *(const uint4*)(zr + 2304);
    }
    if (tid < 128) { wf[tid] = expf(lgf * (float)(127 - tid)); wb[tid] = expf(lgb * (float)tid); }
    __syncthreads();
    const int dk0 = (tid >> 4) * 4, dv0 = (tid & 15) * 4;
    float uf[4][4], ub[4][4];
    _Pragma("unroll") for (int i = 0; i < 4; ++i)
      _Pragma("unroll") for (int j = 0; j < 4; ++j) { uf[i][j] = 0.f; ub[i][j] = 0.f; }
    for (int j = 0; j < 128; ++j) {
      const uint2 kv = *(const uint2*)(sK + j * 64 + dk0);
      const uint2 vv = *(const uint2*)(sV + j * 64 + dv0);
      const float k4[4] = {bflo(kv.x), bfhi(kv.x), bflo(kv.y), bfhi(kv.y)};
      const float v4[4] = {bflo(vv.x), bfhi(vv.x), bflo(vv.y), bfhi(vv.y)};
      const float a = wf[j], b = wb[j];
      _Pragma("unroll") for (int i = 0; i < 4; ++i) {
        const float kf = k4[i] * a, kb = k4[i] * b;
        _Pragma("unroll") for (int q = 0; q < 4; ++q) { uf[i][q] += kf * v4[q]; ub[i][q] += kb * v4[q]; }
      }
    }
    float* uo = p.U + (size_t)item * 2 * 4096;
    _Pragma("unroll") for (int i = 0; i < 4; ++i) {
      *(float4*)(uo + (dk0 + i) * 64 + dv0) = make_float4(uf[i][0], uf[i][1], uf[i][2], uf[i][3]);
      *(float4*)(uo + 4096 + (dk0 + i) * 64 + dv0) = make_float4(ub[i][0], ub[i][1], ub[i][2], ub[i][3]);
    }
  }
}

template <bool CTX>
DI void r2_item(const Params& p, int l, int bi) {
  const int tid = otid();
  const int eb = bi & 15, dir = (bi >> 4) & 1, h = (bi >> 5) & 3, bb = bi >> 7;
  const int ep = eb * 256 + tid;
  const int dv = ep >> 6, dk = ep & 63;
  const int e = dk * 64 + dv;
  constexpr int nch = CTX ? 2 : 32;
  const int base = CTX ? (bb * 4 + h) * 2 : 256 + (bb * 4 + h) * 32;
  const float gC = expf(log_gamma(p, l, dir, h) * 128.f);
  float S = CTX ? 0.f : p.state_ret[((((size_t)bb * 2 + l) * 2 + dir) * 4 + h) * 4096 + e];
  float u[nch];
  _Pragma("unroll") for (int i = 0; i < nch; ++i) {
    const int c = dir ? (nch - 1 - i) : i;
    u[i] = p.U[((size_t)(base + c) * 2 + dir) * 4096 + e];
  }
  _Pragma("unroll") for (int i = 0; i < nch; ++i) {
    const int c = dir ? (nch - 1 - i) : i;
    p.SinT[((size_t)(base + c) * 2 + dir) * 4096 + ep] = f2bf(S);
    S = S * gC + u[i];
  }
  if (CTX) p.out[OUT_ST + ((((size_t)bb * 2 + l) * 2 + dir) * 4 + h) * 4096 + e] = S;
}

template <bool DIFF>
DI void attn_item(const Params& p, int l, bool ctx, int bb, int unit, int qb, unsigned char* smem) {
  const int tid = otid(), lane = tid & 63, w = tid >> 6, l31 = lane & 31, hf = lane >> 5;
  const int qi = w & 1, qs = w >> 1;
  const int mq = (ctx ? bb * 256 : MC + bb * 4096) + qb * 64 + qs * 32 + l31;
  const int nkeys = ctx ? 256 : NKL;
  const u16* Kp; const u16* Vt; int ldk, ldv;
  if (!DIFF) {
    if (ctx) { Kp = p.Z + (size_t)(bb * 256) * INW + 1280 + unit * 64; ldk = INW; Vt = p.VtGc + ((size_t)(bb * 2 + unit) * 64) * 256; ldv = 256; }
    else { Kp = p.KG + (size_t)bb * NKL * 128 + unit * 64; ldk = 128; Vt = p.VtG + ((size_t)(bb * 2 + unit) * 64) * NKL; ldv = NKL; }
  } else {
    if (ctx) { Kp = p.Z + (size_t)(bb * 256) * INW + 3072 + unit * 64; ldk = INW; Vt = p.VtDc + ((size_t)(bb * 4 + unit) * 64) * 256; ldv = 256; }
    else { Kp = p.KD + (size_t)bb * NKL * 256 + unit * 64; ldk = 256; Vt = p.VtD + ((size_t)(bb * 4 + unit) * 64) * NKL; ldv = NKL; }
  }
  constexpr int NS = DIFF ? 2 : 4;
  bf16x8 qf[NS];
  {
    const u16* zq = p.Z + (size_t)mq * INW + (DIFF ? 2816 + unit * 64 + qi * 32 : 1024 + (unit * 2 + qi) * 64) + hf * 8;
    _Pragma("unroll") for (int s = 0; s < NS; ++s) qf[s] = *(const bf16x8*)(zq + s * 16);
  }
  const float sc = (DIFF ? 0.17677669529663687f : 0.125f) * 1.4426950408889634f;
  f32x16 O[2];
  O[0] = zero16(); O[1] = zero16();
  float mref = -1e30f, lsum = 0.f;

  char* smb = (char*)smem;
  constexpr int STGB = 16384;
  const int lr = tid >> 3, gch = (tid & 7) ^ ((lr >> 1) & 7);
  const u16* gk = Kp + (size_t)lr * ldk + gch * 8;
  const u16* gv = Vt + (size_t)lr * ldv + gch * 8;
  const int wv = __builtin_amdgcn_readfirstlane(w);
  char* smw = smb + wv * 1024;
  const u16* pk0 = gk; const u16* pk1 = gk + (size_t)32 * ldk;
  const u16* pv0 = gv; const u16* pv1 = gv + (size_t)32 * ldv;
  const size_t kstep = (size_t)64 * ldk;
#define ATT_STAGE(ST) do { \
    __builtin_amdgcn_global_load_lds((const unsigned*)pk0, (unsigned*)(smw + (ST) * STGB), 16, 0, 0); pk0 += kstep; \
    __builtin_amdgcn_global_load_lds((const unsigned*)pk1, (unsigned*)(smw + (ST) * STGB + 4096), 16, 0, 0); pk1 += kstep; \
    __builtin_amdgcn_global_load_lds((const unsigned*)pv0, (unsigned*)(smw + (ST) * STGB + 8192), 16, 0, 0); pv0 += 64; \
    __builtin_amdgcn_global_load_lds((const unsigned*)pv1, (unsigned*)(smw + (ST) * STGB + 8192 + 4096), 16, 0, 0); pv1 += 64; \
  } while (0)
  const int nt = nkeys >> 6;
  __syncthreads();
  VMWAIT(0);
  ATT_STAGE(0); ATT_STAGE(1); ATT_STAGE(2);
  const int sw = (l31 >> 1) & 7;
  const int kq0 = DIFF ? qi * 4 : 0;
  for (int kt = 0; kt < nt; ++kt) {
    if (kt + 2 < nt) VMWAIT(8); else if (kt + 1 < nt) VMWAIT(4); else VMWAIT(0);
    RAW_BARRIER();
    if (kt + 3 < nt) ATT_STAGE((kt + 3) & 3);
    __builtin_amdgcn_sched_barrier(0);
    const char* sK = smb + (kt & 3) * STGB;
    const char* sV = sK + 8192;
    f32x16 S[2];
    _Pragma("unroll") for (int s = 0; s < NS; ++s)
      _Pragma("unroll") for (int k2 = 0; k2 < 2; ++k2) {
        const bf16x8 kf = *(const bf16x8*)(sK + (k2 * 32 + l31) * 128 + (((kq0 + 2 * s + hf) ^ sw) << 4));
        if (s == 0) { const f32x16 zc = {0.f, 0.f, 0.f, 0.f, 0.f, 0.f, 0.f, 0.f, 0.f, 0.f, 0.f, 0.f, 0.f, 0.f, 0.f, 0.f}; S[k2] = MFMA32(kf, qf[s], zc); }
        else S[k2] = MFMA32(kf, qf[s], S[k2]);
      }
    float mx = S[0][0];
    _Pragma("unroll") for (int k2 = 0; k2 < 2; ++k2)
      _Pragma("unroll") for (int r = 0; r < 16; ++r) mx = fmaxf(mx, S[k2][r]);
    mx = fmaxf(mx, __shfl_xor(mx, 32));
    const float mxs = mx * sc;
    if (__builtin_amdgcn_ballot_w64(mxs > mref + 8.f) != 0ull) {
      const float mnew = (mxs > mref + 8.f) ? mxs : mref;
      const float alpha = __builtin_amdgcn_exp2f(mref - mnew);
      mref = mnew;
      lsum *= alpha;
      _Pragma("unroll") for (int a = 0; a < 2; ++a)
        _Pragma("unroll") for (int r = 0; r < 16; ++r) O[a][r] *= alpha;
    }
    const f32x2 sc2 = {sc, sc}, nm2 = {-mref, -mref};
    f32x2 ps2 = {0.f, 0.f};
    bf16x8 pf[4];
    _Pragma("unroll") for (int k2 = 0; k2 < 2; ++k2)
      _Pragma("unroll") for (int u = 0; u < 2; ++u) {
        u32x4 pk;
        _Pragma("unroll") for (int j = 0; j < 4; ++j) {
          f32x2 v = {S[k2][8 * u + 2 * j], S[k2][8 * u + 2 * j + 1]};
          v = v * sc2 + nm2;
          f32x2 e;
          e.x = __builtin_amdgcn_exp2f(v.x);
          e.y = __builtin_amdgcn_exp2f(v.y);
          ps2 += e;
          pk[j] = pack2(e.x, e.y);
        }
        pf[2 * k2 + u] = __builtin_bit_cast(bf16x8, pk);
      }
    lsum += ps2.x + ps2.y;
    _Pragma("unroll") for (int a = 0; a < 2; ++a)
      _Pragma("unroll") for (int s2 = 0; s2 < 4; ++s2) {
        const char* vr = sV + (a * 32 + l31) * 128 + 8 * hf;
        u32x4 vv;
        const u32x2 lo = *(const u32x2*)(vr + (((2 * s2) ^ sw) << 4));
        const u32x2 hi = *(const u32x2*)(vr + (((2 * s2 + 1) ^ sw) << 4));
        vv[0] = lo[0]; vv[1] = lo[1]; vv[2] = hi[0]; vv[3] = hi[1];
        O[a] = MFMA32(__builtin_bit_cast(bf16x8, vv), pf[s2], O[a]);
      }
  }
  RAW_BARRIER();
#undef ATT_STAGE
  const float inv = 1.f / (lsum + __shfl_xor(lsum, 32));
  const u16* zg = p.Z + (size_t)mq * INW;
  if (!DIFF) {
    _Pragma("unroll") for (int a = 0; a < 2; ++a)
      _Pragma("unroll") for (int i = 0; i < 4; ++i) {
        const int col = (unit * 2 + qi) * 64 + a * 32 + 8 * i + 4 * hf;
        const uint2 gv2 = *(const uint2*)(zg + 1536 + col);
        const float y0 = O[a][4 * i + 0] * inv * silu_f(bflo(gv2.x));
        const float y1 = O[a][4 * i + 1] * inv * silu_f(bfhi(gv2.x));
        const float y2 = O[a][4 * i + 2] * inv * silu_f(bflo(gv2.y));
        const float y3 = O[a][4 * i + 3] * inv * silu_f(bfhi(gv2.y));
        *(uint2*)(p.Y + tix(mq, 256 + col, 32)) = make_uint2(pack2(y0, y1), pack2(y2, y3));
      }
  } else {
    float* xb = (float*)smem + qs * 32 * 64;
    if (qi == 1) {
      _Pragma("unroll") for (int a = 0; a < 2; ++a)
        _Pragma("unroll") for (int r = 0; r < 16; ++r) xb[(a * 16 + r) * 64 + lane] = O[a][r] * inv;
    }
    __syncthreads();
    if (qi == 0) {
      const float* lp = p.diff_lambda + l * 128;
      float d1 = 0.f, d2 = 0.f;
      for (int i = 0; i < 32; ++i) { d1 += lp[i] * lp[32 + i]; d2 += lp[64 + i] * lp[96 + i]; }
      const float lam_init = 0.8f - 0.6f * expf(-0.3f * (float)l);
      const float lam = expf(d1) - expf(d2) + lam_init;
      float ss = 0.f;
      _Pragma("unroll") for (int a = 0; a < 2; ++a)
        _Pragma("unroll") for (int r = 0; r < 16; ++r) {
          const float o = O[a][r] * inv - lam * xb[(a * 16 + r) * 64 + lane];
          O[a][r] = o;
          ss += o * o;
        }
      ss += __shfl_xor(ss, 32);
      const float rinv = rsqrtf(ss * (1.f / 64.f) + EPSN) * (1.f - lam_init);
      const float* gn = p.diff_gain + l * 64;
      _Pragma("unroll") for (int a = 0; a < 2; ++a)
        _Pragma("unroll") for (int i = 0; i < 4; ++i) {
          const int nl = a * 32 + 8 * i + 4 * hf;
          const int col = unit * 64 + nl;
          const uint2 gv2 = *(const uint2*)(zg + 3584 + col);
          const float4 g4 = *(const float4*)(gn + nl);
          const float y0 = O[a][4 * i + 0] * rinv * g4.x * silu_f(bflo(gv2.x));
          const float y1 = O[a][4 * i + 1] * rinv * g4.y * silu_f(bfhi(gv2.x));
          const float y2 = O[a][4 * i + 2] * rinv * g4.z * silu_f(bflo(gv2.y));
          const float y3 = O[a][4 * i + 3] * rinv * g4.w * silu_f(bfhi(gv2.y));
          *(uint2*)(p.Y + tix(mq, 768 + col, 32)) = make_uint2(pack2(y0, y1), pack2(y2, y3));
        }
    }
  }
}

DI void r3_item(const Params& p, int l, int item, unsigned char* smem) {
  const int tid = otid(), lane = tid & 63, w = tid >> 6, l31 = lane & 31, hf = lane >> 5;
  bool ctx; int bb, h, c, m0;
  ret_decode(item, ctx, bb, h, c, m0);
  const int iq = w * 32 + l31;
  const int mq = m0 + iq;
  const float LOG2E = 1.4426950408889634f;
  const float lf2 = log_gamma(p, l, 0, h) * LOG2E, lb2 = log_gamma(p, l, 1, h) * LOG2E;
  u16* sK = (u16*)smem;
  u16* sV = sK + 128 * LSTR;
  constexpr int VSTR = 136;
  const u16* Vt = ctx ? p.VtRc + ((size_t)(bb * 4 + h) * 64) * 256 + c * 128 : p.VtRl + ((size_t)(bb * 4 + h) * 64) * 4096 + c * 128;
  const int ldv = ctx ? 256 : 4096;
  __syncthreads();
  _Pragma("unroll") for (int i = 0; i < 4; ++i) {
    const int cidx = tid + 256 * i;
    { const int row = cidx >> 3, kc = cidx & 7;
      *(uint4*)(sK + row * LSTR + kc * 8) = *(const uint4*)(p.Z + (size_t)(m0 + row) * INW + 2048 + h * 64 + kc * 8); }
    { const int dv = cidx >> 4, kc = cidx & 15;
      *(uint4*)(sV + dv * VSTR + kc * 8) = *(const uint4*)(Vt + (size_t)dv * ldv + kc * 8); }
  }
  bf16x8 qf[4];
  {
    const u16* zq = p.Z + (size_t)mq * INW + 1792 + h * 64 + hf * 8;
    _Pragma("unroll") for (int s = 0; s < 4; ++s) qf[s] = *(const bf16x8*)(zq + s * 16);
  }
  __syncthreads();
  f32x16 O[2];
  O[0] = zero16(); O[1] = zero16();
  _Pragma("unroll 1") for (int kt = 0; kt < 2; ++kt) {
    f32x16 S[2];
    S[0] = zero16(); S[1] = zero16();
    _Pragma("unroll") for (int s = 0; s < 4; ++s)
      _Pragma("unroll") for (int k2 = 0; k2 < 2; ++k2) {
        const bf16x8 kf = *(const bf16x8*)(sK + (kt * 64 + k2 * 32 + l31) * LSTR + s * 16 + hf * 8);
        S[k2] = MFMA32(kf, qf[s], S[k2]);
      }
    bf16x8 pf[4];
    _Pragma("unroll") for (int k2 = 0; k2 < 2; ++k2) {
      _Pragma("unroll") for (int r = 0; r < 16; ++r) {
        const int jk = kt * 64 + k2 * 32 + 8 * (r >> 2) + 4 * hf + (r & 3);
        const int d = iq - jk;
        float wgt;
        if (d > 0) wgt = __builtin_amdgcn_exp2f(lf2 * (float)d);
        else if (d < 0) wgt = __builtin_amdgcn_exp2f(lb2 * (float)(-d));
        else wgt = 2.f;
        S[k2][r] *= wgt;
      }
      _Pragma("unroll") for (int u = 0; u < 2; ++u) {
        u32x4 pk;
        pk[0] = pack2(S[k2][8 * u + 0], S[k2][8 * u + 1]);
        pk[1] = pack2(S[k2][8 * u + 2], S[k2][8 * u + 3]);
        pk[2] = pack2(S[k2][8 * u + 4], S[k2][8 * u + 5]);
        pk[3] = pack2(S[k2][8 * u + 6], S[k2][8 * u + 7]);
        pf[2 * k2 + u] = __builtin_bit_cast(bf16x8, pk);
      }
    }
    _Pragma("unroll") for (int a = 0; a < 2; ++a)
      _Pragma("unroll") for (int s2 = 0; s2 < 4; ++s2) {
        const u16* vp = sV + (a * 32 + l31) * VSTR + kt * 64 + 16 * s2 + 4 * hf;
        u32x4 vv;
        const u32x2 lo = *(const u32x2*)vp;
        const u32x2 hi = *(const u32x2*)(vp + 8);
        vv[0] = lo[0]; vv[1] = lo[1]; vv[2] = hi[0]; vv[3] = hi[1];
        O[a] = MFMA32(__builtin_bit_cast(bf16x8, vv), pf[s2], O[a]);
      }
  }
  _Pragma("unroll") for (int dir = 0; dir < 2; ++dir) {
    const u16* st = p.SinT + ((size_t)item * 2 + dir) * 4096;
    const float dq = dir == 0 ? __builtin_amdgcn_exp2f(lf2 * (float)(iq + 1)) : __builtin_amdgcn_exp2f(lb2 * (float)(128 - iq));
    _Pragma("unroll") for (int a = 0; a < 2; ++a) {
      f32x16 X = zero16();
      _Pragma("unroll") for (int s = 0; s < 4; ++s) {
        const bf16x8 sf = *(const bf16x8*)(st + (a * 32 + l31) * 64 + s * 16 + hf * 8);
        X = MFMA32(sf, qf[s], X);
      }
      _Pragma("unroll") for (int r = 0; r < 16; ++r) O[a][r] += X[r] * dq;
    }
  }
  float ss = 0.f;
  _Pragma("unroll") for (int a = 0; a < 2; ++a)
    _Pragma("unroll") for (int r = 0; r < 16; ++r) ss += O[a][r] * O[a][r];
  ss += __shfl_xor(ss, 32);
  const float rinv = rsqrtf(ss * (1.f / 64.f) + EPSN);
  const u16* zg = p.Z + (size_t)mq * INW + 2560 + h * 64;
  _Pragma("unroll") for (int a = 0; a < 2; ++a)
    _Pragma("unroll") for (int i = 0; i < 4; ++i) {
      const int nl = a * 32 + 8 * i + 4 * hf;
      const uint2 gv2 = *(const uint2*)(zg + nl);
      const float y0 = O[a][4 * i + 0] * rinv * silu_f(bflo(gv2.x));
      const float y1 = O[a][4 * i + 1] * rinv * silu_f(bfhi(gv2.x));
      const float y2 = O[a][4 * i + 2] * rinv * silu_f(bflo(gv2.y));
      const float y3 = O[a][4 * i + 3] * rinv * silu_f(bfhi(gv2.y));
      *(uint2*)(p.Y + tix(mq, 512 + h * 64 + nl, 32)) = make_uint2(pack2(y0, y1), pack2(y2, y3));
    }
}

DI void phaseC(const Params& p, int l, unsigned char* smem) {
  const int lane = otid() & 63, w = otid() >> 6, wn = w >> 1, wt = w & 1, l31 = lane & 31, hf = lane >> 5;
  u16* Mg = p.Z;
  for (int tile = vblock(); tile < 8 * 320; tile += gridDim.x) {
    const int grp = tile / 640, rem = tile - grp * 640;
    const int tm = rem >> 1, tn = grp * 2 + (rem & 1);
    unsigned mgp[2][2][8];
    _Pragma("unroll") for (int a = 0; a < 2; ++a)
      _Pragma("unroll") for (int b = 0; b < 2; ++b)
        _Pragma("unroll") for (int r = 0; r < 8; ++r) mgp[a][b][r] = 0u;
    for (int br = 0; br < 4; ++br) {
      unsigned gp[2][2][8];
      {
        f32x16 acc[2][2];
        _Pragma("unroll") for (int a = 0; a < 2; ++a)
          _Pragma("unroll") for (int b = 0; b < 2; ++b) acc[a][b] = zero16();
        gemm_acc<2>(p.WgT + (size_t)l * 4096 * 1024 + ((size_t)((br * 8 + tn) * 32) << 12), p.H + ((size_t)(tm * 32) << 12), 0, 32, acc, (u16*)smem);
        _Pragma("unroll") for (int a = 0; a < 2; ++a)
          _Pragma("unroll") for (int b = 0; b < 2; ++b)
            _Pragma("unroll") for (int r = 0; r < 8; ++r) gp[a][b][r] = pack2(sigmoid_f(acc[a][b][2 * r]), sigmoid_f(acc[a][b][2 * r + 1]));
      }
      f32x16 acc[2][2];
      _Pragma("unroll") for (int a = 0; a < 2; ++a)
        _Pragma("unroll") for (int b = 0; b < 2; ++b) acc[a][b] = zero16();
      gemm_acc<2>(p.WbT + (size_t)l * 1024 * 1024 + ((size_t)(tn * 32 + br * 8) << 12), p.Y + ((size_t)(tm * 32 + br * 8) << 12), 0, 8, acc, (u16*)smem);
      _Pragma("unroll") for (int a = 0; a < 2; ++a)
        _Pragma("unroll") for (int b = 0; b < 2; ++b)
          _Pragma("unroll") for (int r = 0; r < 8; ++r)
            mgp[a][b][r] = pack2(bflo(mgp[a][b][r]) + bflo(gp[a][b][r]) * acc[a][b][2 * r], bfhi(mgp[a][b][r]) + bfhi(gp[a][b][r]) * acc[a][b][2 * r + 1]);
    }
    _Pragma("unroll") for (int b = 0; b < 2; ++b) {
      const int m = tm * 128 + wt * 64 + b * 32 + l31;
      _Pragma("unroll") for (int a = 0; a < 2; ++a)
        _Pragma("unroll") for (int i = 0; i < 4; ++i)
          *(uint2*)(Mg + tix(m, tn * 128 + wn * 64 + a * 32 + 8 * i + 4 * hf, 32)) = make_uint2(mgp[a][b][2 * i], mgp[a][b][2 * i + 1]);
    }
  }
}

DI void phaseD(const Params& p, int l, unsigned char* smem) {
  const int lane = otid() & 63, w = otid() >> 6, wn = w >> 1, wt = w & 1, l31 = lane & 31, hf = lane >> 5;
  const u16* Mg = p.Z;
  for (int tile = vblock(); tile < 8 * 320; tile += gridDim.x) {
    const int tn = tile & 7, tm = tile >> 3;
    f32x16 acc[2][2];
    _Pragma("unroll") for (int a = 0; a < 2; ++a)
      _Pragma("unroll") for (int b = 0; b < 2; ++b) acc[a][b] = zero16();
    gemm_acc<2>(p.WoT + (size_t)l * 1024 * 1024 + ((size_t)(tn * 32) << 12), Mg + ((size_t)(tm * 32) << 12), 0, 32, acc, (u16*)smem);
    _Pragma("unroll") for (int b = 0; b < 2; ++b) {
      const int m = tm * 128 + wt * 64 + b * 32 + l31;
      const int j = m < MC ? 0 : 1 + ((m - MC) >> 12);
      const float* gate = p.mod + (l * 9 + j) * 3072 + 2048 + tn * 128 + wn * 64;
      const float* xr = ((l == 0) ? (m < MC ? p.x_prompt + (size_t)m * 1024 : p.x_sample + (size_t)(m - MC) * 1024) : p.out + (size_t)m * 1024) + tn * 128 + wn * 64;
      float* xo = p.out + (size_t)m * 1024 + tn * 128 + wn * 64;
      _Pragma("unroll") for (int a = 0; a < 2; ++a)
        _Pragma("unroll") for (int i = 0; i < 4; ++i) {
          const int nl = a * 32 + 8 * i + 4 * hf;
          const float4 xv = *(const float4*)(xr + nl);
          const float4 gv = *(const float4*)(gate + nl);
          float4 o;
          o.x = xv.x + gv.x * acc[a][b][4 * i + 0];
          o.y = xv.y + gv.y * acc[a][b][4 * i + 1];
          o.z = xv.z + gv.z * acc[a][b][4 * i + 2];
          o.w = xv.w + gv.w * acc[a][b][4 * i + 3];
          *(float4*)(xo + nl) = o;
        }
    }
  }
}

DI void phaseFinal(const Params& p) {
  const int tid = otid(), lane = tid & 63;
  const int gw = blockIdx.x * 4 + (tid >> 6), nw = gridDim.x * 4;
  for (int row = gw; row < MT; row += nw) {
    float* xr = p.out + (size_t)row * 1024;
    float4 v[4];
    float ss = 0.f;
    _Pragma("unroll") for (int i = 0; i < 4; ++i) {
      v[i] = ((const float4*)xr)[lane + 64 * i];
      ss += v[i].x * v[i].x + v[i].y * v[i].y + v[i].z * v[i].z + v[i].w * v[i].w;
    }
    ss = wave_sum(ss);
    const float rstd = rsqrtf(ss * (1.f / 1024.f) + EPSN);
    _Pragma("unroll") for (int i = 0; i < 4; ++i) {
      const float4 g = *(const float4*)(p.final_gain + 4 * (lane + 64 * i));
      ((float4*)xr)[lane + 64 * i] = make_float4(v[i].x * rstd * g.x, v[i].y * rstd * g.y, v[i].z * rstd * g.z, v[i].w * rstd * g.w);
    }
  }
}

__global__ void __launch_bounds__(256, 2) hybrid_megakernel(Params p) {
  cg::grid_group grid = cg::this_grid();
  __shared__ __attribute__((aligned(16))) unsigned char smem[SMEM_BYTES];
  __shared__ uint4 xb_words;
  if (threadIdx.x == 0) xb_words = make_uint4(0u, 0u, 0u, 0u);
  __syncthreads();
  XcdBarrier xb = xcd_barrier_post(p.bar, (volatile LAS unsigned*)&xb_words);
  phase0(p, smem);
  grid.sync();
  _Pragma("unroll 1") for (int l = 0; l < 2; ++l) {
    phaseA0(p, l);
    xcd_barrier(xb);
    phaseA1(p, l, smem);
    xcd_barrier(xb);
    conv_items(p, l);
    r1_items(p, l, smem);
    xcd_barrier(xb);
    for (int rep = 0; rep < REP_B2; ++rep)
    for (int it = vblock(); it < 1024 + 1024 + 2048 + 256 + 512 + 4096; it += gridDim.x) {
      if (it < 1024) r2_item<false>(p, l, it);
      else if (it < 2048) { const int i = it - 1024; attn_item<false>(p, l, false, i >> 7, (i >> 6) & 1, i & 63, smem); }
      else if (it < 4096) { const int i = it - 2048; attn_item<true>(p, l, false, i >> 8, (i >> 6) & 3, i & 63, smem); }
      else if (it < 4352) { const int i = it - 4096; attn_item<false>(p, l, true, i >> 3, (i >> 2) & 1, i & 3, smem); }
      else if (it < 4864) { const int i = it - 4352; attn_item<true>(p, l, true, i >> 4, (i >> 2) & 3, i & 3, smem); }
      else r2_item<true>(p, l, it - 4864);
    }
    xcd_barrier(xb);
    for (int it = vblock(); it < 1280; it += gridDim.x) r3_item(p, l, it, smem);
    xcd_barrier(xb);
    phaseC(p, l, smem);
    xcd_barrier(xb);
    phaseD(p, l, smem);
    xcd_barrier(xb);
  }
  phaseFinal(p);
}

extern "C" void kernel_launch(void* const* d_in, const int* in_sizes, int n_in, void* d_out, int out_size, void* d_ws, size_t ws_size,
                              hipStream_t stream) {
  static int grid_blocks = 0;
  if (!grid_blocks) {
    int dev = 0, cus = 0, per_cu = 0;
    (void)hipGetDevice(&dev);
    (void)hipDeviceGetAttribute(&cus, hipDeviceAttributeMultiprocessorCount, dev);
    (void)hipOccupancyMaxActiveBlocksPerMultiprocessor(&per_cu, hybrid_megakernel, 256, 0);
    if (per_cu > 2) per_cu = 2;
    if (per_cu < 1) per_cu = 1;
    grid_blocks = cus * per_cu;
  }
  Params p{};
  const float** fin = (const float**)&p.x_prompt;
  for (int i = 0; i < 23; ++i) fin[i] = (const float*)d_in[i];
  p.out = (float*)d_out;
  unsigned char* wsp = (unsigned char*)d_ws;
  size_t off = 0;
  auto take = [&](size_t bytes) { void* r = wsp + off; off += (bytes + 255) & ~(size_t)255; return r; };
  p.WinT = (u16*)take(2ull * 3840 * 1024 * 2);
  p.WgT = (u16*)take(2ull * 4096 * 1024 * 2);
  p.WbT = (u16*)take(2ull * 1024 * 1024 * 2);
  p.WoT = (u16*)take(2ull * 1024 * 1024 * 2);
  p.mod = (float*)take(2ull * 9 * 3072 * 4);
  p.rope = (float*)take(64ull * 16 * 2 * 4);
  p.H = (u16*)take((size_t)MT * 1024 * 2);
  p.Z = (u16*)take((size_t)MT * INW * 2);
  p.KG = (u16*)take(8ull * NKL * 128 * 2);
  p.VtG = (u16*)take(8ull * 2 * 64 * NKL * 2);
  p.KD = (u16*)take(8ull * NKL * 256 * 2);
  p.VtD = (u16*)take(8ull * 4 * 64 * NKL * 2);
  p.VtGc = (u16*)take(32ull * 2 * 64 * 256 * 2);
  p.VtDc = (u16*)take(32ull * 4 * 64 * 256 * 2);
  p.VtRc = (u16*)take(32ull * 4 * 64 * 256 * 2);
  p.VtRl = (u16*)take(8ull * 4 * 64 * 4096 * 2);
  p.U = (float*)take(1280ull * 2 * 4096 * 4);
  p.SinT = (u16*)take(1280ull * 2 * 4096 * 2);
  p.Y = (u16*)take((size_t)MT * 1024 * 2);
  p.bar = (unsigned*)take(XCD_BAR_WORDS * 4);
  if (off > ws_size) { fprintf(stderr, "workspace too small: need %zu have %zu\n", off, ws_size); return; }
  (void)hipMemsetAsync(p.bar, 0, XCD_BAR_WORDS * 4, stream);
  void* args[] = {&p};
  hipError_t e = hipLaunchCooperativeKernel((void*)hybrid_megakernel, dim3(grid_blocks), dim3(256), args, 0, stream);
  if (e != hipSuccess) fprintf(stderr, "cooperative launch failed: %s (grid %d)\n", hipGetErrorString(e), grid_blocks);
}
```

```cpp
#include <hip/hip_runtime.h>
#include <hip/hip_bf16.h>
#include <hip/hip_cooperative_groups.h>
#include <cstdio>
namespace cg = cooperative_groups;

typedef unsigned short u16;
using bf16x8 = __attribute__((ext_vector_type(8))) short;
using f32x16 = __attribute__((ext_vector_type(16))) float;
using u32x4 = __attribute__((ext_vector_type(4))) unsigned;
using u32x2 = __attribute__((ext_vector_type(2))) unsigned;

#define DI __device__ __forceinline__
#define MFMA32(a, b, c) __builtin_amdgcn_mfma_f32_32x32x16_bf16((a), (b), (c), 0, 0, 0)

#ifndef REP_A1
#define REP_A1 1
#endif
#ifndef REP_B2
#define REP_B2 1
#endif
#ifndef PIPE_C
#define PIPE_C true
#endif
constexpr int DM = 1024;
constexpr int INW = 3840;
constexpr int MC = 8192;
constexpr int MT = 40960;
constexpr int NKL = 4608;
constexpr int LSTR = 72;
constexpr float EPSN = 1e-6f;
constexpr int SMEM_BYTES = 2 * 2 * 128 * LSTR * 2;

constexpr size_t OUT_GK = 41943040ull;
constexpr size_t OUT_GV = 44040192ull;
constexpr size_t OUT_DK = 46137344ull;
constexpr size_t OUT_DV = 50331648ull;
constexpr size_t OUT_ST = 54525952ull;

constexpr size_t OFF_WinT = 0ull;
constexpr size_t OFF_WgT = 15728640ull;
constexpr size_t OFF_WbT = 32505856ull;
constexpr size_t OFF_WoT = 36700160ull;
constexpr size_t OFF_mod = 40894464ull;
constexpr size_t OFF_rope = 41115648ull;
constexpr size_t OFF_H = 41123840ull;
constexpr size_t OFF_Z = 125009920ull;
constexpr size_t OFF_KG = 439582720ull;
constexpr size_t OFF_VtG = 449019904ull;
constexpr size_t OFF_KD = 458457088ull;
constexpr size_t OFF_VtD = 477331456ull;
constexpr size_t OFF_VtGc = 496205824ull;
constexpr size_t OFF_VtDc = 498302976ull;
constexpr size_t OFF_VtRc = 502497280ull;
constexpr size_t OFF_VtRl = 506691584ull;
constexpr size_t OFF_U = 523468800ull;
constexpr size_t OFF_SinT = 565411840ull;
constexpr size_t OFF_Y = 586383360ull;
constexpr size_t OFF_bar = 670269440ull;
constexpr size_t WS_NEED = 670283264ull;
struct Params {
  const float *x_prompt, *x_sample, *cache_gk, *cache_gv, *cache_dk, *cache_dv, *state_ret, *c, *c_ctx, *w_ada, *b_ada,
      *norm_gain, *w_in, *conv_w, *q_gain, *k_gain, *ret_decay, *diff_lambda, *diff_gain, *w_branch, *w_mgate, *w_out, *final_gain;
  float* out;
  unsigned char* ws;
};

typedef float f32x2 __attribute__((ext_vector_type(2)));
typedef __bf16 bf16x2_t __attribute__((ext_vector_type(2)));
typedef const Params __attribute__((address_space(4))) CPar;
DI CPar& PP() { CPar* q = (CPar*)__builtin_amdgcn_kernarg_segment_ptr(); asm volatile("" : "+s"(q)); return *q; }
DI unsigned pack2(float a, float b) {
  const f32x2 v = {a, b};
  return __builtin_bit_cast(unsigned, __builtin_convertvector(v, bf16x2_t));
}
DI u16 f2bf(float a) { return (u16)(pack2(a, 0.f) & 0xffffu); }
DI float bflo(unsigned v) { return __uint_as_float(v << 16); }
DI float bfhi(unsigned v) { return __uint_as_float(v & 0xffff0000u); }
DI float silu_f(float x) { return x / (1.f + __expf(-x)); }
DI float sigmoid_f(float x) { return 1.f / (1.f + __expf(-x)); }
DI f32x16 zero16() { f32x16 z; _Pragma("unroll") for (int i = 0; i < 16; ++i) z[i] = 0.f; return z; }
DI int otid() { int t = (int)__builtin_amdgcn_workitem_id_x(); asm volatile("" : "+v"(t)); return t; }
DI int vblock() { const int b = (int)blockIdx.x, g = (int)gridDim.x; return ((g & 7) == 0) ? (b & 7) * (g >> 3) + (b >> 3) : b; }
DI size_t tix(int r, int k, int ksl) { return ((size_t)((r >> 7) * ksl + (k >> 5)) << 12) + ((r & 127) << 5) + (k & 31); }
#define XB_TMO      128
#define XB_XCNT(j)  (256  + 64 * (j))
#define XB_XSUB(j)  (1280 + 64 * (j))
#define XB_XGEN(j)  (2304 + 64 * (j))
#define XB_TOP      3328
#define XB_TOPGEN   3392
#define XCD_BAR_WORDS 3456
#define XB_SPIN_CAP (1u << 18)
#define LAS __attribute__((address_space(3)))

__device__ __forceinline__ unsigned xb_ld(unsigned* p)              { return __hip_atomic_load(p, __ATOMIC_RELAXED, __HIP_MEMORY_SCOPE_AGENT); }
__device__ __forceinline__ unsigned xb_add(unsigned* p, unsigned v) { return __hip_atomic_fetch_add(p, v, __ATOMIC_RELAXED, __HIP_MEMORY_SCOPE_AGENT); }
__device__ __forceinline__ unsigned xb_xcc_id() { return (unsigned)__builtin_amdgcn_s_getreg((3 << 11) | 20) & 0xFu; }
#define XB_SPIN(cond, bar) do { unsigned _sp = 0; while (cond) { __builtin_amdgcn_s_sleep(1); \
    if ((++_sp & 255u) == 0u) { if (xb_ld(&(bar)[XB_TMO])) break; if (_sp > XB_SPIN_CAP) { atomicAdd(&(bar)[XB_TMO], 1u); break; } } } } while (0)

struct XcdBarrier {
    unsigned* bar; unsigned x;
    volatile LAS unsigned* st;
};

__device__ __forceinline__ XcdBarrier xcd_barrier_post(unsigned* bar, volatile LAS unsigned* st) {
    XcdBarrier b; b.bar = bar; b.x = xb_xcc_id(); b.st = st;
    if (threadIdx.x == 0) (void)xb_add(&bar[XB_XCNT(b.x)], 1u);
    return b;
}
__device__ __forceinline__ void xcd_barrier_complete(unsigned* bar, unsigned x, unsigned& nloc, unsigned& nx) {
    const unsigned G = gridDim.x * gridDim.y * gridDim.z;
    unsigned sum, cnt, mine, sp = 0u;
    for (;;) {
        sum = 0u; cnt = 0u; mine = 0u;
#pragma unroll
        for (unsigned j = 0; j < 16; ++j) { const unsigned c = xb_ld(&bar[XB_XCNT(j)]); sum += c; cnt += (c > 0u) ? 1u : 0u; mine = (j == x) ? c : mine; }
        if (sum == G) break;
        __builtin_amdgcn_s_sleep(1);
        if ((++sp & 255u) == 0u) { if (xb_ld(&bar[XB_TMO])) break; if (sp > XB_SPIN_CAP) { atomicAdd(&bar[XB_TMO], 1u); break; } }
    }
    nloc = mine > 0u ? mine : 1u; nx = cnt > 0u ? cnt : 1u;
}

__device__ __forceinline__ void xcd_barrier(const XcdBarrier& b) {
    asm volatile("s_waitcnt vmcnt(0)" ::: "memory");
    __syncthreads();
    if (threadIdx.x == 0) {
        unsigned* bar = b.bar;
        __builtin_amdgcn_s_waitcnt(0);
        unsigned nloc = b.st[0], nx = b.st[1];
        if (nloc == 0u) { xcd_barrier_complete(bar, b.x, nloc, nx); b.st[0] = nloc; b.st[1] = nx; }
        const unsigned old = xb_add(&bar[XB_XSUB(b.x)], 1u);
        const unsigned gen = old / nloc;
        if (old + 1u == (gen + 1u) * nloc) {
            __builtin_amdgcn_fence(__ATOMIC_RELEASE, "agent");
            asm volatile("s_waitcnt vmcnt(0)" ::: "memory");
            const unsigned og = xb_add(&bar[XB_TOP], 1u);
            const unsigned tg = og / nx;
            if (og + 1u == (tg + 1u) * nx) xb_add(&bar[XB_TOPGEN], 1u);
            else XB_SPIN(xb_ld(&bar[XB_TOPGEN]) == tg, bar);
            __builtin_amdgcn_fence(__ATOMIC_ACQUIRE, "agent");
            xb_add(&bar[XB_XGEN(b.x)], 1u);
            asm volatile("s_waitcnt vmcnt(0)" ::: "memory");
        } else {
            XB_SPIN(xb_ld(&bar[XB_XGEN(b.x)]) == gen, bar);
            __builtin_amdgcn_fence(__ATOMIC_ACQUIRE, "agent");
            asm volatile("s_waitcnt vmcnt(0)" ::: "memory");
        }
    }
    __syncthreads();
}


DI int kperm(int t) { return (t & ~12) | ((t & 4) << 1) | ((t & 8) >> 1); }
DI float wave_sum(float v) {
  _Pragma("unroll") for (int o = 1; o < 64; o <<= 1) v += __shfl_xor(v, o);
  return v;
}

#define VMWAIT(N) asm volatile("s_waitcnt vmcnt(" #N ")" ::: "memory")
#define RAW_BARRIER() do { asm volatile("s_waitcnt lgkmcnt(0)" ::: "memory"); __builtin_amdgcn_s_barrier(); } while (0)
template <int TB, bool BMAP = false>
DI void gemm_acc(const u16* __restrict__ A, const u16* __restrict__ B, int bstride, int nk, f32x16 (&acc)[2][TB], u16* sm) {
  const int tid = otid(), lane = tid & 63, w = tid >> 6, wn = w >> 1, wt = w & 1, l31 = lane & 31, hf = lane >> 5;
  constexpr int NSTG = (TB == 2) ? 4 : 3;
  constexpr int RB = 64 * TB;
  constexpr int STGB = (128 + RB) * 64;
  constexpr int LPB = RB / 64;
  const int lr = tid >> 2, gsl = (tid & 3) ^ ((lr >> 2) & 3);
  const u16* ga = A + lr * 32 + gsl * 8;
  const u16* gb = B + lr * 32 + gsl * 8;
  char* smb = (char*)sm;
  const int wv = __builtin_amdgcn_readfirstlane(w);
  char* smw = smb + wv * 1024;
  const u16* pa[2];
  const u16* pb[LPB];
  _Pragma("unroll") for (int i = 0; i < 2; ++i) pa[i] = ga + 2048 * i;
  _Pragma("unroll") for (int i = 0; i < LPB; ++i) pb[i] = BMAP ? gb + (size_t)(i & 1) * bstride + 2048 * (i >> 1) : gb + (size_t)(i >> 1) * bstride + 2048 * (i & 1);
#define GEMM_STAGE(ST) do { \
    _Pragma("unroll") for (int i = 0; i < 2; ++i) { \
      __builtin_amdgcn_global_load_lds((const unsigned*)pa[i], (unsigned*)(smw + (ST) * STGB + i * 4096), 16, 0, 0); pa[i] += 4096; } \
    _Pragma("unroll") for (int i = 0; i < LPB; ++i) { \
      __builtin_amdgcn_global_load_lds((const unsigned*)pb[i], (unsigned*)(smw + (ST) * STGB + 8192 + i * 4096), 16, 0, 0); pb[i] += 4096; } \
  } while (0)
  VMWAIT(0);
  _Pragma("unroll") for (int s0 = 0; s0 < NSTG - 1; ++s0) GEMM_STAGE(s0);
  const int sw = (l31 >> 2) & 3;
  const int oa0 = (wn * 64 + l31) * 64 + ((hf ^ sw) << 4), oa1 = (wn * 64 + l31) * 64 + (((2 + hf) ^ sw) << 4);
  const int ob0 = 8192 + (wt * 32 * TB + l31) * 64 + ((hf ^ sw) << 4), ob1 = 8192 + (wt * 32 * TB + l31) * 64 + (((2 + hf) ^ sw) << 4);
  int st = 0, stn = NSTG - 1;
  for (int kt = 0; kt < nk; ++kt) {
    if (kt + NSTG - 2 < nk) { if (TB == 2) VMWAIT(8); else VMWAIT(6); }
    else if (NSTG == 4 && kt + 1 < nk) VMWAIT(4);
    else VMWAIT(0);
    RAW_BARRIER();
    if (kt + NSTG - 1 < nk) GEMM_STAGE(stn);
    __builtin_amdgcn_sched_barrier(0);
    const char* sb = smb + st * STGB;
    if (!BMAP) {
      bf16x8 fa[2][2], fb[2][TB];
      _Pragma("unroll") for (int a = 0; a < 2; ++a) fa[0][a] = *(const bf16x8*)(sb + oa0 + a * 2048);
      _Pragma("unroll") for (int b = 0; b < TB; ++b) fb[0][b] = *(const bf16x8*)(sb + ob0 + b * 2048);
      _Pragma("unroll") for (int a = 0; a < 2; ++a) fa[1][a] = *(const bf16x8*)(sb + oa1 + a * 2048);
      _Pragma("unroll") for (int b = 0; b < TB; ++b) fb[1][b] = *(const bf16x8*)(sb + ob1 + b * 2048);
      __builtin_amdgcn_sched_barrier(0);
      _Pragma("unroll") for (int ks = 0; ks < 2; ++ks) {
        _Pragma("unroll") for (int a = 0; a < 2; ++a)
          _Pragma("unroll") for (int b = 0; b < TB; ++b) acc[a][b] = MFMA32(fa[ks][a], fb[ks][b], acc[a][b]);
        __builtin_amdgcn_sched_barrier(0);
      }
    } else {
      _Pragma("unroll") for (int ks = 0; ks < 2; ++ks) {
        bf16x8 fa[2], fb[TB];
        _Pragma("unroll") for (int a = 0; a < 2; ++a) fa[a] = *(const bf16x8*)(sb + (ks ? oa1 : oa0) + a * 2048);
        _Pragma("unroll") for (int b = 0; b < TB; ++b) fb[b] = *(const bf16x8*)(sb + (ks ? ob1 : ob0) + b * 2048);
        __builtin_amdgcn_sched_barrier(0);
        _Pragma("unroll") for (int a = 0; a < 2; ++a)
          _Pragma("unroll") for (int b = 0; b < TB; ++b) acc[a][b] = MFMA32(fa[a], fb[b], acc[a][b]);
        __builtin_amdgcn_sched_barrier(0);
      }
    }
    st = (st + 1 == NSTG) ? 0 : st + 1;
    stn = (stn + 1 == NSTG) ? 0 : stn + 1;
  }
  RAW_BARRIER();
#undef GEMM_STAGE
}

DI void phase0(CPar& p, unsigned char* smem) {
  const int tid = otid();
  float* tile = (float*)smem;
  for (int job = blockIdx.x; job < 4992; job += gridDim.x) {
    const int l = job / 2496;
    int rem = job - l * 2496;
    const float* src; u16* dst; int C;
    if (rem < 960) { src = p.w_in + (size_t)l * 1024 * 3840; dst = ((u16*)(p.ws + OFF_WinT)) + (size_t)l * 3840 * 1024; C = 3840; }
    else if (rem < 1984) { rem -= 960; src = p.w_mgate + (size_t)l * 1024 * 4096; dst = ((u16*)(p.ws + OFF_WgT)) + (size_t)l * 4096 * 1024; C = 4096; }
    else if (rem < 2240) { rem -= 1984; src = p.w_branch + (size_t)l * 1024 * 1024; dst = ((u16*)(p.ws + OFF_WbT)) + (size_t)l * 1024 * 1024; C = 1024; }
    else { rem -= 2240; src = p.w_out + (size_t)l * 1024 * 1024; dst = ((u16*)(p.ws + OFF_WoT)) + (size_t)l * 1024 * 1024; C = 1024; }
    const int tr = rem & 15, tc = rem >> 4;
    const int r0 = tr * 64, c0 = tc * 64;
    __syncthreads();
    _Pragma("unroll") for (int i = 0; i < 4; ++i) {
      const int rr = (tid >> 4) + 16 * i, cc = (tid & 15) * 4;
      const float4 v = *(const float4*)(src + (size_t)(r0 + rr) * C + c0 + cc);
      tile[rr * 65 + cc + 0] = v.x; tile[rr * 65 + cc + 1] = v.y; tile[rr * 65 + cc + 2] = v.z; tile[rr * 65 + cc + 3] = v.w;
    }
    __syncthreads();
    {
      const int n = tid >> 2, kq = (tid & 3) * 16;
      unsigned wv[8];
      _Pragma("unroll") for (int j = 0; j < 8; ++j) wv[j] = pack2(tile[(kq + 2 * j) * 65 + n], tile[(kq + 2 * j + 1) * 65 + n]);
      u16* d = dst + tix(c0 + n, r0 + kq, 32);
      *(uint4*)d = make_uint4(wv[0], wv[1], wv[2], wv[3]);
      *(uint4*)(d + 8) = make_uint4(wv[4], wv[5], wv[6], wv[7]);
    }
  }
  __syncthreads();
  if (blockIdx.x < 384) {
  {
    float* sc = (float*)smem;
    float* red = sc + 9 * 1024;
    for (int i = tid; i < 9 * 1024; i += 256) {
      const int j = i >> 10, k = i & 1023;
      const float cv = (j == 0) ? p.c_ctx[k] : p.c[(j - 1) * 1024 + k];
      sc[i] = silu_f(cv);
    }
    __syncthreads();
    for (int item = blockIdx.x; item < 384; item += gridDim.x) {
    const int lane = tid & 63, w = tid >> 6;
    const int l = item / 192, n = (item % 192) * 16 + (lane & 15);
    const int kbeg = (w * 4 + (lane >> 4)) * 64;
    float acc[9];
    _Pragma("unroll") for (int j = 0; j < 9; ++j) acc[j] = 0.f;
    const float* wp = p.w_ada + (size_t)l * 1024 * 3072 + n;
    for (int k = kbeg; k < kbeg + 64; k += 8) {
      float wv[8];
      _Pragma("unroll") for (int u = 0; u < 8; ++u) wv[u] = wp[(size_t)(k + u) * 3072];
      _Pragma("unroll") for (int u = 0; u < 8; ++u)
        _Pragma("unroll") for (int j = 0; j < 9; ++j) acc[j] += sc[j * 1024 + k + u] * wv[u];
    }
    _Pragma("unroll") for (int j = 0; j < 9; ++j) {
      acc[j] += __shfl_xor(acc[j], 16);
      acc[j] += __shfl_xor(acc[j], 32);
    }
    if (lane < 16) {
      _Pragma("unroll") for (int j = 0; j < 9; ++j) red[(w * 9 + j) * 16 + lane] = acc[j];
    }
    __syncthreads();
    if (tid < 144) {
      const int j = tid >> 4, nn = tid & 15;
      const int n2 = (item % 192) * 16 + nn;
      const float v = red[(0 * 9 + j) * 16 + nn] + red[(1 * 9 + j) * 16 + nn] + red[(2 * 9 + j) * 16 + nn] + red[(3 * 9 + j) * 16 + nn];
      ((float*)(p.ws + OFF_mod))[(l * 9 + j) * 3072 + n2] = v + p.b_ada[l * 3072 + n2];
    }
    __syncthreads();
    }
  }
  }
  if (blockIdx.x == gridDim.x - 1) {
    for (int i = tid; i < 1024; i += 256) {
      const int pos = i >> 4, f = i & 15;
      const float inv = powf(10000.f, -(float)f / 16.f);
      const float ang = (float)pos * inv;
      ((float*)(p.ws + OFF_rope))[2 * i] = cosf(ang);
      ((float*)(p.ws + OFF_rope))[2 * i + 1] = sinf(ang);
    }
  }
}

DI void phaseA0(CPar& p, int l) {
  const int tid = otid(), lane = tid & 63;
  const int gw = blockIdx.x * 4 + (tid >> 6), nw = gridDim.x * 4;
  const float* ng = p.norm_gain + l * 1024;
  for (int row = gw; row < MT; row += nw) {
    const float* xr = (l == 0) ? (row < MC ? p.x_prompt + (size_t)row * 1024 : p.x_sample + (size_t)(row - MC) * 1024)
                               : p.out + (size_t)row * 1024;
    float4 v[4];
    float ss = 0.f;
    _Pragma("unroll") for (int i = 0; i < 4; ++i) {
      v[i] = ((const float4*)xr)[lane + 64 * i];
      ss += v[i].x * v[i].x + v[i].y * v[i].y + v[i].z * v[i].z + v[i].w * v[i].w;
    }
    ss = wave_sum(ss);
    const float rstd = rsqrtf(ss * (1.f / 1024.f) + EPSN);
    const int j = row < MC ? 0 : 1 + ((row - MC) >> 12);
    const float* shift = ((float*)(p.ws + OFF_mod)) + (l * 9 + j) * 3072;
    const float* scale = shift + 1024;
    _Pragma("unroll") for (int i = 0; i < 4; ++i) {
      const int k = 4 * (lane + 64 * i);
      const float4 g = *(const float4*)(ng + k);
      const float4 s = *(const float4*)(scale + k);
      const float4 sh = *(const float4*)(shift + k);
      const float h0 = v[i].x * rstd * g.x * (1.f + s.x) + sh.x;
      const float h1 = v[i].y * rstd * g.y * (1.f + s.y) + sh.y;
      const float h2 = v[i].z * rstd * g.z * (1.f + s.z) + sh.z;
      const float h3 = v[i].w * rstd * g.w * (1.f + s.w) + sh.w;
      *(uint2*)(((u16*)(p.ws + OFF_H)) + tix(row, k, 32)) = make_uint2(pack2(h0, h1), pack2(h2, h3));
    }
  }
  const int gt = blockIdx.x * 256 + tid, nt = gridDim.x * 256;
  for (int idx = gt; idx < 8 * 65536; idx += nt) {
    const int b = idx >> 16, rem = idx & 65535;
    ((u16*)(p.ws + OFF_KG))[(size_t)b * NKL * 128 + rem] = f2bf(p.cache_gk[(size_t)(b * 2 + l) * 65536 + rem]);
  }
  for (int idx = gt; idx < 8 * 131072; idx += nt) {
    const int b = idx >> 17, rem = idx & 131071;
    ((u16*)(p.ws + OFF_KD))[(size_t)b * NKL * 256 + rem] = f2bf(p.cache_dk[(size_t)(b * 2 + l) * 131072 + rem]);
  }
  for (int idx = gt; idx < 8 * 2 * 64 * 512; idx += nt) {
    const int pk = idx & 511, dv = (idx >> 9) & 63, g = (idx >> 15) & 1, b = idx >> 16;
    ((u16*)(p.ws + OFF_VtG))[((size_t)(b * 2 + g) * 64 + dv) * NKL + kperm(pk)] = f2bf(p.cache_gv[((size_t)(b * 2 + l) * 512 + pk) * 128 + g * 64 + dv]);
  }
  for (int idx = gt; idx < 8 * 4 * 64 * 512; idx += nt) {
    const int pk = idx & 511, dv = (idx >> 9) & 63, h = (idx >> 15) & 3, b = idx >> 17;
    ((u16*)(p.ws + OFF_VtD))[((size_t)(b * 4 + h) * 64 + dv) * NKL + kperm(pk)] = f2bf(p.cache_dv[((size_t)(b * 2 + l) * 512 + pk) * 256 + h * 64 + dv]);
  }
}

#define NLOC(a, r) ((a) * 32 + 8 * ((r) >> 2) + 4 * hf + ((r) & 3))

template <int NB>
DI void a1_epilogue(CPar& p, int l, int nbase, int m0w, f32x16 (&acc)[2][NB], unsigned char* smem) {
  const int lane = otid() & 63, l31 = lane & 31, hf = lane >> 5;
  u16* stg = (u16*)smem + (otid() >> 6) * (32 * 68);
  _Pragma("unroll") for (int b = 0; b < NB; ++b) {
    const int m = m0w + b * 32 + l31;
    const bool ctx = m < MC;
    int bb, t;
    if (ctx) { bb = m >> 8; t = m & 255; } else { const int ml = m - MC; bb = ml >> 12; t = ml & 4095; }
    float v[2][16];
    _Pragma("unroll") for (int a = 0; a < 2; ++a)
      _Pragma("unroll") for (int r = 0; r < 16; ++r) v[a][r] = acc[a][b][r];

    auto rmsn = [&](const float* gain) {
      float ss = 0.f;
      _Pragma("unroll") for (int a = 0; a < 2; ++a)
        _Pragma("unroll") for (int r = 0; r < 16; ++r) ss += v[a][r] * v[a][r];
      ss += __shfl_xor(ss, 32);
      const float rinv = rsqrtf(ss * (1.f / 64.f) + EPSN);
      _Pragma("unroll") for (int a = 0; a < 2; ++a)
        _Pragma("unroll") for (int i = 0; i < 4; ++i) {
          const float4 g = *(const float4*)(gain + a * 32 + 8 * i + 4 * hf);
          v[a][4 * i + 0] *= rinv * g.x; v[a][4 * i + 1] *= rinv * g.y; v[a][4 * i + 2] *= rinv * g.z; v[a][4 * i + 3] *= rinv * g.w;
        }
    };
    auto rope64 = [&]() {
      const int trow = t >> 6, tcol = t & 63;
      const float2* rp = (const float2*)((float*)(p.ws + OFF_rope));
      _Pragma("unroll") for (int r = 0; r < 16; ++r) {
        const int j = 8 * (r >> 2) + 4 * hf + (r & 3);
        const int pos = ((r >> 2) < 2) ? trow : tcol;
        const float2 cs = rp[pos * 16 + (j & 15)];
        const float x1 = v[0][r], x2 = v[1][r];
        v[0][r] = x1 * cs.x - x2 * cs.y;
        v[1][r] = x1 * cs.y + x2 * cs.x;
      }
    };
    auto rope32 = [&]() {
      const int trow = t >> 6, tcol = t & 63;
      const float2* rp = (const float2*)((float*)(p.ws + OFF_rope));
      _Pragma("unroll") for (int a = 0; a < 2; ++a)
        _Pragma("unroll") for (int r = 0; r < 8; ++r) {
          const int j = 8 * (r >> 2) + 4 * hf + (r & 3);
          const int pos = ((r >> 2) == 0) ? trow : tcol;
          const float2 cs = rp[pos * 16 + 2 * (j & 7)];
          const float x1 = v[a][r], x2 = v[a][r + 8];
          v[a][r] = x1 * cs.x - x2 * cs.y;
          v[a][r + 8] = x1 * cs.y + x2 * cs.x;
        }
    };
    auto store_nat = [&](u16* dst) {
      _Pragma("unroll") for (int a = 0; a < 2; ++a)
        _Pragma("unroll") for (int i = 0; i < 4; ++i)
          *(uint2*)(stg + l31 * 68 + a * 32 + 8 * i + 4 * hf) = make_uint2(pack2(v[a][4 * i], v[a][4 * i + 1]), pack2(v[a][4 * i + 2], v[a][4 * i + 3]));
      const unsigned long long dp = (unsigned long long)dst;
      _Pragma("unroll") for (int j = 0; j < 8; ++j) {
        const int row = (lane >> 4) + 4 * j;
        const unsigned lo = __shfl((unsigned)dp, row), hi = __shfl((unsigned)(dp >> 32), row);
        u16* rp = (u16*)(((unsigned long long)hi << 32) | lo);
        const uint2 val = *(const uint2*)(stg + row * 68 + (lane & 15) * 4);
        *(uint2*)(rp + (lane & 15) * 4) = val;
      }
    };
    auto store_f32 = [&](float* dst) {
      _Pragma("unroll") for (int a = 0; a < 2; ++a)
        _Pragma("unroll") for (int i = 0; i < 4; ++i)
          *(float4*)(dst + a * 32 + 8 * i + 4 * hf) = make_float4(v[a][4 * i], v[a][4 * i + 1], v[a][4 * i + 2], v[a][4 * i + 3]);
    };
    auto store_T = [&](u16* dst, int ld) {
      _Pragma("unroll") for (int a = 0; a < 2; ++a)
        _Pragma("unroll") for (int r = 0; r < 16; ++r) dst[(size_t)NLOC(a, r) * ld] = f2bf(v[a][r]);
    };

    u16* zrow = ((u16*)(p.ws + OFF_Z)) + (size_t)m * INW + nbase;
    if (nbase < 1024) {
      store_nat(zrow);
    } else if (nbase < 1280) {
      rmsn(p.q_gain + l * 64);
      if (!ctx) rope64();
      store_nat(zrow);
    } else if (nbase < 1408) {
      const int kvh = (nbase - 1280) >> 6;
      rmsn(p.k_gain + l * 64);
      if (ctx) {
        store_f32(p.out + OUT_GK + ((size_t)(bb * 2 + l) * 256 + t) * 128 + kvh * 64);
        store_nat(zrow);
      } else {
        rope64();
        store_nat(((u16*)(p.ws + OFF_KG)) + ((size_t)bb * NKL + 512 + t) * 128 + kvh * 64);
      }
    } else if (nbase < 1536) {
      const int kvh = (nbase - 1408) >> 6;
      if (ctx) {
        store_f32(p.out + OUT_GV + ((size_t)(bb * 2 + l) * 256 + t) * 128 + kvh * 64);
        store_T(((u16*)(p.ws + OFF_VtGc)) + ((size_t)(bb * 2 + kvh) * 64) * 256 + kperm(t), 256);
      } else {
        store_T(((u16*)(p.ws + OFF_VtG)) + ((size_t)(bb * 2 + kvh) * 64) * NKL + 512 + kperm(t), NKL);
      }
    } else if (nbase < 2048) {
      store_nat(zrow);
    } else if (nbase < 2304) {
      _Pragma("unroll") for (int a = 0; a < 2; ++a)
        _Pragma("unroll") for (int r = 0; r < 16; ++r) v[a][r] *= 0.125f;
      store_nat(zrow);
    } else if (nbase < 2560) {
      const int hh = (nbase - 2304) >> 6;
      store_nat(zrow);
      if (ctx) store_T(((u16*)(p.ws + OFF_VtRc)) + ((size_t)(bb * 4 + hh) * 64) * 256 + kperm(t), 256);
      else store_T(((u16*)(p.ws + OFF_VtRl)) + ((size_t)(bb * 4 + hh) * 64) * 4096 + kperm(t), 4096);
    } else if (nbase < 2816) {
      store_nat(zrow);
    } else if (nbase < 3072) {
      if (!ctx) rope32();
      store_nat(zrow);
    } else if (nbase < 3328) {
      const int cb = nbase - 3072;
      if (ctx) {
        store_f32(p.out + OUT_DK + ((size_t)(bb * 2 + l) * 256 + t) * 256 + cb);
        store_nat(zrow);
      } else {
        rope32();
        store_nat(((u16*)(p.ws + OFF_KD)) + ((size_t)bb * NKL + 512 + t) * 256 + cb);
      }
    } else if (nbase < 3584) {
      const int cb = nbase - 3328, hh = cb >> 6;
      if (ctx) {
        store_f32(p.out + OUT_DV + ((size_t)(bb * 2 + l) * 256 + t) * 256 + cb);
        store_T(((u16*)(p.ws + OFF_VtDc)) + ((size_t)(bb * 4 + hh) * 64) * 256 + kperm(t), 256);
      } else {
        store_T(((u16*)(p.ws + OFF_VtD)) + ((size_t)(bb * 4 + hh) * 64) * NKL + 512 + kperm(t), NKL);
      }
    } else {
      store_nat(zrow);
    }
  }
}

DI void phaseA1(CPar& p, int l, unsigned char* smem) {
  const int w = otid() >> 6, wn = w >> 1, wt = w & 1;
  for (int tile = vblock(); tile < 30 * 160; tile += gridDim.x) {
    const int grp = tile / 800, rem = tile - grp * 800;
    const int tm = rem / 5, tn = grp * 5 + (rem - tm * 5);
    f32x16 acc[2][4];
    _Pragma("unroll") for (int a = 0; a < 2; ++a)
      _Pragma("unroll") for (int b = 0; b < 4; ++b) acc[a][b] = zero16();
    gemm_acc<4>(((u16*)(p.ws + OFF_WinT)) + (size_t)l * 3840 * 1024 + ((size_t)(tn * 32) << 12), ((u16*)(p.ws + OFF_H)) + ((size_t)(tm * 2 * 32) << 12), 32 * 4096, 32, acc, (u16*)smem);
    a1_epilogue<4>(p, l, tn * 128 + wn * 64, tm * 256 + wt * 128, acc, smem);
    __syncthreads();
  }
}

DI void ld8(const u16* ptr, float (&f)[8]) {
  const uint4 v = *(const uint4*)ptr;
  f[0] = bflo(v.x); f[1] = bfhi(v.x); f[2] = bflo(v.y); f[3] = bfhi(v.y);
  f[4] = bflo(v.z); f[5] = bfhi(v.z); f[6] = bflo(v.w); f[7] = bfhi(v.w);
}

DI void conv_items(CPar& p, int l) {
  const int gt = blockIdx.x * 256 + otid(), nt = gridDim.x * 256;
  const float* cw = p.conv_w + l * 768;
  for (int idx = gt; idx < MT * 32; idx += nt) {
    const int m = idx >> 5, c8 = (idx & 31) * 8;
    int t, T;
    if (m < MC) { t = m & 255; T = 256; } else { t = (m - MC) & 4095; T = 4096; }
    const u16* zr = ((u16*)(p.ws + OFF_Z)) + (size_t)m * INW + c8;
    float bg[8], gt8[8], cgc[8], uc[8], gp[8], gn[8];
    ld8(zr, bg); ld8(zr + 768, gt8); ld8(zr + 256, cgc); ld8(zr + 512, uc);
    if (t > 0) { float a[8], b[8]; ld8(zr - INW + 256, a); ld8(zr - INW + 512, b); _Pragma("unroll") for (int i = 0; i < 8; ++i) gp[i] = a[i] * b[i]; }
    else { _Pragma("unroll") for (int i = 0; i < 8; ++i) gp[i] = 0.f; }
    if (t < T - 1) { float a[8], b[8]; ld8(zr + INW + 256, a); ld8(zr + INW + 512, b); _Pragma("unroll") for (int i = 0; i < 8; ++i) gn[i] = a[i] * b[i]; }
    else { _Pragma("unroll") for (int i = 0; i < 8; ++i) gn[i] = 0.f; }
    float y[8];
    _Pragma("unroll") for (int i = 0; i < 8; ++i) {
      const float w0 = cw[c8 + i], w1 = cw[256 + c8 + i], w2 = cw[512 + c8 + i];
      const float g = cgc[i] * uc[i];
      y[i] = bg[i] * (w0 * gp[i] + w1 * g + w2 * gn[i]) * silu_f(gt8[i]);
    }
    *(uint4*)(((u16*)(p.ws + OFF_Y)) + tix(m, c8, 32)) = make_uint4(pack2(y[0], y[1]), pack2(y[2], y[3]), pack2(y[4], y[5]), pack2(y[6], y[7]));
  }
}

DI float log_gamma(CPar& p, int l, int dir, int h) {
  const float x = p.ret_decay[(l * 2 + dir) * 4 + h];
  return -log1pf(expf(-x));
}

DI void ret_decode(int item, bool& ctx, int& bb, int& h, int& c, int& m0) {
  if (item < 256) { ctx = true; c = item & 1; h = (item >> 1) & 3; bb = item >> 3; m0 = bb * 256 + c * 128; }
  else { const int it = item - 256; ctx = false; c = it & 31; h = (it >> 5) & 3; bb = it >> 7; m0 = MC + bb * 4096 + c * 128; }
}

DI void r1_items(CPar& p, int l, unsigned char* smem) {
  const int tid = otid();
  u16* sK = (u16*)smem;
  u16* sV = sK + 128 * 64;
  float* wf = (float*)(sV + 128 * 64);
  float* wb = wf + 128;
  for (int item = blockIdx.x; item < 1280; item += gridDim.x) {
    bool ctx; int bb, h, c, m0;
    ret_decode(item, ctx, bb, h, c, m0);
    const float lgf = log_gamma(p, l, 0, h), lgb = log_gamma(p, l, 1, h);
    __syncthreads();
    _Pragma("unroll") for (int i = 0; i < 4; ++i) {
      const int cidx = tid + 256 * i, row = cidx >> 3, kc = cidx & 7;
      const u16* zr = ((u16*)(p.ws + OFF_Z)) + (size_t)(m0 + row) * INW + h * 64 + kc * 8;
      *(uint4*)(sK + row * 64 + kc * 8) = *(const uint4*)(zr + 2048);
      *(uint4*)(sV + row * 64 + kc * 8) = *(const uint4*)(zr + 2304);
    }
    if (tid < 128) { wf[tid] = expf(lgf * (float)(127 - tid)); wb[tid] = expf(lgb * (float)tid); }
    __syncthreads();
    const int dk0 = (tid >> 4) * 4, dv0 = (tid & 15) * 4;
    float uf[4][4], ub[4][4];
    _Pragma("unroll") for (int i = 0; i < 4; ++i)
      _Pragma("unroll") for (int j = 0; j < 4; ++j) { uf[i][j] = 0.f; ub[i][j] = 0.f; }
    for (int j = 0; j < 128; ++j) {
      const uint2 kv = *(const uint2*)(sK + j * 64 + dk0);
      const uint2 vv = *(const uint2*)(sV + j * 64 + dv0);
      const float k4[4] = {bflo(kv.x), bfhi(kv.x), bflo(kv.y), bfhi(kv.y)};
      const float v4[4] = {bflo(vv.x), bfhi(vv.x), bflo(vv.y), bfhi(vv.y)};
      const float a = wf[j], b = wb[j];
      _Pragma("unroll") for (int i = 0; i < 4; ++i) {
        const float kf = k4[i] * a, kb = k4[i] * b;
        _Pragma("unroll") for (int q = 0; q < 4; ++q) { uf[i][q] += kf * v4[q]; ub[i][q] += kb * v4[q]; }
      }
    }
    float* uo = ((float*)(p.ws + OFF_U)) + (size_t)item * 2 * 4096;
    _Pragma("unroll") for (int i = 0; i < 4; ++i) {
      *(float4*)(uo + (dk0 + i) * 64 + dv0) = make_float4(uf[i][0], uf[i][1], uf[i][2], uf[i][3]);
      *(float4*)(uo + 4096 + (dk0 + i) * 64 + dv0) = make_float4(ub[i][0], ub[i][1], ub[i][2], ub[i][3]);
    }
  }
}

template <bool CTX>
DI void r2_item(CPar& p, int l, int bi) {
  const int tid = otid();
  const int eb = bi & 15, dir = (bi >> 4) & 1, h = (bi >> 5) & 3, bb = bi >> 7;
  const int ep = eb * 256 + tid;
  const int dv = ep >> 6, dk = ep & 63;
  const int e = dk * 64 + dv;
  constexpr int nch = CTX ? 2 : 32;
  const int base = CTX ? (bb * 4 + h) * 2 : 256 + (bb * 4 + h) * 32;
  const float gC = expf(log_gamma(p, l, dir, h) * 128.f);
  float S = CTX ? 0.f : p.state_ret[((((size_t)bb * 2 + l) * 2 + dir) * 4 + h) * 4096 + e];
  float u[nch];
  _Pragma("unroll") for (int i = 0; i < nch; ++i) {
    const int c = dir ? (nch - 1 - i) : i;
    u[i] = ((float*)(p.ws + OFF_U))[((size_t)(base + c) * 2 + dir) * 4096 + e];
  }
  _Pragma("unroll") for (int i = 0; i < nch; ++i) {
    const int c = dir ? (nch - 1 - i) : i;
    ((u16*)(p.ws + OFF_SinT))[((size_t)(base + c) * 2 + dir) * 4096 + ep] = f2bf(S);
    S = S * gC + u[i];
  }
  if (CTX) p.out[OUT_ST + ((((size_t)bb * 2 + l) * 2 + dir) * 4 + h) * 4096 + e] = S;
}

template <bool DIFF>
DI void attn_item(CPar& p, int l, bool ctx, int bb, int unit, int qb, unsigned char* smem) {
  const int tid = otid(), lane = tid & 63, w = tid >> 6, l31 = lane & 31, hf = lane >> 5;
  const int qi = w & 1, qs = w >> 1;
  const int mq = (ctx ? bb * 256 : MC + bb * 4096) + qb * 64 + qs * 32 + l31;
  const int nkeys = ctx ? 256 : NKL;
  const u16* Kp; const u16* Vt; int ldk, ldv;
  if (!DIFF) {
    if (ctx) { Kp = ((u16*)(p.ws + OFF_Z)) + (size_t)(bb * 256) * INW + 1280 + unit * 64; ldk = INW; Vt = ((u16*)(p.ws + OFF_VtGc)) + ((size_t)(bb * 2 + unit) * 64) * 256; ldv = 256; }
    else { Kp = ((u16*)(p.ws + OFF_KG)) + (size_t)bb * NKL * 128 + unit * 64; ldk = 128; Vt = ((u16*)(p.ws + OFF_VtG)) + ((size_t)(bb * 2 + unit) * 64) * NKL; ldv = NKL; }
  } else {
    if (ctx) { Kp = ((u16*)(p.ws + OFF_Z)) + (size_t)(bb * 256) * INW + 3072 + unit * 64; ldk = INW; Vt = ((u16*)(p.ws + OFF_VtDc)) + ((size_t)(bb * 4 + unit) * 64) * 256; ldv = 256; }
    else { Kp = ((u16*)(p.ws + OFF_KD)) + (size_t)bb * NKL * 256 + unit * 64; ldk = 256; Vt = ((u16*)(p.ws + OFF_VtD)) + ((size_t)(bb * 4 + unit) * 64) * NKL; ldv = NKL; }
  }
  constexpr int NS = DIFF ? 2 : 4;
  bf16x8 qf[NS];
  {
    const u16* zq = ((u16*)(p.ws + OFF_Z)) + (size_t)mq * INW + (DIFF ? 2816 + unit * 64 + qi * 32 : 1024 + (unit * 2 + qi) * 64) + hf * 8;
    _Pragma("unroll") for (int s = 0; s < NS; ++s) qf[s] = *(const bf16x8*)(zq + s * 16);
  }
  const float sc = (DIFF ? 0.17677669529663687f : 0.125f) * 1.4426950408889634f;
  f32x16 O[2];
  O[0] = zero16(); O[1] = zero16();
  float mref = -1e30f, lsum = 0.f;

  char* smb = (char*)smem;
  constexpr int STGB = 16384;
  const int lr = tid >> 3, gch = (tid & 7) ^ ((lr >> 1) & 7);
  const u16* gk = Kp + (size_t)lr * ldk + gch * 8;
  const u16* gv = Vt + (size_t)lr * ldv + gch * 8;
  const int wv = __builtin_amdgcn_readfirstlane(w);
  char* smw = smb + wv * 1024;
  const u16* pk0 = gk; const u16* pk1 = gk + (size_t)32 * ldk;
  const u16* pv0 = gv; const u16* pv1 = gv + (size_t)32 * ldv;
  const size_t kstep = (size_t)64 * ldk;
#define ATT_STAGE(ST) do { \
    __builtin_amdgcn_global_load_lds((const unsigned*)pk0, (unsigned*)(smw + (ST) * STGB), 16, 0, 0); pk0 += kstep; \
    __builtin_amdgcn_global_load_lds((const unsigned*)pk1, (unsigned*)(smw + (ST) * STGB + 4096), 16, 0, 0); pk1 += kstep; \
    __builtin_amdgcn_global_load_lds((const unsigned*)pv0, (unsigned*)(smw + (ST) * STGB + 8192), 16, 0, 0); pv0 += 64; \
    __builtin_amdgcn_global_load_lds((const unsigned*)pv1, (unsigned*)(smw + (ST) * STGB + 8192 + 4096), 16, 0, 0); pv1 += 64; \
  } while (0)
  const int nt = nkeys >> 6;
  __syncthreads();
  VMWAIT(0);
  ATT_STAGE(0); ATT_STAGE(1); ATT_STAGE(2);
  const int sw = (l31 >> 1) & 7;
  const int kq0 = DIFF ? qi * 4 : 0;
  for (int kt = 0; kt < nt; ++kt) {
    if (kt + 2 < nt) VMWAIT(8); else if (kt + 1 < nt) VMWAIT(4); else VMWAIT(0);
    RAW_BARRIER();
    if (kt + 3 < nt) ATT_STAGE((kt + 3) & 3);
    __builtin_amdgcn_sched_barrier(0);
    const char* sK = smb + (kt & 3) * STGB;
    const char* sV = sK + 8192;
    f32x16 S[2];
    _Pragma("unroll") for (int s = 0; s < NS; ++s)
      _Pragma("unroll") for (int k2 = 0; k2 < 2; ++k2) {
        const bf16x8 kf = *(const bf16x8*)(sK + (k2 * 32 + l31) * 128 + (((kq0 + 2 * s + hf) ^ sw) << 4));
        if (s == 0) { const f32x16 zc = {0.f, 0.f, 0.f, 0.f, 0.f, 0.f, 0.f, 0.f, 0.f, 0.f, 0.f, 0.f, 0.f, 0.f, 0.f, 0.f}; S[k2] = MFMA32(kf, qf[s], zc); }
        else S[k2] = MFMA32(kf, qf[s], S[k2]);
      }
    float mx = S[0][0];
    _Pragma("unroll") for (int k2 = 0; k2 < 2; ++k2)
      _Pragma("unroll") for (int r = 0; r < 16; ++r) mx = fmaxf(mx, S[k2][r]);
    mx = fmaxf(mx, __shfl_xor(mx, 32));
    const float mxs = mx * sc;
    if (__builtin_amdgcn_ballot_w64(mxs > mref + 8.f) != 0ull) {
      const float mnew = (mxs > mref + 8.f) ? mxs : mref;
      const float alpha = __builtin_amdgcn_exp2f(mref - mnew);
      mref = mnew;
      lsum *= alpha;
      _Pragma("unroll") for (int a = 0; a < 2; ++a)
        _Pragma("unroll") for (int r = 0; r < 16; ++r) O[a][r] *= alpha;
    }
    const f32x2 sc2 = {sc, sc}, nm2 = {-mref, -mref};
    f32x2 ps2 = {0.f, 0.f};
    bf16x8 pf[4];
    _Pragma("unroll") for (int k2 = 0; k2 < 2; ++k2)
      _Pragma("unroll") for (int u = 0; u < 2; ++u) {
        u32x4 pk;
        _Pragma("unroll") for (int j = 0; j < 4; ++j) {
          f32x2 v = {S[k2][8 * u + 2 * j], S[k2][8 * u + 2 * j + 1]};
          v = v * sc2 + nm2;
          f32x2 e;
          e.x = __builtin_amdgcn_exp2f(v.x);
          e.y = __builtin_amdgcn_exp2f(v.y);
          ps2 += e;
          pk[j] = pack2(e.x, e.y);
        }
        pf[2 * k2 + u] = __builtin_bit_cast(bf16x8, pk);
      }
    lsum += ps2.x + ps2.y;
    _Pragma("unroll") for (int a = 0; a < 2; ++a)
      _Pragma("unroll") for (int s2 = 0; s2 < 4; ++s2) {
        const bf16x8 vf = *(const bf16x8*)(sV + (a * 32 + l31) * 128 + (((2 * s2 + hf) ^ sw) << 4));
        O[a] = MFMA32(vf, pf[s2], O[a]);
      }
  }
  RAW_BARRIER();
#undef ATT_STAGE
  const float inv = 1.f / (lsum + __shfl_xor(lsum, 32));
  const u16* zg = ((u16*)(p.ws + OFF_Z)) + (size_t)mq * INW;
  if (!DIFF) {
    _Pragma("unroll") for (int a = 0; a < 2; ++a)
      _Pragma("unroll") for (int i = 0; i < 4; ++i) {
        const int col = (unit * 2 + qi) * 64 + a * 32 + 8 * i + 4 * hf;
        const uint2 gv2 = *(const uint2*)(zg + 1536 + col);
        const float y0 = O[a][4 * i + 0] * inv * silu_f(bflo(gv2.x));
        const float y1 = O[a][4 * i + 1] * inv * silu_f(bfhi(gv2.x));
        const float y2 = O[a][4 * i + 2] * inv * silu_f(bflo(gv2.y));
        const float y3 = O[a][4 * i + 3] * inv * silu_f(bfhi(gv2.y));
        *(uint2*)(((u16*)(p.ws + OFF_Y)) + tix(mq, 256 + col, 32)) = make_uint2(pack2(y0, y1), pack2(y2, y3));
      }
  } else {
    float* xb = (float*)smem + qs * 32 * 64;
    if (qi == 1) {
      _Pragma("unroll") for (int a = 0; a < 2; ++a)
        _Pragma("unroll") for (int r = 0; r < 16; ++r) xb[(a * 16 + r) * 64 + lane] = O[a][r] * inv;
    }
    __syncthreads();
    if (qi == 0) {
      const float* lp = p.diff_lambda + l * 128;
      float d1 = 0.f, d2 = 0.f;
      for (int i = 0; i < 32; ++i) { d1 += lp[i] * lp[32 + i]; d2 += lp[64 + i] * lp[96 + i]; }
      const float lam_init = 0.8f - 0.6f * expf(-0.3f * (float)l);
      const float lam = expf(d1) - expf(d2) + lam_init;
      float ss = 0.f;
      _Pragma("unroll") for (int a = 0; a < 2; ++a)
        _Pragma("unroll") for (int r = 0; r < 16; ++r) {
          const float o = O[a][r] * inv - lam * xb[(a * 16 + r) * 64 + lane];
          O[a][r] = o;
          ss += o * o;
        }
      ss += __shfl_xor(ss, 32);
      const float rinv = rsqrtf(ss * (1.f / 64.f) + EPSN) * (1.f - lam_init);
      const float* gn = p.diff_gain + l * 64;
      _Pragma("unroll") for (int a = 0; a < 2; ++a)
        _Pragma("unroll") for (int i = 0; i < 4; ++i) {
          const int nl = a * 32 + 8 * i + 4 * hf;
          const int col = unit * 64 + nl;
          const uint2 gv2 = *(const uint2*)(zg + 3584 + col);
          const float4 g4 = *(const float4*)(gn + nl);
          const float y0 = O[a][4 * i + 0] * rinv * g4.x * silu_f(bflo(gv2.x));
          const float y1 = O[a][4 * i + 1] * rinv * g4.y * silu_f(bfhi(gv2.x));
          const float y2 = O[a][4 * i + 2] * rinv * g4.z * silu_f(bflo(gv2.y));
          const float y3 = O[a][4 * i + 3] * rinv * g4.w * silu_f(bfhi(gv2.y));
          *(uint2*)(((u16*)(p.ws + OFF_Y)) + tix(mq, 768 + col, 32)) = make_uint2(pack2(y0, y1), pack2(y2, y3));
        }
    }
  }
}

DI void r3_item(CPar& p, int l, int item, unsigned char* smem) {
  const int tid = otid(), lane = tid & 63, w = tid >> 6, l31 = lane & 31, hf = lane >> 5;
  bool ctx; int bb, h, c, m0;
  ret_decode(item, ctx, bb, h, c, m0);
  const int iq = w * 32 + l31;
  const int mq = m0 + iq;
  const float LOG2E = 1.4426950408889634f;
  const float lf2 = log_gamma(p, l, 0, h) * LOG2E, lb2 = log_gamma(p, l, 1, h) * LOG2E;
  u16* sK = (u16*)smem;
  u16* sV = sK + 128 * LSTR;
  constexpr int VSTR = 136;
  const u16* Vt = ctx ? ((u16*)(p.ws + OFF_VtRc)) + ((size_t)(bb * 4 + h) * 64) * 256 + c * 128 : ((u16*)(p.ws + OFF_VtRl)) + ((size_t)(bb * 4 + h) * 64) * 4096 + c * 128;
  const int ldv = ctx ? 256 : 4096;
  __syncthreads();
  _Pragma("unroll") for (int i = 0; i < 4; ++i) {
    const int cidx = tid + 256 * i;
    { const int row = cidx >> 3, kc = cidx & 7;
      *(uint4*)(sK + row * LSTR + kc * 8) = *(const uint4*)(((u16*)(p.ws + OFF_Z)) + (size_t)(m0 + row) * INW + 2048 + h * 64 + kc * 8); }
    { const int dv = cidx >> 4, kc = cidx & 15;
      *(uint4*)(sV + dv * VSTR + kc * 8) = *(const uint4*)(Vt + (size_t)dv * ldv + kc * 8); }
  }
  bf16x8 qf[4];
  {
    const u16* zq = ((u16*)(p.ws + OFF_Z)) + (size_t)mq * INW + 1792 + h * 64 + hf * 8;
    _Pragma("unroll") for (int s = 0; s < 4; ++s) qf[s] = *(const bf16x8*)(zq + s * 16);
  }
  __syncthreads();
  f32x16 O[2];
  O[0] = zero16(); O[1] = zero16();
  _Pragma("unroll 1") for (int kt = 0; kt < 2; ++kt) {
    f32x16 S[2];
    S[0] = zero16(); S[1] = zero16();
    _Pragma("unroll") for (int s = 0; s < 4; ++s)
      _Pragma("unroll") for (int k2 = 0; k2 < 2; ++k2) {
        const bf16x8 kf = *(const bf16x8*)(sK + (kt * 64 + k2 * 32 + l31) * LSTR + s * 16 + hf * 8);
        S[k2] = MFMA32(kf, qf[s], S[k2]);
      }
    bf16x8 pf[4];
    _Pragma("unroll") for (int k2 = 0; k2 < 2; ++k2) {
      _Pragma("unroll") for (int r = 0; r < 16; ++r) {
        const int jk = kt * 64 + k2 * 32 + 8 * (r >> 2) + 4 * hf + (r & 3);
        const int d = iq - jk;
        float wgt;
        if (d > 0) wgt = __builtin_amdgcn_exp2f(lf2 * (float)d);
        else if (d < 0) wgt = __builtin_amdgcn_exp2f(lb2 * (float)(-d));
        else wgt = 2.f;
        S[k2][r] *= wgt;
      }
      _Pragma("unroll") for (int u = 0; u < 2; ++u) {
        u32x4 pk;
        pk[0] = pack2(S[k2][8 * u + 0], S[k2][8 * u + 1]);
        pk[1] = pack2(S[k2][8 * u + 2], S[k2][8 * u + 3]);
        pk[2] = pack2(S[k2][8 * u + 4], S[k2][8 * u + 5]);
        pk[3] = pack2(S[k2][8 * u + 6], S[k2][8 * u + 7]);
        pf[2 * k2 + u] = __builtin_bit_cast(bf16x8, pk);
      }
    }
    _Pragma("unroll") for (int a = 0; a < 2; ++a)
      _Pragma("unroll") for (int s2 = 0; s2 < 4; ++s2) {
        const bf16x8 vf = *(const bf16x8*)(sV + (a * 32 + l31) * VSTR + kt * 64 + 16 * s2 + 8 * hf);
        O[a] = MFMA32(vf, pf[s2], O[a]);
      }
  }
  _Pragma("unroll") for (int dir = 0; dir < 2; ++dir) {
    const u16* st = ((u16*)(p.ws + OFF_SinT)) + ((size_t)item * 2 + dir) * 4096;
    const float dq = dir == 0 ? __builtin_amdgcn_exp2f(lf2 * (float)(iq + 1)) : __builtin_amdgcn_exp2f(lb2 * (float)(128 - iq));
    _Pragma("unroll") for (int a = 0; a < 2; ++a) {
      f32x16 X = zero16();
      _Pragma("unroll") for (int s = 0; s < 4; ++s) {
        const bf16x8 sf = *(const bf16x8*)(st + (a * 32 + l31) * 64 + s * 16 + hf * 8);
        X = MFMA32(sf, qf[s], X);
      }
      _Pragma("unroll") for (int r = 0; r < 16; ++r) O[a][r] += X[r] * dq;
    }
  }
  float ss = 0.f;
  _Pragma("unroll") for (int a = 0; a < 2; ++a)
    _Pragma("unroll") for (int r = 0; r < 16; ++r) ss += O[a][r] * O[a][r];
  ss += __shfl_xor(ss, 32);
  const float rinv = rsqrtf(ss * (1.f / 64.f) + EPSN);
  const u16* zg = ((u16*)(p.ws + OFF_Z)) + (size_t)mq * INW + 2560 + h * 64;
  _Pragma("unroll") for (int a = 0; a < 2; ++a)
    _Pragma("unroll") for (int i = 0; i < 4; ++i) {
      const int nl = a * 32 + 8 * i + 4 * hf;
      const uint2 gv2 = *(const uint2*)(zg + nl);
      const float y0 = O[a][4 * i + 0] * rinv * silu_f(bflo(gv2.x));
      const float y1 = O[a][4 * i + 1] * rinv * silu_f(bfhi(gv2.x));
      const float y2 = O[a][4 * i + 2] * rinv * silu_f(bflo(gv2.y));
      const float y3 = O[a][4 * i + 3] * rinv * silu_f(bfhi(gv2.y));
      *(uint2*)(((u16*)(p.ws + OFF_Y)) + tix(mq, 512 + h * 64 + nl, 32)) = make_uint2(pack2(y0, y1), pack2(y2, y3));
    }
}

DI void phaseC(CPar& p, int l, unsigned char* smem) {
  const int lane = otid() & 63, w = otid() >> 6, wn = w >> 1, wt = w & 1, l31 = lane & 31, hf = lane >> 5;
  u16* Mg = ((u16*)(p.ws + OFF_Z));
  for (int tile = vblock(); tile < 8 * 320; tile += gridDim.x) {
    const int grp = tile / 640, rem = tile - grp * 640;
    const int tm = rem >> 1, tn = grp * 2 + (rem & 1);
    unsigned mgp[2][2][8];
    _Pragma("unroll") for (int a = 0; a < 2; ++a)
      _Pragma("unroll") for (int b = 0; b < 2; ++b)
        _Pragma("unroll") for (int r = 0; r < 8; ++r) mgp[a][b][r] = 0u;
    const u16* Ht = ((u16*)(p.ws + OFF_H)) + ((size_t)(tm * 32) << 12);
    _Pragma("unroll 1") for (int pr = 0; pr < 2; ++pr) {
      unsigned gp[2][4][8];
      {
        f32x16 acc[2][4];
        _Pragma("unroll") for (int a = 0; a < 2; ++a)
          _Pragma("unroll") for (int b = 0; b < 4; ++b) acc[a][b] = zero16();
        gemm_acc<4, true>(Ht, ((u16*)(p.ws + OFF_WgT)) + (size_t)l * 4096 * 1024 + ((size_t)((pr * 16 + tn) * 32) << 12), 8 * 32 * 4096, 32, acc, (u16*)smem);
        _Pragma("unroll") for (int a = 0; a < 2; ++a)
          _Pragma("unroll") for (int b = 0; b < 4; ++b)
            _Pragma("unroll") for (int r = 0; r < 8; ++r) gp[a][b][r] = pack2(sigmoid_f(acc[a][b][2 * r]), sigmoid_f(acc[a][b][2 * r + 1]));
      }
      _Pragma("unroll") for (int bh = 0; bh < 2; ++bh) {
        const int br = pr * 2 + bh;
        f32x16 acc[2][2];
        _Pragma("unroll") for (int a = 0; a < 2; ++a)
          _Pragma("unroll") for (int b = 0; b < 2; ++b) acc[a][b] = zero16();
        gemm_acc<2>(((u16*)(p.ws + OFF_Y)) + ((size_t)(tm * 32 + br * 8) << 12), ((u16*)(p.ws + OFF_WbT)) + (size_t)l * 1024 * 1024 + ((size_t)(tn * 32 + br * 8) << 12), 0, 8, acc, (u16*)smem);
        _Pragma("unroll") for (int a = 0; a < 2; ++a)
          _Pragma("unroll") for (int b = 0; b < 2; ++b)
            _Pragma("unroll") for (int r = 0; r < 8; ++r)
              mgp[a][b][r] = pack2(bflo(mgp[a][b][r]) + bflo(gp[a][bh * 2 + b][r]) * acc[a][b][2 * r], bfhi(mgp[a][b][r]) + bfhi(gp[a][bh * 2 + b][r]) * acc[a][b][2 * r + 1]);
      }
    }
    _Pragma("unroll") for (int a = 0; a < 2; ++a)
      _Pragma("unroll") for (int b = 0; b < 2; ++b) {
        const int n = tn * 128 + wt * 64 + b * 32 + l31;
        _Pragma("unroll") for (int r = 0; r < 8; ++r) {
          const int t0 = tm * 128 + wn * 64 + a * 32 + 8 * ((2 * r) >> 2) + 4 * hf + ((2 * r) & 3);
          Mg[tix(t0, n, 32)] = (u16)(mgp[a][b][r] & 0xffffu);
          Mg[tix(t0 + 1, n, 32)] = (u16)(mgp[a][b][r] >> 16);
        }
      }
  }
}

DI void phaseD(CPar& p, int l, unsigned char* smem) {
  const int lane = otid() & 63, w = otid() >> 6, wn = w >> 1, wt = w & 1, l31 = lane & 31, hf = lane >> 5;
  const u16* Mg = ((u16*)(p.ws + OFF_Z));
  for (int tile = vblock(); tile < 8 * 320; tile += gridDim.x) {
    const int tn = tile & 7, tm = tile >> 3;
    f32x16 acc[2][2];
    _Pragma("unroll") for (int a = 0; a < 2; ++a)
      _Pragma("unroll") for (int b = 0; b < 2; ++b) acc[a][b] = zero16();
    gemm_acc<2>(((u16*)(p.ws + OFF_WoT)) + (size_t)l * 1024 * 1024 + ((size_t)(tn * 32) << 12), Mg + ((size_t)(tm * 32) << 12), 0, 32, acc, (u16*)smem);
    _Pragma("unroll") for (int b = 0; b < 2; ++b) {
      const int m = tm * 128 + wt * 64 + b * 32 + l31;
      const int j = m < MC ? 0 : 1 + ((m - MC) >> 12);
      const float* gate = ((float*)(p.ws + OFF_mod)) + (l * 9 + j) * 3072 + 2048 + tn * 128 + wn * 64;
      const float* xr = ((l == 0) ? (m < MC ? p.x_prompt + (size_t)m * 1024 : p.x_sample + (size_t)(m - MC) * 1024) : p.out + (size_t)m * 1024) + tn * 128 + wn * 64;
      float* xo = p.out + (size_t)m * 1024 + tn * 128 + wn * 64;
      _Pragma("unroll") for (int a = 0; a < 2; ++a)
        _Pragma("unroll") for (int i = 0; i < 4; ++i) {
          const int nl = a * 32 + 8 * i + 4 * hf;
          const float4 xv = *(const float4*)(xr + nl);
          const float4 gv = *(const float4*)(gate + nl);
          float4 o;
          o.x = xv.x + gv.x * acc[a][b][4 * i + 0];
          o.y = xv.y + gv.y * acc[a][b][4 * i + 1];
          o.z = xv.z + gv.z * acc[a][b][4 * i + 2];
          o.w = xv.w + gv.w * acc[a][b][4 * i + 3];
          *(float4*)(xo + nl) = o;
        }
    }
  }
}

DI void phaseFinal(CPar& p) {
  const int tid = otid(), lane = tid & 63;
  const int gw = blockIdx.x * 4 + (tid >> 6), nw = gridDim.x * 4;
  for (int row = gw; row < MT; row += nw) {
    float* xr = p.out + (size_t)row * 1024;
    float4 v[4];
    float ss = 0.f;
    _Pragma("unroll") for (int i = 0; i < 4; ++i) {
      v[i] = ((const float4*)xr)[lane + 64 * i];
      ss += v[i].x * v[i].x + v[i].y * v[i].y + v[i].z * v[i].z + v[i].w * v[i].w;
    }
    ss = wave_sum(ss);
    const float rstd = rsqrtf(ss * (1.f / 1024.f) + EPSN);
    _Pragma("unroll") for (int i = 0; i < 4; ++i) {
      const float4 g = *(const float4*)(p.final_gain + 4 * (lane + 64 * i));
      ((float4*)xr)[lane + 64 * i] = make_float4(v[i].x * rstd * g.x, v[i].y * rstd * g.y, v[i].z * rstd * g.z, v[i].w * rstd * g.w);
    }
  }
}

__global__ void __launch_bounds__(256, 2) hybrid_megakernel(Params p_unused) {
  cg::grid_group grid = cg::this_grid();
  __shared__ __attribute__((aligned(16))) unsigned char smem[SMEM_BYTES];
  __shared__ uint4 xb_words;
  if (threadIdx.x == 0) xb_words = make_uint4(0u, 0u, 0u, 0u);
  __syncthreads();
  XcdBarrier xb = xcd_barrier_post(((unsigned*)(PP().ws + OFF_bar)), (volatile LAS unsigned*)&xb_words);
  phase0(PP(), smem);
  grid.sync();
  _Pragma("unroll 1") for (int l = 0; l < 2; ++l) {
    phaseA0(PP(), l);
    xcd_barrier(xb);
    phaseA1(PP(), l, smem);
    xcd_barrier(xb);
    conv_items(PP(), l);
    r1_items(PP(), l, smem);
    xcd_barrier(xb);
    for (int rep = 0; rep < REP_B2; ++rep)
    for (int it = vblock(); it < 1024 + 1024 + 2048 + 256 + 512 + 4096; it += gridDim.x) {
      if (it < 1024) r2_item<false>(PP(), l, it);
      else if (it < 2048) { const int i = it - 1024; attn_item<false>(PP(), l, false, i >> 7, (i >> 6) & 1, i & 63, smem); }
      else if (it < 4096) { const int i = it - 2048; attn_item<true>(PP(), l, false, i >> 8, (i >> 6) & 3, i & 63, smem); }
      else if (it < 4352) { const int i = it - 4096; attn_item<false>(PP(), l, true, i >> 3, (i >> 2) & 1, i & 3, smem); }
      else if (it < 4864) { const int i = it - 4352; attn_item<true>(PP(), l, true, i >> 4, (i >> 2) & 3, i & 3, smem); }
      else r2_item<true>(PP(), l, it - 4864);
    }
    xcd_barrier(xb);
    for (int it = vblock(); it < 1280; it += gridDim.x) r3_item(PP(), l, it, smem);
    xcd_barrier(xb);
    phaseC(PP(), l, smem);
    xcd_barrier(xb);
    phaseD(PP(), l, smem);
    xcd_barrier(xb);
  }
  phaseFinal(PP());
}

extern "C" void kernel_launch(void* const* d_in, const int* in_sizes, int n_in, void* d_out, int out_size, void* d_ws, size_t ws_size,
                              hipStream_t stream) {
  static int grid_blocks = 0;
  if (!grid_blocks) {
    int dev = 0, cus = 0, per_cu = 0;
    (void)hipGetDevice(&dev);
    (void)hipDeviceGetAttribute(&cus, hipDeviceAttributeMultiprocessorCount, dev);
    (void)hipOccupancyMaxActiveBlocksPerMultiprocessor(&per_cu, hybrid_megakernel, 256, 0);
    if (per_cu > 2) per_cu = 2;
    if (per_cu < 1) per_cu = 1;
    grid_blocks = cus * per_cu;
  }
  Params p{};
  const float** fin = (const float**)&p.x_prompt;
  for (int i = 0; i < 23; ++i) fin[i] = (const float*)d_in[i];
  p.out = (float*)d_out;
  p.ws = (unsigned char*)d_ws;
  const size_t off = WS_NEED;
  if (off > ws_size) { fprintf(stderr, "workspace too small: need %zu have %zu\n", off, ws_size); return; }
  (void)hipMemsetAsync(p.ws + OFF_bar, 0, XCD_BAR_WORDS * 4, stream);
  void* args[] = {&p};
  hipError_t e = hipLaunchCooperativeKernel((void*)hybrid_megakernel, dim3(grid_blocks), dim3(256), args, 0, stream);
  if (e != hipSuccess) fprintf(stderr, "cooperative launch failed: %s (grid %d)\n", hipGetErrorString(e), grid_blocks);
}
```

```cpp
#include <hip/hip_runtime.h>
#include <hip/hip_bf16.h>
#include <hip/hip_cooperative_groups.h>
#include <cstdio>
namespace cg = cooperative_groups;

typedef unsigned short u16;
using bf16x8 = __attribute__((ext_vector_type(8))) short;
using f32x16 = __attribute__((ext_vector_type(16))) float;
using u32x4 = __attribute__((ext_vector_type(4))) unsigned;
using u32x2 = __attribute__((ext_vector_type(2))) unsigned;

#define DI __device__ __forceinline__
#define MFMA32(a, b, c) __builtin_amdgcn_mfma_f32_32x32x16_bf16((a), (b), (c), 0, 0, 0)

#ifndef REP_A1
#define REP_A1 1
#endif
#ifndef REP_B2
#define REP_B2 1
#endif
#ifndef PIPE_C
#define PIPE_C true
#endif
constexpr int DM = 1024;
constexpr int INW = 3840;
constexpr int MC = 8192;
constexpr int MT = 40960;
constexpr int NKL = 4608;
constexpr int LSTR = 72;
constexpr float EPSN = 1e-6f;
constexpr int SMEM_BYTES = 2 * 2 * 128 * LSTR * 2;

constexpr size_t OUT_GK = 41943040ull;
constexpr size_t OUT_GV = 44040192ull;
constexpr size_t OUT_DK = 46137344ull;
constexpr size_t OUT_DV = 50331648ull;
constexpr size_t OUT_ST = 54525952ull;

constexpr size_t OFF_WinT = 0ull;
constexpr size_t OFF_WgT = 15728640ull;
constexpr size_t OFF_WbT = 32505856ull;
constexpr size_t OFF_WoT = 36700160ull;
constexpr size_t OFF_mod = 40894464ull;
constexpr size_t OFF_rope = 41115648ull;
constexpr size_t OFF_H = 41123840ull;
constexpr size_t OFF_Z = 125009920ull;
constexpr size_t OFF_KG = 439582720ull;
constexpr size_t OFF_VtG = 449019904ull;
constexpr size_t OFF_KD = 458457088ull;
constexpr size_t OFF_VtD = 477331456ull;
constexpr size_t OFF_VtGc = 496205824ull;
constexpr size_t OFF_VtDc = 498302976ull;
constexpr size_t OFF_VtRc = 502497280ull;
constexpr size_t OFF_VtRl = 506691584ull;
constexpr size_t OFF_U = 523468800ull;
constexpr size_t OFF_SinT = 565411840ull;
constexpr size_t OFF_Y = 586383360ull;
constexpr size_t OFF_bar = 670269440ull;
constexpr size_t WS_NEED = 670283264ull;
struct Params {
  const float *x_prompt, *x_sample, *cache_gk, *cache_gv, *cache_dk, *cache_dv, *state_ret, *c, *c_ctx, *w_ada, *b_ada,
      *norm_gain, *w_in, *conv_w, *q_gain, *k_gain, *ret_decay, *diff_lambda, *diff_gain, *w_branch, *w_mgate, *w_out, *final_gain;
  float* out;
  unsigned char* ws;
};

typedef float f32x2 __attribute__((ext_vector_type(2)));
typedef __bf16 bf16x2_t __attribute__((ext_vector_type(2)));
typedef const Params __attribute__((address_space(4))) CPar;
DI CPar& PP() { CPar* q = (CPar*)__builtin_amdgcn_kernarg_segment_ptr(); asm volatile("" : "+s"(q)); return *q; }
DI unsigned pack2(float a, float b) {
  const f32x2 v = {a, b};
  return __builtin_bit_cast(unsigned, __builtin_convertvector(v, bf16x2_t));
}
DI u16 f2bf(float a) { return (u16)(pack2(a, 0.f) & 0xffffu); }
DI float bflo(unsigned v) { return __uint_as_float(v << 16); }
DI float bfhi(unsigned v) { return __uint_as_float(v & 0xffff0000u); }
DI float silu_f(float x) { return x / (1.f + __expf(-x)); }
DI float sigmoid_f(float x) { return 1.f / (1.f + __expf(-x)); }
DI f32x16 zero16() { f32x16 z; _Pragma("unroll") for (int i = 0; i < 16; ++i) z[i] = 0.f; return z; }
DI int otid() { int t = (int)__builtin_amdgcn_workitem_id_x(); asm volatile("" : "+v"(t)); return t; }
DI int vblock() { const int b = (int)blockIdx.x, g = (int)gridDim.x; return ((g & 7) == 0) ? (b & 7) * (g >> 3) + (b >> 3) : b; }
DI size_t tix(int r, int k, int ksl) { return ((size_t)((r >> 7) * ksl + (k >> 5)) << 12) + ((r & 127) << 5) + (k & 31); }
#define XB_TMO      128
#define XB_XCNT(j)  (256  + 64 * (j))
#define XB_XSUB(j)  (1280 + 64 * (j))
#define XB_XGEN(j)  (2304 + 64 * (j))
#define XB_TOP      3328
#define XB_TOPGEN   3392
#define XCD_BAR_WORDS 3456
#define XB_SPIN_CAP (1u << 18)
#define LAS __attribute__((address_space(3)))

__device__ __forceinline__ unsigned xb_ld(unsigned* p)              { return __hip_atomic_load(p, __ATOMIC_RELAXED, __HIP_MEMORY_SCOPE_AGENT); }
__device__ __forceinline__ unsigned xb_add(unsigned* p, unsigned v) { return __hip_atomic_fetch_add(p, v, __ATOMIC_RELAXED, __HIP_MEMORY_SCOPE_AGENT); }
__device__ __forceinline__ unsigned xb_xcc_id() { return (unsigned)__builtin_amdgcn_s_getreg((3 << 11) | 20) & 0xFu; }
#define XB_SPIN(cond, bar) do { unsigned _sp = 0; while (cond) { __builtin_amdgcn_s_sleep(1); \
    if ((++_sp & 255u) == 0u) { if (xb_ld(&(bar)[XB_TMO])) break; if (_sp > XB_SPIN_CAP) { atomicAdd(&(bar)[XB_TMO], 1u); break; } } } } while (0)

struct XcdBarrier {
    unsigned* bar; unsigned x;
    volatile LAS unsigned* st;
};

__device__ __forceinline__ XcdBarrier xcd_barrier_post(unsigned* bar, volatile LAS unsigned* st) {
    XcdBarrier b; b.bar = bar; b.x = xb_xcc_id(); b.st = st;
    if (threadIdx.x == 0) (void)xb_add(&bar[XB_XCNT(b.x)], 1u);
    return b;
}
__device__ __forceinline__ void xcd_barrier_complete(unsigned* bar, unsigned x, unsigned& nloc, unsigned& nx) {
    const unsigned G = gridDim.x * gridDim.y * gridDim.z;
    unsigned sum, cnt, mine, sp = 0u;
    for (;;) {
        sum = 0u; cnt = 0u; mine = 0u;
#pragma unroll
        for (unsigned j = 0; j < 16; ++j) { const unsigned c = xb_ld(&bar[XB_XCNT(j)]); sum += c; cnt += (c > 0u) ? 1u : 0u; mine = (j == x) ? c : mine; }
        if (sum == G) break;
        __builtin_amdgcn_s_sleep(1);
        if ((++sp & 255u) == 0u) { if (xb_ld(&bar[XB_TMO])) break; if (sp > XB_SPIN_CAP) { atomicAdd(&bar[XB_TMO], 1u); break; } }
    }
    nloc = mine > 0u ? mine : 1u; nx = cnt > 0u ? cnt : 1u;
}

__device__ __forceinline__ void xcd_barrier(const XcdBarrier& b) {
    asm volatile("s_waitcnt vmcnt(0)" ::: "memory");
    __syncthreads();
    if (threadIdx.x == 0) {
        unsigned* bar = b.bar;
        __builtin_amdgcn_s_waitcnt(0);
        unsigned nloc = b.st[0], nx = b.st[1];
        if (nloc == 0u) { xcd_barrier_complete(bar, b.x, nloc, nx); b.st[0] = nloc; b.st[1] = nx; }
        const unsigned old = xb_add(&bar[XB_XSUB(b.x)], 1u);
        const unsigned gen = old / nloc;
        if (old + 1u == (gen + 1u) * nloc) {
            __builtin_amdgcn_fence(__ATOMIC_RELEASE, "agent");
            asm volatile("s_waitcnt vmcnt(0)" ::: "memory");
            const unsigned og = xb_add(&bar[XB_TOP], 1u);
            const unsigned tg = og / nx;
            if (og + 1u == (tg + 1u) * nx) xb_add(&bar[XB_TOPGEN], 1u);
            else XB_SPIN(xb_ld(&bar[XB_TOPGEN]) == tg, bar);
            __builtin_amdgcn_fence(__ATOMIC_ACQUIRE, "agent");
            xb_add(&bar[XB_XGEN(b.x)], 1u);
            asm volatile("s_waitcnt vmcnt(0)" ::: "memory");
        } else {
            XB_SPIN(xb_ld(&bar[XB_XGEN(b.x)]) == gen, bar);
            __builtin_amdgcn_fence(__ATOMIC_ACQUIRE, "agent");
            asm volatile("s_waitcnt vmcnt(0)" ::: "memory");
        }
    }
    __syncthreads();
}


DI int kperm(int t) { return (t & ~12) | ((t & 4) << 1) | ((t & 8) >> 1); }
DI float xhalf_max(float x) {
  const auto r = __builtin_amdgcn_permlane32_swap(__float_as_uint(x), __float_as_uint(x), false, false);
  return fmaxf(__uint_as_float(r[0]), __uint_as_float(r[1]));
}
DI float xhalf_sum(float x) {
  const auto r = __builtin_amdgcn_permlane32_swap(__float_as_uint(x), __float_as_uint(x), false, false);
  return __uint_as_float(r[0]) + __uint_as_float(r[1]);
}
DI float wave_sum(float v) {
  _Pragma("unroll") for (int o = 1; o < 64; o <<= 1) v += __shfl_xor(v, o);
  return v;
}

#define VMWAIT(N) asm volatile("s_waitcnt vmcnt(" #N ")" ::: "memory")
#define RAW_BARRIER() do { asm volatile("s_waitcnt lgkmcnt(0)" ::: "memory"); __builtin_amdgcn_s_barrier(); } while (0)
template <int TB, bool BMAP = false, bool LEAN = false>
DI void gemm_acc(const u16* __restrict__ A, const u16* __restrict__ B, int bstride, int nk, f32x16 (&acc)[2][TB], u16* sm) {
  const int tid = otid(), lane = tid & 63, w = tid >> 6, wn = w >> 1, wt = w & 1, l31 = lane & 31, hf = lane >> 5;
  constexpr int NSTG = (TB == 2) ? 4 : 3;
  constexpr int RB = 64 * TB;
  constexpr int STGB = (128 + RB) * 64;
  constexpr int LPB = RB / 64;
  const int lr = tid >> 2, gsl = (tid & 3) ^ ((lr >> 2) & 3);
  const u16* ga = A + lr * 32 + gsl * 8;
  const u16* gb = B + lr * 32 + gsl * 8;
  char* smb = (char*)sm;
  const int wv = __builtin_amdgcn_readfirstlane(w);
  char* smw = smb + wv * 1024;
  const u16* pa[2];
  const u16* pb[LPB];
  _Pragma("unroll") for (int i = 0; i < 2; ++i) pa[i] = ga + 2048 * i;
  _Pragma("unroll") for (int i = 0; i < LPB; ++i) pb[i] = BMAP ? gb + (size_t)(i & 1) * bstride + 2048 * (i >> 1) : gb + (size_t)(i >> 1) * bstride + 2048 * (i & 1);
#define GEMM_STAGE(ST) do { \
    _Pragma("unroll") for (int i = 0; i < 2; ++i) { \
      __builtin_amdgcn_global_load_lds((const unsigned*)pa[i], (unsigned*)(smw + (ST) * STGB + i * 4096), 16, 0, 0); pa[i] += 4096; } \
    _Pragma("unroll") for (int i = 0; i < LPB; ++i) { \
      __builtin_amdgcn_global_load_lds((const unsigned*)pb[i], (unsigned*)(smw + (ST) * STGB + 8192 + i * 4096), 16, 0, 0); pb[i] += 4096; } \
  } while (0)
  VMWAIT(0);
  _Pragma("unroll") for (int s0 = 0; s0 < NSTG - 1; ++s0) GEMM_STAGE(s0);
  const int sw = (l31 >> 2) & 3;
  const int oa0 = (wn * 64 + l31) * 64 + ((hf ^ sw) << 4), oa1 = (wn * 64 + l31) * 64 + (((2 + hf) ^ sw) << 4);
  const int ob0 = 8192 + (wt * 32 * TB + l31) * 64 + ((hf ^ sw) << 4), ob1 = 8192 + (wt * 32 * TB + l31) * 64 + (((2 + hf) ^ sw) << 4);
  int st = 0, stn = NSTG - 1;
  bf16x8 dfa[2], dfb[TB];
  _Pragma("unroll") for (int a = 0; a < 2; ++a) dfa[a] = bf16x8{0, 0, 0, 0, 0, 0, 0, 0};
  _Pragma("unroll") for (int b = 0; b < TB; ++b) dfb[b] = bf16x8{0, 0, 0, 0, 0, 0, 0, 0};
  for (int kt = 0; kt < nk; ++kt) {
    if (kt + NSTG - 2 < nk) { if (TB == 2) VMWAIT(8); else VMWAIT(6); }
    else if (NSTG == 4 && kt + 1 < nk) VMWAIT(4);
    else VMWAIT(0);
    RAW_BARRIER();
    if (kt + NSTG - 1 < nk) GEMM_STAGE(stn);
    __builtin_amdgcn_sched_barrier(0);
    const char* sb = smb + st * STGB;
    if (!LEAN) {
      bf16x8 fa0[2], fb0[TB], fa1[2], fb1[TB];
      _Pragma("unroll") for (int a = 0; a < 2; ++a) fa0[a] = *(const bf16x8*)(sb + oa0 + a * 2048);
      _Pragma("unroll") for (int b = 0; b < TB; ++b) fb0[b] = *(const bf16x8*)(sb + ob0 + b * 2048);
      _Pragma("unroll") for (int a = 0; a < 2; ++a) fa1[a] = *(const bf16x8*)(sb + oa1 + a * 2048);
      _Pragma("unroll") for (int b = 0; b < TB; ++b) fb1[b] = *(const bf16x8*)(sb + ob1 + b * 2048);
      __builtin_amdgcn_sched_barrier(0);
      _Pragma("unroll") for (int a = 0; a < 2; ++a)
        _Pragma("unroll") for (int b = 0; b < TB; ++b) acc[a][b] = MFMA32(dfa[a], dfb[b], acc[a][b]);
      __builtin_amdgcn_sched_barrier(0);
      _Pragma("unroll") for (int a = 0; a < 2; ++a)
        _Pragma("unroll") for (int b = 0; b < TB; ++b) acc[a][b] = MFMA32(fa0[a], fb0[b], acc[a][b]);
      __builtin_amdgcn_sched_barrier(0);
      _Pragma("unroll") for (int a = 0; a < 2; ++a) dfa[a] = fa1[a];
      _Pragma("unroll") for (int b = 0; b < TB; ++b) dfb[b] = fb1[b];
    } else {
      _Pragma("unroll") for (int ks = 0; ks < 2; ++ks) {
        bf16x8 fa[2], fb[TB];
        _Pragma("unroll") for (int a = 0; a < 2; ++a) fa[a] = *(const bf16x8*)(sb + (ks ? oa1 : oa0) + a * 2048);
        _Pragma("unroll") for (int b = 0; b < TB; ++b) fb[b] = *(const bf16x8*)(sb + (ks ? ob1 : ob0) + b * 2048);
        __builtin_amdgcn_sched_barrier(0);
        _Pragma("unroll") for (int a = 0; a < 2; ++a)
          _Pragma("unroll") for (int b = 0; b < TB; ++b) acc[a][b] = MFMA32(fa[a], fb[b], acc[a][b]);
        __builtin_amdgcn_sched_barrier(0);
      }
    }
    st = (st + 1 == NSTG) ? 0 : st + 1;
    stn = (stn + 1 == NSTG) ? 0 : stn + 1;
  }
  if (!LEAN) {
    _Pragma("unroll") for (int a = 0; a < 2; ++a)
      _Pragma("unroll") for (int b = 0; b < TB; ++b) acc[a][b] = MFMA32(dfa[a], dfb[b], acc[a][b]);
  }
  RAW_BARRIER();
#undef GEMM_STAGE
}

DI void phase0(CPar& p, unsigned char* smem) {
  const int tid = otid();
  float* tile = (float*)smem;
  for (int job = blockIdx.x; job < 4992; job += gridDim.x) {
    const int l = job / 2496;
    int rem = job - l * 2496;
    const float* src; u16* dst; int C;
    if (rem < 960) { src = p.w_in + (size_t)l * 1024 * 3840; dst = ((u16*)(p.ws + OFF_WinT)) + (size_t)l * 3840 * 1024; C = 3840; }
    else if (rem < 1984) { rem -= 960; src = p.w_mgate + (size_t)l * 1024 * 4096; dst = ((u16*)(p.ws + OFF_WgT)) + (size_t)l * 4096 * 1024; C = 4096; }
    else if (rem < 2240) { rem -= 1984; src = p.w_branch + (size_t)l * 1024 * 1024; dst = ((u16*)(p.ws + OFF_WbT)) + (size_t)l * 1024 * 1024; C = 1024; }
    else { rem -= 2240; src = p.w_out + (size_t)l * 1024 * 1024; dst = ((u16*)(p.ws + OFF_WoT)) + (size_t)l * 1024 * 1024; C = 1024; }
    const int tr = rem & 15, tc = rem >> 4;
    const int r0 = tr * 64, c0 = tc * 64;
    __syncthreads();
    _Pragma("unroll") for (int i = 0; i < 4; ++i) {
      const int rr = (tid >> 4) + 16 * i, cc = (tid & 15) * 4;
      const float4 v = *(const float4*)(src + (size_t)(r0 + rr) * C + c0 + cc);
      tile[rr * 65 + cc + 0] = v.x; tile[rr * 65 + cc + 1] = v.y; tile[rr * 65 + cc + 2] = v.z; tile[rr * 65 + cc + 3] = v.w;
    }
    __syncthreads();
    {
      const int n = tid >> 2, kq = (tid & 3) * 16;
      unsigned wv[8];
      _Pragma("unroll") for (int j = 0; j < 8; ++j) wv[j] = pack2(tile[(kq + 2 * j) * 65 + n], tile[(kq + 2 * j + 1) * 65 + n]);
      u16* d = dst + tix(c0 + n, r0 + kq, 32);
      *(uint4*)d = make_uint4(wv[0], wv[1], wv[2], wv[3]);
      *(uint4*)(d + 8) = make_uint4(wv[4], wv[5], wv[6], wv[7]);
    }
  }
  __syncthreads();
  if (blockIdx.x < 384) {
  {
    float* sc = (float*)smem;
    float* red = sc + 9 * 1024;
    for (int i = tid; i < 9 * 1024; i += 256) {
      const int j = i >> 10, k = i & 1023;
      const float cv = (j == 0) ? p.c_ctx[k] : p.c[(j - 1) * 1024 + k];
      sc[i] = silu_f(cv);
    }
    __syncthreads();
    for (int item = blockIdx.x; item < 384; item += gridDim.x) {
    const int lane = tid & 63, w = tid >> 6;
    const int l = item / 192, n = (item % 192) * 16 + (lane & 15);
    const int kbeg = (w * 4 + (lane >> 4)) * 64;
    float acc[9];
    _Pragma("unroll") for (int j = 0; j < 9; ++j) acc[j] = 0.f;
    const float* wp = p.w_ada + (size_t)l * 1024 * 3072 + n;
    for (int k = kbeg; k < kbeg + 64; k += 8) {
      float wv[8];
      _Pragma("unroll") for (int u = 0; u < 8; ++u) wv[u] = wp[(size_t)(k + u) * 3072];
      _Pragma("unroll") for (int u = 0; u < 8; ++u)
        _Pragma("unroll") for (int j = 0; j < 9; ++j) acc[j] += sc[j * 1024 + k + u] * wv[u];
    }
    _Pragma("unroll") for (int j = 0; j < 9; ++j) {
      acc[j] += __shfl_xor(acc[j], 16);
      acc[j] += __shfl_xor(acc[j], 32);
    }
    if (lane < 16) {
      _Pragma("unroll") for (int j = 0; j < 9; ++j) red[(w * 9 + j) * 16 + lane] = acc[j];
    }
    __syncthreads();
    if (tid < 144) {
      const int j = tid >> 4, nn = tid & 15;
      const int n2 = (item % 192) * 16 + nn;
      const float v = red[(0 * 9 + j) * 16 + nn] + red[(1 * 9 + j) * 16 + nn] + red[(2 * 9 + j) * 16 + nn] + red[(3 * 9 + j) * 16 + nn];
      ((float*)(p.ws + OFF_mod))[(l * 9 + j) * 3072 + n2] = v + p.b_ada[l * 3072 + n2];
    }
    __syncthreads();
    }
  }
  }
  if (blockIdx.x == gridDim.x - 1) {
    for (int i = tid; i < 1024; i += 256) {
      const int pos = i >> 4, f = i & 15;
      const float inv = powf(10000.f, -(float)f / 16.f);
      const float ang = (float)pos * inv;
      ((float*)(p.ws + OFF_rope))[2 * i] = cosf(ang);
      ((float*)(p.ws + OFF_rope))[2 * i + 1] = sinf(ang);
    }
  }
}

DI void phaseA0(CPar& p, int l) {
  const int tid = otid(), lane = tid & 63;
  const int gw = blockIdx.x * 4 + (tid >> 6), nw = gridDim.x * 4;
  const float* ng = p.norm_gain + l * 1024;
  for (int row = gw; row < MT; row += nw) {
    const float* xr = (l == 0) ? (row < MC ? p.x_prompt + (size_t)row * 1024 : p.x_sample + (size_t)(row - MC) * 1024)
                               : p.out + (size_t)row * 1024;
    float4 v[4];
    float ss = 0.f;
    _Pragma("unroll") for (int i = 0; i < 4; ++i) {
      v[i] = ((const float4*)xr)[lane + 64 * i];
      ss += v[i].x * v[i].x + v[i].y * v[i].y + v[i].z * v[i].z + v[i].w * v[i].w;
    }
    ss = wave_sum(ss);
    const float rstd = rsqrtf(ss * (1.f / 1024.f) + EPSN);
    const int j = row < MC ? 0 : 1 + ((row - MC) >> 12);
    const float* shift = ((float*)(p.ws + OFF_mod)) + (l * 9 + j) * 3072;
    const float* scale = shift + 1024;
    _Pragma("unroll") for (int i = 0; i < 4; ++i) {
      const int k = 4 * (lane + 64 * i);
      const float4 g = *(const float4*)(ng + k);
      const float4 s = *(const float4*)(scale + k);
      const float4 sh = *(const float4*)(shift + k);
      const float h0 = v[i].x * rstd * g.x * (1.f + s.x) + sh.x;
      const float h1 = v[i].y * rstd * g.y * (1.f + s.y) + sh.y;
      const float h2 = v[i].z * rstd * g.z * (1.f + s.z) + sh.z;
      const float h3 = v[i].w * rstd * g.w * (1.f + s.w) + sh.w;
      *(uint2*)(((u16*)(p.ws + OFF_H)) + tix(row, k, 32)) = make_uint2(pack2(h0, h1), pack2(h2, h3));
    }
  }
  const int gt = blockIdx.x * 256 + tid, nt = gridDim.x * 256;
  for (int idx = gt; idx < 8 * 65536; idx += nt) {
    const int b = idx >> 16, rem = idx & 65535;
    ((u16*)(p.ws + OFF_KG))[(size_t)b * NKL * 128 + rem] = f2bf(p.cache_gk[(size_t)(b * 2 + l) * 65536 + rem]);
  }
  for (int idx = gt; idx < 8 * 131072; idx += nt) {
    const int b = idx >> 17, rem = idx & 131071;
    ((u16*)(p.ws + OFF_KD))[(size_t)b * NKL * 256 + rem] = f2bf(p.cache_dk[(size_t)(b * 2 + l) * 131072 + rem]);
  }
  for (int idx = gt; idx < 8 * 2 * 64 * 512; idx += nt) {
    const int pk = idx & 511, dv = (idx >> 9) & 63, g = (idx >> 15) & 1, b = idx >> 16;
    ((u16*)(p.ws + OFF_VtG))[((size_t)(b * 2 + g) * 64 + dv) * NKL + kperm(pk)] = f2bf(p.cache_gv[((size_t)(b * 2 + l) * 512 + pk) * 128 + g * 64 + dv]);
  }
  for (int idx = gt; idx < 8 * 4 * 64 * 512; idx += nt) {
    const int pk = idx & 511, dv = (idx >> 9) & 63, h = (idx >> 15) & 3, b = idx >> 17;
    ((u16*)(p.ws + OFF_VtD))[((size_t)(b * 4 + h) * 64 + dv) * NKL + kperm(pk)] = f2bf(p.cache_dv[((size_t)(b * 2 + l) * 512 + pk) * 256 + h * 64 + dv]);
  }
}

#define NLOC(a, r) ((a) * 32 + 8 * ((r) >> 2) + 4 * hf + ((r) & 3))

template <int NB>
DI void a1_epilogue(CPar& p, int l, int nbase, int m0w, f32x16 (&acc)[2][NB], unsigned char* smem) {
  const int lane = otid() & 63, l31 = lane & 31, hf = lane >> 5;
  u16* stg = (u16*)smem + (otid() >> 6) * (32 * 68);
  _Pragma("unroll") for (int b = 0; b < NB; ++b) {
    const int m = m0w + b * 32 + l31;
    const bool ctx = m < MC;
    int bb, t;
    if (ctx) { bb = m >> 8; t = m & 255; } else { const int ml = m - MC; bb = ml >> 12; t = ml & 4095; }
    float v[2][16];
    _Pragma("unroll") for (int a = 0; a < 2; ++a)
      _Pragma("unroll") for (int r = 0; r < 16; ++r) v[a][r] = acc[a][b][r];

    auto rmsn = [&](const float* gain) {
      float ss = 0.f;
      _Pragma("unroll") for (int a = 0; a < 2; ++a)
        _Pragma("unroll") for (int r = 0; r < 16; ++r) ss += v[a][r] * v[a][r];
      ss = xhalf_sum(ss);
      const float rinv = rsqrtf(ss * (1.f / 64.f) + EPSN);
      _Pragma("unroll") for (int a = 0; a < 2; ++a)
        _Pragma("unroll") for (int i = 0; i < 4; ++i) {
          const float4 g = *(const float4*)(gain + a * 32 + 8 * i + 4 * hf);
          v[a][4 * i + 0] *= rinv * g.x; v[a][4 * i + 1] *= rinv * g.y; v[a][4 * i + 2] *= rinv * g.z; v[a][4 * i + 3] *= rinv * g.w;
        }
    };
    auto rope64 = [&]() {
      const int trow = t >> 6, tcol = t & 63;
      const float2* rp = (const float2*)((float*)(p.ws + OFF_rope));
      _Pragma("unroll") for (int r = 0; r < 16; ++r) {
        const int j = 8 * (r >> 2) + 4 * hf + (r & 3);
        const int pos = ((r >> 2) < 2) ? trow : tcol;
        const float2 cs = rp[pos * 16 + (j & 15)];
        const float x1 = v[0][r], x2 = v[1][r];
        v[0][r] = x1 * cs.x - x2 * cs.y;
        v[1][r] = x1 * cs.y + x2 * cs.x;
      }
    };
    auto rope32 = [&]() {
      const int trow = t >> 6, tcol = t & 63;
      const float2* rp = (const float2*)((float*)(p.ws + OFF_rope));
      _Pragma("unroll") for (int a = 0; a < 2; ++a)
        _Pragma("unroll") for (int r = 0; r < 8; ++r) {
          const int j = 8 * (r >> 2) + 4 * hf + (r & 3);
          const int pos = ((r >> 2) == 0) ? trow : tcol;
          const float2 cs = rp[pos * 16 + 2 * (j & 7)];
          const float x1 = v[a][r], x2 = v[a][r + 8];
          v[a][r] = x1 * cs.x - x2 * cs.y;
          v[a][r + 8] = x1 * cs.y + x2 * cs.x;
        }
    };
    auto store_nat = [&](u16* dst) {
      _Pragma("unroll") for (int a = 0; a < 2; ++a)
        _Pragma("unroll") for (int i = 0; i < 4; ++i)
          *(uint2*)(stg + l31 * 68 + a * 32 + 8 * i + 4 * hf) = make_uint2(pack2(v[a][4 * i], v[a][4 * i + 1]), pack2(v[a][4 * i + 2], v[a][4 * i + 3]));
      const unsigned long long dp = (unsigned long long)dst;
      _Pragma("unroll") for (int j = 0; j < 8; ++j) {
        const int row = (lane >> 4) + 4 * j;
        const unsigned lo = __shfl((unsigned)dp, row), hi = __shfl((unsigned)(dp >> 32), row);
        u16* rp = (u16*)(((unsigned long long)hi << 32) | lo);
        const uint2 val = *(const uint2*)(stg + row * 68 + (lane & 15) * 4);
        *(uint2*)(rp + (lane & 15) * 4) = val;
      }
    };
    auto store_f32 = [&](float* dst) {
      _Pragma("unroll") for (int a = 0; a < 2; ++a)
        _Pragma("unroll") for (int i = 0; i < 4; ++i)
          *(float4*)(dst + a * 32 + 8 * i + 4 * hf) = make_float4(v[a][4 * i], v[a][4 * i + 1], v[a][4 * i + 2], v[a][4 * i + 3]);
    };
    auto store_T = [&](u16* dst, int ld) {
      _Pragma("unroll") for (int a = 0; a < 2; ++a)
        _Pragma("unroll") for (int r = 0; r < 16; ++r) dst[(size_t)NLOC(a, r) * ld] = f2bf(v[a][r]);
    };

    u16* zrow = ((u16*)(p.ws + OFF_Z)) + (size_t)m * INW + nbase;
    if (nbase < 1024) {
      store_nat(zrow);
    } else if (nbase < 1280) {
      rmsn(p.q_gain + l * 64);
      if (!ctx) rope64();
      store_nat(zrow);
    } else if (nbase < 1408) {
      const int kvh = (nbase - 1280) >> 6;
      rmsn(p.k_gain + l * 64);
      if (ctx) {
        store_f32(p.out + OUT_GK + ((size_t)(bb * 2 + l) * 256 + t) * 128 + kvh * 64);
        store_nat(zrow);
      } else {
        rope64();
        store_nat(((u16*)(p.ws + OFF_KG)) + ((size_t)bb * NKL + 512 + t) * 128 + kvh * 64);
      }
    } else if (nbase < 1536) {
      const int kvh = (nbase - 1408) >> 6;
      if (ctx) {
        store_f32(p.out + OUT_GV + ((size_t)(bb * 2 + l) * 256 + t) * 128 + kvh * 64);
        store_T(((u16*)(p.ws + OFF_VtGc)) + ((size_t)(bb * 2 + kvh) * 64) * 256 + kperm(t), 256);
      } else {
        store_T(((u16*)(p.ws + OFF_VtG)) + ((size_t)(bb * 2 + kvh) * 64) * NKL + 512 + kperm(t), NKL);
      }
    } else if (nbase < 2048) {
      store_nat(zrow);
    } else if (nbase < 2304) {
      _Pragma("unroll") for (int a = 0; a < 2; ++a)
        _Pragma("unroll") for (int r = 0; r < 16; ++r) v[a][r] *= 0.125f;
      store_nat(zrow);
    } else if (nbase < 2560) {
      const int hh = (nbase - 2304) >> 6;
      store_nat(zrow);
      if (ctx) store_T(((u16*)(p.ws + OFF_VtRc)) + ((size_t)(bb * 4 + hh) * 64) * 256 + kperm(t), 256);
      else store_T(((u16*)(p.ws + OFF_VtRl)) + ((size_t)(bb * 4 + hh) * 64) * 4096 + kperm(t), 4096);
    } else if (nbase < 2816) {
      store_nat(zrow);
    } else if (nbase < 3072) {
      if (!ctx) rope32();
      store_nat(zrow);
    } else if (nbase < 3328) {
      const int cb = nbase - 3072;
      if (ctx) {
        store_f32(p.out + OUT_DK + ((size_t)(bb * 2 + l) * 256 + t) * 256 + cb);
        store_nat(zrow);
      } else {
        rope32();
        store_nat(((u16*)(p.ws + OFF_KD)) + ((size_t)bb * NKL + 512 + t) * 256 + cb);
      }
    } else if (nbase < 3584) {
      const int cb = nbase - 3328, hh = cb >> 6;
      if (ctx) {
        store_f32(p.out + OUT_DV + ((size_t)(bb * 2 + l) * 256 + t) * 256 + cb);
        store_T(((u16*)(p.ws + OFF_VtDc)) + ((size_t)(bb * 4 + hh) * 64) * 256 + kperm(t), 256);
      } else {
        store_T(((u16*)(p.ws + OFF_VtD)) + ((size_t)(bb * 4 + hh) * 64) * NKL + 512 + kperm(t), NKL);
      }
    } else {
      store_nat(zrow);
    }
  }
}

DI void phaseA1(CPar& p, int l, unsigned char* smem) {
  const int w = otid() >> 6, wn = w >> 1, wt = w & 1;
  for (int tile = vblock(); tile < 30 * 160; tile += gridDim.x) {
    const int grp = tile / 800, rem = tile - grp * 800;
    const int tm = rem / 5, tn = grp * 5 + (rem - tm * 5);
    f32x16 acc[2][4];
    _Pragma("unroll") for (int a = 0; a < 2; ++a)
      _Pragma("unroll") for (int b = 0; b < 4; ++b) acc[a][b] = zero16();
    gemm_acc<4>(((u16*)(p.ws + OFF_WinT)) + (size_t)l * 3840 * 1024 + ((size_t)(tn * 32) << 12), ((u16*)(p.ws + OFF_H)) + ((size_t)(tm * 2 * 32) << 12), 32 * 4096, 32, acc, (u16*)smem);
    a1_epilogue<4>(p, l, tn * 128 + wn * 64, tm * 256 + wt * 128, acc, smem);
    __syncthreads();
  }
}

DI void ld8(const u16* ptr, float (&f)[8]) {
  const uint4 v = *(const uint4*)ptr;
  f[0] = bflo(v.x); f[1] = bfhi(v.x); f[2] = bflo(v.y); f[3] = bfhi(v.y);
  f[4] = bflo(v.z); f[5] = bfhi(v.z); f[6] = bflo(v.w); f[7] = bfhi(v.w);
}

DI void conv_items(CPar& p, int l) {
  const int gt = blockIdx.x * 256 + otid(), nt = gridDim.x * 256;
  const float* cw = p.conv_w + l * 768;
  for (int idx = gt; idx < MT * 32; idx += nt) {
    const int m = idx >> 5, c8 = (idx & 31) * 8;
    int t, T;
    if (m < MC) { t = m & 255; T = 256; } else { t = (m - MC) & 4095; T = 4096; }
    const u16* zr = ((u16*)(p.ws + OFF_Z)) + (size_t)m * INW + c8;
    float bg[8], gt8[8], cgc[8], uc[8], gp[8], gn[8];
    ld8(zr, bg); ld8(zr + 768, gt8); ld8(zr + 256, cgc); ld8(zr + 512, uc);
    if (t > 0) { float a[8], b[8]; ld8(zr - INW + 256, a); ld8(zr - INW + 512, b); _Pragma("unroll") for (int i = 0; i < 8; ++i) gp[i] = a[i] * b[i]; }
    else { _Pragma("unroll") for (int i = 0; i < 8; ++i) gp[i] = 0.f; }
    if (t < T - 1) { float a[8], b[8]; ld8(zr + INW + 256, a); ld8(zr + INW + 512, b); _Pragma("unroll") for (int i = 0; i < 8; ++i) gn[i] = a[i] * b[i]; }
    else { _Pragma("unroll") for (int i = 0; i < 8; ++i) gn[i] = 0.f; }
    float y[8];
    _Pragma("unroll") for (int i = 0; i < 8; ++i) {
      const float w0 = cw[c8 + i], w1 = cw[256 + c8 + i], w2 = cw[512 + c8 + i];
      const float g = cgc[i] * uc[i];
      y[i] = bg[i] * (w0 * gp[i] + w1 * g + w2 * gn[i]) * silu_f(gt8[i]);
    }
    *(uint4*)(((u16*)(p.ws + OFF_Y)) + tix(m, c8, 32)) = make_uint4(pack2(y[0], y[1]), pack2(y[2], y[3]), pack2(y[4], y[5]), pack2(y[6], y[7]));
  }
}

DI float log_gamma(CPar& p, int l, int dir, int h) {
  const float x = p.ret_decay[(l * 2 + dir) * 4 + h];
  return -log1pf(expf(-x));
}

DI void ret_decode(int item, bool& ctx, int& bb, int& h, int& c, int& m0) {
  if (item < 256) { ctx = true; c = item & 1; h = (item >> 1) & 3; bb = item >> 3; m0 = bb * 256 + c * 128; }
  else { const int it = item - 256; ctx = false; c = it & 31; h = (it >> 5) & 3; bb = it >> 7; m0 = MC + bb * 4096 + c * 128; }
}

DI void r1_items(CPar& p, int l, unsigned char* smem) {
  const int tid = otid();
  u16* sK = (u16*)smem;
  u16* sV = sK + 128 * 64;
  float* wf = (float*)(sV + 128 * 64);
  float* wb = wf + 128;
  for (int item = blockIdx.x; item < 1280; item += gridDim.x) {
    bool ctx; int bb, h, c, m0;
    ret_decode(item, ctx, bb, h, c, m0);
    const float lgf = log_gamma(p, l, 0, h), lgb = log_gamma(p, l, 1, h);
    __syncthreads();
    _Pragma("unroll") for (int i = 0; i < 4; ++i) {
      const int cidx = tid + 256 * i, row = cidx >> 3, kc = cidx & 7;
      const u16* zr = ((u16*)(p.ws + OFF_Z)) + (size_t)(m0 + row) * INW + h * 64 + kc * 8;
      *(uint4*)(sK + row * 64 + kc * 8) = *(const uint4*)(zr + 2048);
      *(uint4*)(sV + row * 64 + kc * 8) = *(const uint4*)(zr + 2304);
    }
    if (tid < 128) { wf[tid] = expf(lgf * (float)(127 - tid)); wb[tid] = expf(lgb * (float)tid); }
    __syncthreads();
    const int dk0 = (tid >> 4) * 4, dv0 = (tid & 15) * 4;
    float uf[4][4], ub[4][4];
    _Pragma("unroll") for (int i = 0; i < 4; ++i)
      _Pragma("unroll") for (int j = 0; j < 4; ++j) { uf[i][j] = 0.f; ub[i][j] = 0.f; }
    for (int j = 0; j < 128; ++j) {
      const uint2 kv = *(const uint2*)(sK + j * 64 + dk0);
      const uint2 vv = *(const uint2*)(sV + j * 64 + dv0);
      const float k4[4] = {bflo(kv.x), bfhi(kv.x), bflo(kv.y), bfhi(kv.y)};
      const float v4[4] = {bflo(vv.x), bfhi(vv.x), bflo(vv.y), bfhi(vv.y)};
      const float a = wf[j], b = wb[j];
      _Pragma("unroll") for (int i = 0; i < 4; ++i) {
        const float kf = k4[i] * a, kb = k4[i] * b;
        _Pragma("unroll") for (int q = 0; q < 4; ++q) { uf[i][q] += kf * v4[q]; ub[i][q] += kb * v4[q]; }
      }
    }
    float* uo = ((float*)(p.ws + OFF_U)) + (size_t)item * 2 * 4096;
    _Pragma("unroll") for (int i = 0; i < 4; ++i) {
      *(float4*)(uo + (dk0 + i) * 64 + dv0) = make_float4(uf[i][0], uf[i][1], uf[i][2], uf[i][3]);
      *(float4*)(uo + 4096 + (dk0 + i) * 64 + dv0) = make_float4(ub[i][0], ub[i][1], ub[i][2], ub[i][3]);
    }
  }
}

template <bool CTX>
DI void r2_item(CPar& p, int l, int bi) {
  const int tid = otid();
  const int eb = bi & 15, dir = (bi >> 4) & 1, h = (bi >> 5) & 3, bb = bi >> 7;
  const int ep = eb * 256 + tid;
  const int dv = ep >> 6, dk = ep & 63;
  const int e = dk * 64 + dv;
  constexpr int nch = CTX ? 2 : 32;
  const int base = CTX ? (bb * 4 + h) * 2 : 256 + (bb * 4 + h) * 32;
  const float gC = expf(log_gamma(p, l, dir, h) * 128.f);
  float S = CTX ? 0.f : p.state_ret[((((size_t)bb * 2 + l) * 2 + dir) * 4 + h) * 4096 + e];
  float u[nch];
  _Pragma("unroll") for (int i = 0; i < nch; ++i) {
    const int c = dir ? (nch - 1 - i) : i;
    u[i] = ((float*)(p.ws + OFF_U))[((size_t)(base + c) * 2 + dir) * 4096 + e];
  }
  _Pragma("unroll") for (int i = 0; i < nch; ++i) {
    const int c = dir ? (nch - 1 - i) : i;
    ((u16*)(p.ws + OFF_SinT))[((size_t)(base + c) * 2 + dir) * 4096 + ep] = f2bf(S);
    S = S * gC + u[i];
  }
  if (CTX) p.out[OUT_ST + ((((size_t)bb * 2 + l) * 2 + dir) * 4 + h) * 4096 + e] = S;
}

template <bool DIFF>
DI void attn_item(CPar& p, int l, bool ctx, int bb, int unit, int qb, unsigned char* smem) {
  const int tid = otid(), lane = tid & 63, w = tid >> 6, l31 = lane & 31, hf = lane >> 5;
  const int qi = w & 1, qs = w >> 1;
  const int mq = (ctx ? bb * 256 : MC + bb * 4096) + qb * 64 + qs * 32 + l31;
  const int nkeys = ctx ? 256 : NKL;
  const u16* Kp; const u16* Vt; int ldk, ldv;
  if (!DIFF) {
    if (ctx) { Kp = ((u16*)(p.ws + OFF_Z)) + (size_t)(bb * 256) * INW + 1280 + unit * 64; ldk = INW; Vt = ((u16*)(p.ws + OFF_VtGc)) + ((size_t)(bb * 2 + unit) * 64) * 256; ldv = 256; }
    else { Kp = ((u16*)(p.ws + OFF_KG)) + (size_t)bb * NKL * 128 + unit * 64; ldk = 128; Vt = ((u16*)(p.ws + OFF_VtG)) + ((size_t)(bb * 2 + unit) * 64) * NKL; ldv = NKL; }
  } else {
    if (ctx) { Kp = ((u16*)(p.ws + OFF_Z)) + (size_t)(bb * 256) * INW + 3072 + unit * 64; ldk = INW; Vt = ((u16*)(p.ws + OFF_VtDc)) + ((size_t)(bb * 4 + unit) * 64) * 256; ldv = 256; }
    else { Kp = ((u16*)(p.ws + OFF_KD)) + (size_t)bb * NKL * 256 + unit * 64; ldk = 256; Vt = ((u16*)(p.ws + OFF_VtD)) + ((size_t)(bb * 4 + unit) * 64) * NKL; ldv = NKL; }
  }
  constexpr int NS = DIFF ? 2 : 4;
  bf16x8 qf[NS];
  {
    const u16* zq = ((u16*)(p.ws + OFF_Z)) + (size_t)mq * INW + (DIFF ? 2816 + unit * 64 + qi * 32 : 1024 + (unit * 2 + qi) * 64) + hf * 8;
    _Pragma("unroll") for (int s = 0; s < NS; ++s) qf[s] = *(const bf16x8*)(zq + s * 16);
  }
  const float sc = (DIFF ? 0.17677669529663687f : 0.125f) * 1.4426950408889634f;
  f32x16 O[2];
  O[0] = zero16(); O[1] = zero16();
  float mref = -1e30f, lsum = 0.f;

  char* smb = (char*)smem;
  constexpr int STGB = 16384;
  const int lr = tid >> 3, gch = (tid & 7) ^ ((lr >> 1) & 7);
  const u16* gk = Kp + (size_t)lr * ldk + gch * 8;
  const u16* gv = Vt + (size_t)lr * ldv + gch * 8;
  const int wv = __builtin_amdgcn_readfirstlane(w);
  char* smw = smb + wv * 1024;
  const u16* pk0 = gk; const u16* pk1 = gk + (size_t)32 * ldk;
  const u16* pv0 = gv; const u16* pv1 = gv + (size_t)32 * ldv;
  const size_t kstep = (size_t)64 * ldk;
#define ATT_STAGE(ST) do { \
    __builtin_amdgcn_global_load_lds((const unsigned*)pk0, (unsigned*)(smw + (ST) * STGB), 16, 0, 0); pk0 += kstep; \
    __builtin_amdgcn_global_load_lds((const unsigned*)pk1, (unsigned*)(smw + (ST) * STGB + 4096), 16, 0, 0); pk1 += kstep; \
    __builtin_amdgcn_global_load_lds((const unsigned*)pv0, (unsigned*)(smw + (ST) * STGB + 8192), 16, 0, 0); pv0 += 64; \
    __builtin_amdgcn_global_load_lds((const unsigned*)pv1, (unsigned*)(smw + (ST) * STGB + 8192 + 4096), 16, 0, 0); pv1 += 64; \
  } while (0)
  const int nt = nkeys >> 6;
  __syncthreads();
  VMWAIT(0);
  ATT_STAGE(0); ATT_STAGE(1); ATT_STAGE(2);
  const int sw = (l31 >> 1) & 7;
  const int kq0 = DIFF ? qi * 4 : 0;
  for (int kt = 0; kt < nt; ++kt) {
    if (kt + 2 < nt) VMWAIT(8); else if (kt + 1 < nt) VMWAIT(4); else VMWAIT(0);
    RAW_BARRIER();
    if (kt + 3 < nt) ATT_STAGE((kt + 3) & 3);
    __builtin_amdgcn_sched_barrier(0);
    const char* sK = smb + (kt & 3) * STGB;
    const char* sV = sK + 8192;
    f32x16 S[2];
    {
      bf16x8 kf[NS][2];
      _Pragma("unroll") for (int s = 0; s < NS; ++s)
        _Pragma("unroll") for (int k2 = 0; k2 < 2; ++k2)
          kf[s][k2] = *(const bf16x8*)(sK + (k2 * 32 + l31) * 128 + (((kq0 + 2 * s + hf) ^ sw) << 4));
      __builtin_amdgcn_sched_barrier(0);
      _Pragma("unroll") for (int s = 0; s < NS; ++s)
        _Pragma("unroll") for (int k2 = 0; k2 < 2; ++k2) {
          if (s == 0) { const f32x16 zc = {0.f, 0.f, 0.f, 0.f, 0.f, 0.f, 0.f, 0.f, 0.f, 0.f, 0.f, 0.f, 0.f, 0.f, 0.f, 0.f}; S[k2] = MFMA32(kf[s][k2], qf[s], zc); }
          else S[k2] = MFMA32(kf[s][k2], qf[s], S[k2]);
        }
    }
    bf16x8 vfr[2][4];
    _Pragma("unroll") for (int a = 0; a < 2; ++a)
      _Pragma("unroll") for (int s2 = 0; s2 < 4; ++s2)
        vfr[a][s2] = *(const bf16x8*)(sV + (a * 32 + l31) * 128 + (((2 * s2 + hf) ^ sw) << 4));
    __builtin_amdgcn_sched_barrier(0);
    float mx = S[0][0];
    _Pragma("unroll") for (int k2 = 0; k2 < 2; ++k2)
      _Pragma("unroll") for (int r = 0; r < 16; ++r) mx = fmaxf(mx, S[k2][r]);
    mx = xhalf_max(mx);
    const float mxs = mx * sc;
    if (__builtin_amdgcn_ballot_w64(mxs > mref + 8.f) != 0ull) {
      const float mnew = (mxs > mref + 8.f) ? mxs : mref;
      const float alpha = __builtin_amdgcn_exp2f(mref - mnew);
      mref = mnew;
      lsum *= alpha;
      _Pragma("unroll") for (int a = 0; a < 2; ++a)
        _Pragma("unroll") for (int r = 0; r < 16; ++r) O[a][r] *= alpha;
    }
    const f32x2 sc2 = {sc, sc}, nm2 = {-mref, -mref};
    f32x2 ps2 = {0.f, 0.f};
    bf16x8 pf[4];
    _Pragma("unroll") for (int k2 = 0; k2 < 2; ++k2)
      _Pragma("unroll") for (int u = 0; u < 2; ++u) {
        u32x4 pk;
        _Pragma("unroll") for (int j = 0; j < 4; ++j) {
          f32x2 v = {S[k2][8 * u + 2 * j], S[k2][8 * u + 2 * j + 1]};
          v = v * sc2 + nm2;
          f32x2 e;
          e.x = __builtin_amdgcn_exp2f(v.x);
          e.y = __builtin_amdgcn_exp2f(v.y);
          ps2 += e;
          pk[j] = pack2(e.x, e.y);
        }
        pf[2 * k2 + u] = __builtin_bit_cast(bf16x8, pk);
      }
    lsum += ps2.x + ps2.y;
    _Pragma("unroll") for (int a = 0; a < 2; ++a)
      _Pragma("unroll") for (int s2 = 0; s2 < 4; ++s2) {
        O[a] = MFMA32(vfr[a][s2], pf[s2], O[a]);
      }
  }
  RAW_BARRIER();
#undef ATT_STAGE
  const float inv = 1.f / xhalf_sum(lsum);
  const u16* zg = ((u16*)(p.ws + OFF_Z)) + (size_t)mq * INW;
  if (!DIFF) {
    _Pragma("unroll") for (int a = 0; a < 2; ++a)
      _Pragma("unroll") for (int i = 0; i < 4; ++i) {
        const int col = (unit * 2 + qi) * 64 + a * 32 + 8 * i + 4 * hf;
        const uint2 gv2 = *(const uint2*)(zg + 1536 + col);
        const float y0 = O[a][4 * i + 0] * inv * silu_f(bflo(gv2.x));
        const float y1 = O[a][4 * i + 1] * inv * silu_f(bfhi(gv2.x));
        const float y2 = O[a][4 * i + 2] * inv * silu_f(bflo(gv2.y));
        const float y3 = O[a][4 * i + 3] * inv * silu_f(bfhi(gv2.y));
        *(uint2*)(((u16*)(p.ws + OFF_Y)) + tix(mq, 256 + col, 32)) = make_uint2(pack2(y0, y1), pack2(y2, y3));
      }
  } else {
    float* xb = (float*)smem + qs * 32 * 64;
    if (qi == 1) {
      _Pragma("unroll") for (int a = 0; a < 2; ++a)
        _Pragma("unroll") for (int r = 0; r < 16; ++r) xb[(a * 16 + r) * 64 + lane] = O[a][r] * inv;
    }
    __syncthreads();
    if (qi == 0) {
      const float* lp = p.diff_lambda + l * 128;
      float d1 = 0.f, d2 = 0.f;
      for (int i = 0; i < 32; ++i) { d1 += lp[i] * lp[32 + i]; d2 += lp[64 + i] * lp[96 + i]; }
      const float lam_init = 0.8f - 0.6f * expf(-0.3f * (float)l);
      const float lam = expf(d1) - expf(d2) + lam_init;
      float ss = 0.f;
      _Pragma("unroll") for (int a = 0; a < 2; ++a)
        _Pragma("unroll") for (int r = 0; r < 16; ++r) {
          const float o = O[a][r] * inv - lam * xb[(a * 16 + r) * 64 + lane];
          O[a][r] = o;
          ss += o * o;
        }
      ss = xhalf_sum(ss);
      const float rinv = rsqrtf(ss * (1.f / 64.f) + EPSN) * (1.f - lam_init);
      const float* gn = p.diff_gain + l * 64;
      _Pragma("unroll") for (int a = 0; a < 2; ++a)
        _Pragma("unroll") for (int i = 0; i < 4; ++i) {
          const int nl = a * 32 + 8 * i + 4 * hf;
          const int col = unit * 64 + nl;
          const uint2 gv2 = *(const uint2*)(zg + 3584 + col);
          const float4 g4 = *(const float4*)(gn + nl);
          const float y0 = O[a][4 * i + 0] * rinv * g4.x * silu_f(bflo(gv2.x));
          const float y1 = O[a][4 * i + 1] * rinv * g4.y * silu_f(bfhi(gv2.x));
          const float y2 = O[a][4 * i + 2] * rinv * g4.z * silu_f(bflo(gv2.y));
          const float y3 = O[a][4 * i + 3] * rinv * g4.w * silu_f(bfhi(gv2.y));
          *(uint2*)(((u16*)(p.ws + OFF_Y)) + tix(mq, 768 + col, 32)) = make_uint2(pack2(y0, y1), pack2(y2, y3));
        }
    }
  }
}

DI void r3_item(CPar& p, int l, int item, unsigned char* smem) {
  const int tid = otid(), lane = tid & 63, w = tid >> 6, l31 = lane & 31, hf = lane >> 5;
  bool ctx; int bb, h, c, m0;
  ret_decode(item, ctx, bb, h, c, m0);
  const int iq = w * 32 + l31;
  const int mq = m0 + iq;
  const float LOG2E = 1.4426950408889634f;
  const float lf2 = log_gamma(p, l, 0, h) * LOG2E, lb2 = log_gamma(p, l, 1, h) * LOG2E;
  u16* sK = (u16*)smem;
  u16* sV = sK + 128 * LSTR;
  constexpr int VSTR = 136;
  const u16* Vt = ctx ? ((u16*)(p.ws + OFF_VtRc)) + ((size_t)(bb * 4 + h) * 64) * 256 + c * 128 : ((u16*)(p.ws + OFF_VtRl)) + ((size_t)(bb * 4 + h) * 64) * 4096 + c * 128;
  const int ldv = ctx ? 256 : 4096;
  __syncthreads();
  _Pragma("unroll") for (int i = 0; i < 4; ++i) {
    const int cidx = tid + 256 * i;
    { const int row = cidx >> 3, kc = cidx & 7;
      *(uint4*)(sK + row * LSTR + kc * 8) = *(const uint4*)(((u16*)(p.ws + OFF_Z)) + (size_t)(m0 + row) * INW + 2048 + h * 64 + kc * 8); }
    { const int dv = cidx >> 4, kc = cidx & 15;
      *(uint4*)(sV + dv * VSTR + kc * 8) = *(const uint4*)(Vt + (size_t)dv * ldv + kc * 8); }
  }
  bf16x8 qf[4];
  {
    const u16* zq = ((u16*)(p.ws + OFF_Z)) + (size_t)mq * INW + 1792 + h * 64 + hf * 8;
    _Pragma("unroll") for (int s = 0; s < 4; ++s) qf[s] = *(const bf16x8*)(zq + s * 16);
  }
  __syncthreads();
  f32x16 O[2];
  O[0] = zero16(); O[1] = zero16();
  _Pragma("unroll 1") for (int kt = 0; kt < 2; ++kt) {
    f32x16 S[2];
    S[0] = zero16(); S[1] = zero16();
    _Pragma("unroll") for (int s = 0; s < 4; ++s)
      _Pragma("unroll") for (int k2 = 0; k2 < 2; ++k2) {
        const bf16x8 kf = *(const bf16x8*)(sK + (kt * 64 + k2 * 32 + l31) * LSTR + s * 16 + hf * 8);
        S[k2] = MFMA32(kf, qf[s], S[k2]);
      }
    bf16x8 pf[4];
    _Pragma("unroll") for (int k2 = 0; k2 < 2; ++k2) {
      _Pragma("unroll") for (int r = 0; r < 16; ++r) {
        const int jk = kt * 64 + k2 * 32 + 8 * (r >> 2) + 4 * hf + (r & 3);
        const int d = iq - jk;
        float wgt;
        if (d > 0) wgt = __builtin_amdgcn_exp2f(lf2 * (float)d);
        else if (d < 0) wgt = __builtin_amdgcn_exp2f(lb2 * (float)(-d));
        else wgt = 2.f;
        S[k2][r] *= wgt;
      }
      _Pragma("unroll") for (int u = 0; u < 2; ++u) {
        u32x4 pk;
        pk[0] = pack2(S[k2][8 * u + 0], S[k2][8 * u + 1]);
        pk[1] = pack2(S[k2][8 * u + 2], S[k2][8 * u + 3]);
        pk[2] = pack2(S[k2][8 * u + 4], S[k2][8 * u + 5]);
        pk[3] = pack2(S[k2][8 * u + 6], S[k2][8 * u + 7]);
        pf[2 * k2 + u] = __builtin_bit_cast(bf16x8, pk);
      }
    }
    _Pragma("unroll") for (int a = 0; a < 2; ++a)
      _Pragma("unroll") for (int s2 = 0; s2 < 4; ++s2) {
        const bf16x8 vf = *(const bf16x8*)(sV + (a * 32 + l31) * VSTR + kt * 64 + 16 * s2 + 8 * hf);
        O[a] = MFMA32(vf, pf[s2], O[a]);
      }
  }
  _Pragma("unroll") for (int dir = 0; dir < 2; ++dir) {
    const u16* st = ((u16*)(p.ws + OFF_SinT)) + ((size_t)item * 2 + dir) * 4096;
    const float dq = dir == 0 ? __builtin_amdgcn_exp2f(lf2 * (float)(iq + 1)) : __builtin_amdgcn_exp2f(lb2 * (float)(128 - iq));
    _Pragma("unroll") for (int a = 0; a < 2; ++a) {
      f32x16 X = zero16();
      _Pragma("unroll") for (int s = 0; s < 4; ++s) {
        const bf16x8 sf = *(const bf16x8*)(st + (a * 32 + l31) * 64 + s * 16 + hf * 8);
        X = MFMA32(sf, qf[s], X);
      }
      _Pragma("unroll") for (int r = 0; r < 16; ++r) O[a][r] += X[r] * dq;
    }
  }
  float ss = 0.f;
  _Pragma("unroll") for (int a = 0; a < 2; ++a)
    _Pragma("unroll") for (int r = 0; r < 16; ++r) ss += O[a][r] * O[a][r];
  ss = xhalf_sum(ss);
  const float rinv = rsqrtf(ss * (1.f / 64.f) + EPSN);
  const u16* zg = ((u16*)(p.ws + OFF_Z)) + (size_t)mq * INW + 2560 + h * 64;
  _Pragma("unroll") for (int a = 0; a < 2; ++a)
    _Pragma("unroll") for (int i = 0; i < 4; ++i) {
      const int nl = a * 32 + 8 * i + 4 * hf;
      const uint2 gv2 = *(const uint2*)(zg + nl);
      const float y0 = O[a][4 * i + 0] * rinv * silu_f(bflo(gv2.x));
      const float y1 = O[a][4 * i + 1] * rinv * silu_f(bfhi(gv2.x));
      const float y2 = O[a][4 * i + 2] * rinv * silu_f(bflo(gv2.y));
      const float y3 = O[a][4 * i + 3] * rinv * silu_f(bfhi(gv2.y));
      *(uint2*)(((u16*)(p.ws + OFF_Y)) + tix(mq, 512 + h * 64 + nl, 32)) = make_uint2(pack2(y0, y1), pack2(y2, y3));
    }
}

DI void phaseC(CPar& p, int l, unsigned char* smem) {
  const int lane = otid() & 63, w = otid() >> 6, wn = w >> 1, wt = w & 1, l31 = lane & 31, hf = lane >> 5;
  u16* Mg = ((u16*)(p.ws + OFF_Z));
  for (int tile = vblock(); tile < 8 * 320; tile += gridDim.x) {
    const int grp = tile / 640, rem = tile - grp * 640;
    const int tm = rem >> 1, tn = grp * 2 + (rem & 1);
    unsigned mgp[2][2][8];
    _Pragma("unroll") for (int a = 0; a < 2; ++a)
      _Pragma("unroll") for (int b = 0; b < 2; ++b)
        _Pragma("unroll") for (int r = 0; r < 8; ++r) mgp[a][b][r] = 0u;
    const u16* Ht = ((u16*)(p.ws + OFF_H)) + ((size_t)(tm * 32) << 12);
    _Pragma("unroll 1") for (int pr = 0; pr < 2; ++pr) {
      unsigned gp[2][4][8];
      {
        f32x16 acc[2][4];
        _Pragma("unroll") for (int a = 0; a < 2; ++a)
          _Pragma("unroll") for (int b = 0; b < 4; ++b) acc[a][b] = zero16();
        gemm_acc<4, true, true>(Ht, ((u16*)(p.ws + OFF_WgT)) + (size_t)l * 4096 * 1024 + ((size_t)((pr * 16 + tn) * 32) << 12), 8 * 32 * 4096, 32, acc, (u16*)smem);
        _Pragma("unroll") for (int a = 0; a < 2; ++a)
          _Pragma("unroll") for (int b = 0; b < 4; ++b)
            _Pragma("unroll") for (int r = 0; r < 8; ++r) gp[a][b][r] = pack2(sigmoid_f(acc[a][b][2 * r]), sigmoid_f(acc[a][b][2 * r + 1]));
      }
      _Pragma("unroll") for (int bh = 0; bh < 2; ++bh) {
        const int br = pr * 2 + bh;
        f32x16 acc[2][2];
        _Pragma("unroll") for (int a = 0; a < 2; ++a)
          _Pragma("unroll") for (int b = 0; b < 2; ++b) acc[a][b] = zero16();
        gemm_acc<2, false, true>(((u16*)(p.ws + OFF_Y)) + ((size_t)(tm * 32 + br * 8) << 12), ((u16*)(p.ws + OFF_WbT)) + (size_t)l * 1024 * 1024 + ((size_t)(tn * 32 + br * 8) << 12), 0, 8, acc, (u16*)smem);
        _Pragma("unroll") for (int a = 0; a < 2; ++a)
          _Pragma("unroll") for (int b = 0; b < 2; ++b)
            _Pragma("unroll") for (int r = 0; r < 8; ++r)
              mgp[a][b][r] = pack2(bflo(mgp[a][b][r]) + bflo(gp[a][bh * 2 + b][r]) * acc[a][b][2 * r], bfhi(mgp[a][b][r]) + bfhi(gp[a][bh * 2 + b][r]) * acc[a][b][2 * r + 1]);
      }
    }
    _Pragma("unroll") for (int a = 0; a < 2; ++a)
      _Pragma("unroll") for (int b = 0; b < 2; ++b) {
        const int n = tn * 128 + wt * 64 + b * 32 + l31;
        _Pragma("unroll") for (int r = 0; r < 8; ++r) {
          const int t0 = tm * 128 + wn * 64 + a * 32 + 8 * ((2 * r) >> 2) + 4 * hf + ((2 * r) & 3);
          Mg[tix(t0, n, 32)] = (u16)(mgp[a][b][r] & 0xffffu);
          Mg[tix(t0 + 1, n, 32)] = (u16)(mgp[a][b][r] >> 16);
        }
      }
  }
}

template <int TB>
DI void d_epilogue(CPar& p, int l, int tm, int nb0, f32x16 (&acc)[2][TB]) {
  const int lane = otid() & 63, w = otid() >> 6, wn = w >> 1, wt = w & 1, l31 = lane & 31, hf = lane >> 5;
  const int m0 = tm * 128 + wn * 64;
  const int j = m0 < MC ? 0 : 1 + ((m0 - MC) >> 12);
  const float* gate = ((float*)(p.ws + OFF_mod)) + (l * 9 + j) * 3072 + 2048;
  const float* xsrc = (l == 0) ? (m0 < MC ? p.x_prompt : p.x_sample - (size_t)MC * 1024) : p.out;
  _Pragma("unroll") for (int b = 0; b < TB; ++b) {
    const int n = (TB == 2) ? nb0 + wt * 64 + b * 32 + l31 : nb0 + (b >> 1) * 128 + wt * 64 + (b & 1) * 32 + l31;
    const float gv = gate[n];
    const size_t o0 = (size_t)(m0 + 4 * hf) * 1024 + n;
    const float* xp = xsrc + o0;
    float* op = p.out + o0;
    _Pragma("unroll") for (int a = 0; a < 2; ++a)
      _Pragma("unroll") for (int i = 0; i < 4; ++i) {
        float xv[4];
        _Pragma("unroll") for (int q = 0; q < 4; ++q) xv[q] = xp[q * 1024];
        _Pragma("unroll") for (int q = 0; q < 4; ++q) op[q * 1024] = xv[q] + gv * acc[a][b][4 * i + q];
        xp += 8 * 1024; op += 8 * 1024;
        asm volatile("" : "+v"(xp), "+v"(op));
      }
  }
}

DI void phaseD(CPar& p, int l, unsigned char* smem) {
  const u16* Mg = ((u16*)(p.ws + OFF_Z));
  const u16* Wo = ((u16*)(p.ws + OFF_WoT)) + (size_t)l * 1024 * 1024;
  for (int tile = vblock(); tile < 1024 + 512; tile += gridDim.x) {
    if (tile < 1024) {
      const int np = tile & 3, tm = tile >> 2;
      f32x16 acc[2][4];
      _Pragma("unroll") for (int a = 0; a < 2; ++a)
        _Pragma("unroll") for (int b = 0; b < 4; ++b) acc[a][b] = zero16();
      gemm_acc<4, true>(Mg + ((size_t)(tm * 32) << 12), Wo + ((size_t)(np * 2 * 32) << 12), 32 * 4096, 32, acc, (u16*)smem);
      d_epilogue<4>(p, l, tm, np * 256, acc);
    } else {
      const int t2 = tile - 1024, big = 1024 + (t2 >> 1), np = big & 3, tm = big >> 2, tn = np * 2 + (t2 & 1);
      f32x16 acc[2][2];
      _Pragma("unroll") for (int a = 0; a < 2; ++a)
        _Pragma("unroll") for (int b = 0; b < 2; ++b) acc[a][b] = zero16();
      gemm_acc<2>(Mg + ((size_t)(tm * 32) << 12), Wo + ((size_t)(tn * 32) << 12), 0, 32, acc, (u16*)smem);
      d_epilogue<2>(p, l, tm, tn * 128, acc);
    }
  }
}

DI void phaseFinal(CPar& p) {
  const int tid = otid(), lane = tid & 63;
  const int gw = blockIdx.x * 4 + (tid >> 6), nw = gridDim.x * 4;
  for (int row = gw; row < MT; row += nw) {
    float* xr = p.out + (size_t)row * 1024;
    float4 v[4];
    float ss = 0.f;
    _Pragma("unroll") for (int i = 0; i < 4; ++i) {
      v[i] = ((const float4*)xr)[lane + 64 * i];
      ss += v[i].x * v[i].x + v[i].y * v[i].y + v[i].z * v[i].z + v[i].w * v[i].w;
    }
    ss = wave_sum(ss);
    const float rstd = rsqrtf(ss * (1.f / 1024.f) + EPSN);
    _Pragma("unroll") for (int i = 0; i < 4; ++i) {
      const float4 g = *(const float4*)(p.final_gain + 4 * (lane + 64 * i));
      ((float4*)xr)[lane + 64 * i] = make_float4(v[i].x * rstd * g.x, v[i].y * rstd * g.y, v[i].z * rstd * g.z, v[i].w * rstd * g.w);
    }
  }
}

__global__ void __launch_bounds__(256, 2) hybrid_megakernel(Params p_unused) {
  cg::grid_group grid = cg::this_grid();
  __shared__ __attribute__((aligned(16))) unsigned char smem[SMEM_BYTES];
  __shared__ uint4 xb_words;
  if (threadIdx.x == 0) xb_words = make_uint4(0u, 0u, 0u, 0u);
  __syncthreads();
  XcdBarrier xb = xcd_barrier_post(((unsigned*)(PP().ws + OFF_bar)), (volatile LAS unsigned*)&xb_words);
  phase0(PP(), smem);
  grid.sync();
  _Pragma("unroll 1") for (int l = 0; l < 2; ++l) {
    phaseA0(PP(), l);
    xcd_barrier(xb);
    phaseA1(PP(), l, smem);
    xcd_barrier(xb);
    conv_items(PP(), l);
    r1_items(PP(), l, smem);
    xcd_barrier(xb);
    for (int rep = 0; rep < REP_B2; ++rep)
    for (int it = vblock(); it < 1024 + 1024 + 2048 + 256 + 512 + 4096; it += gridDim.x) {
      if (it < 1024) r2_item<false>(PP(), l, it);
      else if (it < 2048) { const int i = it - 1024; attn_item<false>(PP(), l, false, i >> 7, (i >> 6) & 1, i & 63, smem); }
      else if (it < 4096) { const int i = it - 2048; attn_item<true>(PP(), l, false, i >> 8, (i >> 6) & 3, i & 63, smem); }
      else if (it < 4352) { const int i = it - 4096; attn_item<false>(PP(), l, true, i >> 3, (i >> 2) & 1, i & 3, smem); }
      else if (it < 4864) { const int i = it - 4352; attn_item<true>(PP(), l, true, i >> 4, (i >> 2) & 3, i & 3, smem); }
      else r2_item<true>(PP(), l, it - 4864);
    }
    xcd_barrier(xb);
    for (int it = vblock(); it < 1280; it += gridDim.x) r3_item(PP(), l, it, smem);
    xcd_barrier(xb);
    phaseC(PP(), l, smem);
    xcd_barrier(xb);
    phaseD(PP(), l, smem);
    xcd_barrier(xb);
  }
  phaseFinal(PP());
}

extern "C" void kernel_launch(void* const* d_in, const int* in_sizes, int n_in, void* d_out, int out_size, void* d_ws, size_t ws_size,
                              hipStream_t stream) {
  static int grid_blocks = 0;
  if (!grid_blocks) {
    int dev = 0, cus = 0, per_cu = 0;
    (void)hipGetDevice(&dev);
    (void)hipDeviceGetAttribute(&cus, hipDeviceAttributeMultiprocessorCount, dev);
    (void)hipOccupancyMaxActiveBlocksPerMultiprocessor(&per_cu, hybrid_megakernel, 256, 0);
    if (per_cu > 2) per_cu = 2;
    if (per_cu < 1) per_cu = 1;
    grid_blocks = cus * per_cu;
  }
  Params p{};
  const float** fin = (const float**)&p.x_prompt;
  for (int i = 0; i < 23; ++i) fin[i] = (const float*)d_in[i];
  p.out = (float*)d_out;
  p.ws = (unsigned char*)d_ws;
  const size_t off = WS_NEED;
  if (off > ws_size) { fprintf(stderr, "workspace too small: need %zu have %zu\n", off, ws_size); return; }
  (void)hipMemsetAsync(p.ws + OFF_bar, 0, XCD_BAR_WORDS * 4, stream);
  void* args[] = {&p};
  hipError_t e = hipLaunchCooperativeKernel((void*)hybrid_megakernel, dim3(grid_blocks), dim3(256), args, 0, stream);
  if (e != hipSuccess) fprintf(stderr, "cooperative launch failed: %s (grid %d)\n", hipGetErrorString(e), grid_blocks);
}
```

```cpp
#include <hip/hip_runtime.h>
#include <hip/hip_bf16.h>
#include <hip/hip_cooperative_groups.h>
#include <cstdio>
namespace cg = cooperative_groups;

typedef unsigned short u16;
using bf16x8 = __attribute__((ext_vector_type(8))) short;
using f32x16 = __attribute__((ext_vector_type(16))) float;
using u32x4 = __attribute__((ext_vector_type(4))) unsigned;
using u32x2 = __attribute__((ext_vector_type(2))) unsigned;

#define DI __device__ __forceinline__
#define MFMA32(a, b, c) __builtin_amdgcn_mfma_f32_32x32x16_bf16((a), (b), (c), 0, 0, 0)

#ifndef REP_A1
#define REP_A1 1
#endif
#ifndef REP_B2
#define REP_B2 1
#endif
#ifndef PIPE_C
#define PIPE_C true
#endif
constexpr int DM = 1024;
constexpr int INW = 3840;
constexpr int MC = 8192;
constexpr int MT = 40960;
constexpr int NKL = 4608;
constexpr int LSTR = 72;
constexpr float EPSN = 1e-6f;
constexpr int SMEM_BYTES = 2 * 2 * 128 * LSTR * 2;

constexpr size_t OUT_GK = 41943040ull;
constexpr size_t OUT_GV = 44040192ull;
constexpr size_t OUT_DK = 46137344ull;
constexpr size_t OUT_DV = 50331648ull;
constexpr size_t OUT_ST = 54525952ull;

constexpr size_t OFF_WinT = 0ull;
constexpr size_t OFF_WgT = 15728640ull;
constexpr size_t OFF_WbT = 32505856ull;
constexpr size_t OFF_WoT = 36700160ull;
constexpr size_t OFF_mod = 40894464ull;
constexpr size_t OFF_rope = 41115648ull;
constexpr size_t OFF_H = 41123840ull;
constexpr size_t OFF_Z = 125009920ull;
constexpr size_t OFF_KG = 439582720ull;
constexpr size_t OFF_VtG = 449019904ull;
constexpr size_t OFF_KD = 458457088ull;
constexpr size_t OFF_VtD = 477331456ull;
constexpr size_t OFF_VtGc = 496205824ull;
constexpr size_t OFF_VtDc = 498302976ull;
constexpr size_t OFF_VtRc = 502497280ull;
constexpr size_t OFF_VtRl = 506691584ull;
constexpr size_t OFF_U = 523468800ull;
constexpr size_t OFF_SinT = 565411840ull;
constexpr size_t OFF_Y = 586383360ull;
constexpr size_t OFF_bar = 670269440ull;
constexpr size_t WS_NEED = 670283264ull;
struct Params {
  const float *x_prompt, *x_sample, *cache_gk, *cache_gv, *cache_dk, *cache_dv, *state_ret, *c, *c_ctx, *w_ada, *b_ada,
      *norm_gain, *w_in, *conv_w, *q_gain, *k_gain, *ret_decay, *diff_lambda, *diff_gain, *w_branch, *w_mgate, *w_out, *final_gain;
  float* out;
  unsigned char* ws;
};

typedef float f32x2 __attribute__((ext_vector_type(2)));
typedef __bf16 bf16x2_t __attribute__((ext_vector_type(2)));
typedef const Params __attribute__((address_space(4))) CPar;
DI CPar& PP() { CPar* q = (CPar*)__builtin_amdgcn_kernarg_segment_ptr(); asm volatile("" : "+s"(q)); return *q; }
DI unsigned pack2(float a, float b) {
  const f32x2 v = {a, b};
  return __builtin_bit_cast(unsigned, __builtin_convertvector(v, bf16x2_t));
}
DI u16 f2bf(float a) { return (u16)(pack2(a, 0.f) & 0xffffu); }
DI float bflo(unsigned v) { return __uint_as_float(v << 16); }
DI float bfhi(unsigned v) { return __uint_as_float(v & 0xffff0000u); }
DI float silu_f(float x) { return x / (1.f + __expf(-x)); }
DI float sigmoid_f(float x) { return 1.f / (1.f + __expf(-x)); }
DI f32x16 zero16() { f32x16 z; _Pragma("unroll") for (int i = 0; i < 16; ++i) z[i] = 0.f; return z; }
DI int otid() { int t = (int)__builtin_amdgcn_workitem_id_x(); asm volatile("" : "+v"(t)); return t; }
DI int vblock() { const int b = (int)blockIdx.x, g = (int)gridDim.x; return ((g & 7) == 0) ? (b & 7) * (g >> 3) + (b >> 3) : b; }
DI size_t tix(int r, int k, int ksl) { return ((size_t)((r >> 7) * ksl + (k >> 5)) << 12) + ((r & 127) << 5) + (k & 31); }
#define XB_TMO      128
#define XB_XCNT(j)  (256  + 64 * (j))
#define XB_XSUB(j)  (1280 + 64 * (j))
#define XB_XGEN(j)  (2304 + 64 * (j))
#define XB_TOP      3328
#define XB_TOPGEN   3392
#define XCD_BAR_WORDS 3456
#define XB_SPIN_CAP (1u << 18)
#define LAS __attribute__((address_space(3)))

__device__ __forceinline__ unsigned xb_ld(unsigned* p)              { return __hip_atomic_load(p, __ATOMIC_RELAXED, __HIP_MEMORY_SCOPE_AGENT); }
__device__ __forceinline__ unsigned xb_add(unsigned* p, unsigned v) { return __hip_atomic_fetch_add(p, v, __ATOMIC_RELAXED, __HIP_MEMORY_SCOPE_AGENT); }
__device__ __forceinline__ unsigned xb_xcc_id() { return (unsigned)__builtin_amdgcn_s_getreg((3 << 11) | 20) & 0xFu; }
#define XB_SPIN(cond, bar) do { unsigned _sp = 0; while (cond) { __builtin_amdgcn_s_sleep(1); \
    if ((++_sp & 255u) == 0u) { if (xb_ld(&(bar)[XB_TMO])) break; if (_sp > XB_SPIN_CAP) { atomicAdd(&(bar)[XB_TMO], 1u); break; } } } } while (0)

struct XcdBarrier {
    unsigned* bar; unsigned x;
    volatile LAS unsigned* st;
};

__device__ __forceinline__ XcdBarrier xcd_barrier_post(unsigned* bar, volatile LAS unsigned* st) {
    XcdBarrier b; b.bar = bar; b.x = xb_xcc_id(); b.st = st;
    if (threadIdx.x == 0) (void)xb_add(&bar[XB_XCNT(b.x)], 1u);
    return b;
}
__device__ __forceinline__ void xcd_barrier_complete(unsigned* bar, unsigned x, unsigned& nloc, unsigned& nx) {
    const unsigned G = gridDim.x * gridDim.y * gridDim.z;
    unsigned sum, cnt, mine, sp = 0u;
    for (;;) {
        sum = 0u; cnt = 0u; mine = 0u;
#pragma unroll
        for (unsigned j = 0; j < 16; ++j) { const unsigned c = xb_ld(&bar[XB_XCNT(j)]); sum += c; cnt += (c > 0u) ? 1u : 0u; mine = (j == x) ? c : mine; }
        if (sum == G) break;
        __builtin_amdgcn_s_sleep(1);
        if ((++sp & 255u) == 0u) { if (xb_ld(&bar[XB_TMO])) break; if (sp > XB_SPIN_CAP) { atomicAdd(&bar[XB_TMO], 1u); break; } }
    }
    nloc = mine > 0u ? mine : 1u; nx = cnt > 0u ? cnt : 1u;
}

__device__ __forceinline__ void xcd_barrier(const XcdBarrier& b) {
    asm volatile("s_waitcnt vmcnt(0)" ::: "memory");
    __syncthreads();
    if (threadIdx.x == 0) {
        unsigned* bar = b.bar;
        __builtin_amdgcn_s_waitcnt(0);
        unsigned nloc = b.st[0], nx = b.st[1];
        if (nloc == 0u) { xcd_barrier_complete(bar, b.x, nloc, nx); b.st[0] = nloc; b.st[1] = nx; }
        const unsigned old = xb_add(&bar[XB_XSUB(b.x)], 1u);
        const unsigned gen = old / nloc;
        if (old + 1u == (gen + 1u) * nloc) {
            __builtin_amdgcn_fence(__ATOMIC_RELEASE, "agent");
            asm volatile("s_waitcnt vmcnt(0)" ::: "memory");
            const unsigned og = xb_add(&bar[XB_TOP], 1u);
            const unsigned tg = og / nx;
            if (og + 1u == (tg + 1u) * nx) xb_add(&bar[XB_TOPGEN], 1u);
            else XB_SPIN(xb_ld(&bar[XB_TOPGEN]) == tg, bar);
            __builtin_amdgcn_fence(__ATOMIC_ACQUIRE, "agent");
            xb_add(&bar[XB_XGEN(b.x)], 1u);
            asm volatile("s_waitcnt vmcnt(0)" ::: "memory");
        } else {
            XB_SPIN(xb_ld(&bar[XB_XGEN(b.x)]) == gen, bar);
            __builtin_amdgcn_fence(__ATOMIC_ACQUIRE, "agent");
            asm volatile("s_waitcnt vmcnt(0)" ::: "memory");
        }
    }
    __syncthreads();
}


DI int kperm(int t) { return (t & ~12) | ((t & 4) << 1) | ((t & 8) >> 1); }
DI float xhalf_max(float x) {
  const auto r = __builtin_amdgcn_permlane32_swap(__float_as_uint(x), __float_as_uint(x), false, false);
  return fmaxf(__uint_as_float(r[0]), __uint_as_float(r[1]));
}
DI float xhalf_sum(float x) {
  const auto r = __builtin_amdgcn_permlane32_swap(__float_as_uint(x), __float_as_uint(x), false, false);
  return __uint_as_float(r[0]) + __uint_as_float(r[1]);
}
DI float wave_sum(float v) {
  _Pragma("unroll") for (int o = 1; o < 64; o <<= 1) v += __shfl_xor(v, o);
  return v;
}

#define VMWAIT(N) asm volatile("s_waitcnt vmcnt(" #N ")" ::: "memory")
#define RAW_BARRIER() do { asm volatile("s_waitcnt lgkmcnt(0)" ::: "memory"); __builtin_amdgcn_s_barrier(); } while (0)
template <int TB, bool BMAP = false, bool LEAN = false>
DI void gemm_acc(const u16* __restrict__ A, const u16* __restrict__ B, int bstride, int nk, f32x16 (&acc)[2][TB], u16* sm) {
  const int tid = otid(), lane = tid & 63, w = tid >> 6, wn = w >> 1, wt = w & 1, l31 = lane & 31, hf = lane >> 5;
  constexpr int NSTG = (TB == 2) ? 4 : 3;
  constexpr int RB = 64 * TB;
  constexpr int STGB = (128 + RB) * 64;
  constexpr int LPB = RB / 64;
  const int lr = tid >> 2, gsl = (tid & 3) ^ ((lr >> 2) & 3);
  const u16* ga = A + lr * 32 + gsl * 8;
  const u16* gb = B + lr * 32 + gsl * 8;
  char* smb = (char*)sm;
  const int wv = __builtin_amdgcn_readfirstlane(w);
  char* smw = smb + wv * 1024;
  const u16* pa[2];
  const u16* pb[LPB];
  _Pragma("unroll") for (int i = 0; i < 2; ++i) pa[i] = ga + 2048 * i;
  _Pragma("unroll") for (int i = 0; i < LPB; ++i) pb[i] = BMAP ? gb + (size_t)(i & 1) * bstride + 2048 * (i >> 1) : gb + (size_t)(i >> 1) * bstride + 2048 * (i & 1);
#define GEMM_STAGE(ST) do { \
    _Pragma("unroll") for (int i = 0; i < 2; ++i) { \
      __builtin_amdgcn_global_load_lds((const unsigned*)pa[i], (unsigned*)(smw + (ST) * STGB + i * 4096), 16, 0, 0); pa[i] += 4096; } \
    _Pragma("unroll") for (int i = 0; i < LPB; ++i) { \
      __builtin_amdgcn_global_load_lds((const unsigned*)pb[i], (unsigned*)(smw + (ST) * STGB + 8192 + i * 4096), 16, 0, 0); pb[i] += 4096; } \
  } while (0)
  VMWAIT(0);
  _Pragma("unroll") for (int s0 = 0; s0 < NSTG - 1; ++s0) GEMM_STAGE(s0);
  const int sw = (l31 >> 2) & 3;
  const int oa0 = (wn * 64 + l31) * 64 + ((hf ^ sw) << 4), oa1 = (wn * 64 + l31) * 64 + (((2 + hf) ^ sw) << 4);
  const int ob0 = 8192 + (wt * 32 * TB + l31) * 64 + ((hf ^ sw) << 4), ob1 = 8192 + (wt * 32 * TB + l31) * 64 + (((2 + hf) ^ sw) << 4);
  int st = 0, stn = NSTG - 1;
  bf16x8 dfa[2], dfb[TB];
  _Pragma("unroll") for (int a = 0; a < 2; ++a) dfa[a] = bf16x8{0, 0, 0, 0, 0, 0, 0, 0};
  _Pragma("unroll") for (int b = 0; b < TB; ++b) dfb[b] = bf16x8{0, 0, 0, 0, 0, 0, 0, 0};
  for (int kt = 0; kt < nk; ++kt) {
    if (kt + NSTG - 2 < nk) { if (TB == 2) VMWAIT(8); else VMWAIT(6); }
    else if (NSTG == 4 && kt + 1 < nk) VMWAIT(4);
    else VMWAIT(0);
    RAW_BARRIER();
    if (kt + NSTG - 1 < nk) GEMM_STAGE(stn);
    __builtin_amdgcn_sched_barrier(0);
    const char* sb = smb + st * STGB;
    if (!LEAN) {
      bf16x8 fa0[2], fb0[TB], fa1[2], fb1[TB];
      _Pragma("unroll") for (int a = 0; a < 2; ++a) fa0[a] = *(const bf16x8*)(sb + oa0 + a * 2048);
      _Pragma("unroll") for (int b = 0; b < TB; ++b) fb0[b] = *(const bf16x8*)(sb + ob0 + b * 2048);
      _Pragma("unroll") for (int a = 0; a < 2; ++a) fa1[a] = *(const bf16x8*)(sb + oa1 + a * 2048);
      _Pragma("unroll") for (int b = 0; b < TB; ++b) fb1[b] = *(const bf16x8*)(sb + ob1 + b * 2048);
      __builtin_amdgcn_sched_barrier(0);
      _Pragma("unroll") for (int a = 0; a < 2; ++a)
        _Pragma("unroll") for (int b = 0; b < TB; ++b) acc[a][b] = MFMA32(dfa[a], dfb[b], acc[a][b]);
      __builtin_amdgcn_sched_barrier(0);
      _Pragma("unroll") for (int a = 0; a < 2; ++a)
        _Pragma("unroll") for (int b = 0; b < TB; ++b) acc[a][b] = MFMA32(fa0[a], fb0[b], acc[a][b]);
      __builtin_amdgcn_sched_barrier(0);
      _Pragma("unroll") for (int a = 0; a < 2; ++a) dfa[a] = fa1[a];
      _Pragma("unroll") for (int b = 0; b < TB; ++b) dfb[b] = fb1[b];
    } else {
      _Pragma("unroll") for (int ks = 0; ks < 2; ++ks) {
        bf16x8 fa[2], fb[TB];
        _Pragma("unroll") for (int a = 0; a < 2; ++a) fa[a] = *(const bf16x8*)(sb + (ks ? oa1 : oa0) + a * 2048);
        _Pragma("unroll") for (int b = 0; b < TB; ++b) fb[b] = *(const bf16x8*)(sb + (ks ? ob1 : ob0) + b * 2048);
        __builtin_amdgcn_sched_barrier(0);
        _Pragma("unroll") for (int a = 0; a < 2; ++a)
          _Pragma("unroll") for (int b = 0; b < TB; ++b) acc[a][b] = MFMA32(fa[a], fb[b], acc[a][b]);
        __builtin_amdgcn_sched_barrier(0);
      }
    }
    st = (st + 1 == NSTG) ? 0 : st + 1;
    stn = (stn + 1 == NSTG) ? 0 : stn + 1;
  }
  if (!LEAN) {
    _Pragma("unroll") for (int a = 0; a < 2; ++a)
      _Pragma("unroll") for (int b = 0; b < TB; ++b) acc[a][b] = MFMA32(dfa[a], dfb[b], acc[a][b]);
  }
  RAW_BARRIER();
#undef GEMM_STAGE
}

DI void phase0(CPar& p, unsigned char* smem) {
  const int tid = otid();
  float* tile = (float*)smem;
  for (int job = blockIdx.x; job < 4992; job += gridDim.x) {
    const int l = job / 2496;
    int rem = job - l * 2496;
    const float* src; u16* dst; int C;
    if (rem < 960) { src = p.w_in + (size_t)l * 1024 * 3840; dst = ((u16*)(p.ws + OFF_WinT)) + (size_t)l * 3840 * 1024; C = 3840; }
    else if (rem < 1984) { rem -= 960; src = p.w_mgate + (size_t)l * 1024 * 4096; dst = ((u16*)(p.ws + OFF_WgT)) + (size_t)l * 4096 * 1024; C = 4096; }
    else if (rem < 2240) { rem -= 1984; src = p.w_branch + (size_t)l * 1024 * 1024; dst = ((u16*)(p.ws + OFF_WbT)) + (size_t)l * 1024 * 1024; C = 1024; }
    else { rem -= 2240; src = p.w_out + (size_t)l * 1024 * 1024; dst = ((u16*)(p.ws + OFF_WoT)) + (size_t)l * 1024 * 1024; C = 1024; }
    const int tr = rem & 15, tc = rem >> 4;
    const int r0 = tr * 64, c0 = tc * 64;
    __syncthreads();
    _Pragma("unroll") for (int i = 0; i < 4; ++i) {
      const int rr = (tid >> 4) + 16 * i, cc = (tid & 15) * 4;
      const float4 v = *(const float4*)(src + (size_t)(r0 + rr) * C + c0 + cc);
      tile[rr * 65 + cc + 0] = v.x; tile[rr * 65 + cc + 1] = v.y; tile[rr * 65 + cc + 2] = v.z; tile[rr * 65 + cc + 3] = v.w;
    }
    __syncthreads();
    {
      const int n = tid >> 2, kq = (tid & 3) * 16;
      unsigned wv[8];
      _Pragma("unroll") for (int j = 0; j < 8; ++j) wv[j] = pack2(tile[(kq + 2 * j) * 65 + n], tile[(kq + 2 * j + 1) * 65 + n]);
      u16* d = dst + tix(c0 + n, r0 + kq, 32);
      *(uint4*)d = make_uint4(wv[0], wv[1], wv[2], wv[3]);
      *(uint4*)(d + 8) = make_uint4(wv[4], wv[5], wv[6], wv[7]);
    }
  }
  __syncthreads();
  if (blockIdx.x < 384) {
  {
    float* sc = (float*)smem;
    float* red = sc + 9 * 1024;
    for (int i = tid; i < 9 * 1024; i += 256) {
      const int j = i >> 10, k = i & 1023;
      const float cv = (j == 0) ? p.c_ctx[k] : p.c[(j - 1) * 1024 + k];
      sc[i] = silu_f(cv);
    }
    __syncthreads();
    for (int item = blockIdx.x; item < 384; item += gridDim.x) {
    const int lane = tid & 63, w = tid >> 6;
    const int l = item / 192, n = (item % 192) * 16 + (lane & 15);
    const int kbeg = (w * 4 + (lane >> 4)) * 64;
    float acc[9];
    _Pragma("unroll") for (int j = 0; j < 9; ++j) acc[j] = 0.f;
    const float* wp = p.w_ada + (size_t)l * 1024 * 3072 + n;
    for (int k = kbeg; k < kbeg + 64; k += 8) {
      float wv[8];
      _Pragma("unroll") for (int u = 0; u < 8; ++u) wv[u] = wp[(size_t)(k + u) * 3072];
      _Pragma("unroll") for (int u = 0; u < 8; ++u)
        _Pragma("unroll") for (int j = 0; j < 9; ++j) acc[j] += sc[j * 1024 + k + u] * wv[u];
    }
    _Pragma("unroll") for (int j = 0; j < 9; ++j) {
      acc[j] += __shfl_xor(acc[j], 16);
      acc[j] += __shfl_xor(acc[j], 32);
    }
    if (lane < 16) {
      _Pragma("unroll") for (int j = 0; j < 9; ++j) red[(w * 9 + j) * 16 + lane] = acc[j];
    }
    __syncthreads();
    if (tid < 144) {
      const int j = tid >> 4, nn = tid & 15;
      const int n2 = (item % 192) * 16 + nn;
      const float v = red[(0 * 9 + j) * 16 + nn] + red[(1 * 9 + j) * 16 + nn] + red[(2 * 9 + j) * 16 + nn] + red[(3 * 9 + j) * 16 + nn];
      ((float*)(p.ws + OFF_mod))[(l * 9 + j) * 3072 + n2] = v + p.b_ada[l * 3072 + n2];
    }
    __syncthreads();
    }
  }
  }
  if (blockIdx.x == gridDim.x - 1) {
    for (int i = tid; i < 1024; i += 256) {
      const int pos = i >> 4, f = i & 15;
      const float inv = powf(10000.f, -(float)f / 16.f);
      const float ang = (float)pos * inv;
      ((float*)(p.ws + OFF_rope))[2 * i] = cosf(ang);
      ((float*)(p.ws + OFF_rope))[2 * i + 1] = sinf(ang);
    }
  }
}

DI void phaseA0(CPar& p, int l) {
  const int tid = otid(), lane = tid & 63;
  const int gw = blockIdx.x * 4 + (tid >> 6), nw = gridDim.x * 4;
  const float* ng = p.norm_gain + l * 1024;
  for (int row = gw; row < MT; row += nw) {
    const float* xr = (l == 0) ? (row < MC ? p.x_prompt + (size_t)row * 1024 : p.x_sample + (size_t)(row - MC) * 1024)
                               : p.out + (size_t)row * 1024;
    float4 v[4];
    float ss = 0.f;
    _Pragma("unroll") for (int i = 0; i < 4; ++i) {
      v[i] = ((const float4*)xr)[lane + 64 * i];
      ss += v[i].x * v[i].x + v[i].y * v[i].y + v[i].z * v[i].z + v[i].w * v[i].w;
    }
    ss = wave_sum(ss);
    const float rstd = rsqrtf(ss * (1.f / 1024.f) + EPSN);
    const int j = row < MC ? 0 : 1 + ((row - MC) >> 12);
    const float* shift = ((float*)(p.ws + OFF_mod)) + (l * 9 + j) * 3072;
    const float* scale = shift + 1024;
    _Pragma("unroll") for (int i = 0; i < 4; ++i) {
      const int k = 4 * (lane + 64 * i);
      const float4 g = *(const float4*)(ng + k);
      const float4 s = *(const float4*)(scale + k);
      const float4 sh = *(const float4*)(shift + k);
      const float h0 = v[i].x * rstd * g.x * (1.f + s.x) + sh.x;
      const float h1 = v[i].y * rstd * g.y * (1.f + s.y) + sh.y;
      const float h2 = v[i].z * rstd * g.z * (1.f + s.z) + sh.z;
      const float h3 = v[i].w * rstd * g.w * (1.f + s.w) + sh.w;
      *(uint2*)(((u16*)(p.ws + OFF_H)) + tix(row, k, 32)) = make_uint2(pack2(h0, h1), pack2(h2, h3));
    }
  }
  const int gt = blockIdx.x * 256 + tid, nt = gridDim.x * 256;
  for (int idx = gt; idx < 8 * 65536; idx += nt) {
    const int b = idx >> 16, rem = idx & 65535;
    ((u16*)(p.ws + OFF_KG))[(size_t)b * NKL * 128 + rem] = f2bf(p.cache_gk[(size_t)(b * 2 + l) * 65536 + rem]);
  }
  for (int idx = gt; idx < 8 * 131072; idx += nt) {
    const int b = idx >> 17, rem = idx & 131071;
    ((u16*)(p.ws + OFF_KD))[(size_t)b * NKL * 256 + rem] = f2bf(p.cache_dk[(size_t)(b * 2 + l) * 131072 + rem]);
  }
  for (int idx = gt; idx < 8 * 2 * 64 * 512; idx += nt) {
    const int pk = idx & 511, dv = (idx >> 9) & 63, g = (idx >> 15) & 1, b = idx >> 16;
    ((u16*)(p.ws + OFF_VtG))[((size_t)(b * 2 + g) * 64 + dv) * NKL + kperm(pk)] = f2bf(p.cache_gv[((size_t)(b * 2 + l) * 512 + pk) * 128 + g * 64 + dv]);
  }
  for (int idx = gt; idx < 8 * 4 * 64 * 512; idx += nt) {
    const int pk = idx & 511, dv = (idx >> 9) & 63, h = (idx >> 15) & 3, b = idx >> 17;
    ((u16*)(p.ws + OFF_VtD))[((size_t)(b * 4 + h) * 64 + dv) * NKL + kperm(pk)] = f2bf(p.cache_dv[((size_t)(b * 2 + l) * 512 + pk) * 256 + h * 64 + dv]);
  }
}

#define NLOC(a, r) ((a) * 32 + 8 * ((r) >> 2) + 4 * hf + ((r) & 3))

template <int NB>
DI void a1_epilogue(CPar& p, int l, int nbase, int m0w, f32x16 (&acc)[2][NB], unsigned char* smem) {
  const int lane = otid() & 63, l31 = lane & 31, hf = lane >> 5;
  u16* stg = (u16*)smem + (otid() >> 6) * (32 * 68);
  _Pragma("unroll") for (int b = 0; b < NB; ++b) {
    const int m = m0w + b * 32 + l31;
    const bool ctx = m < MC;
    int bb, t;
    if (ctx) { bb = m >> 8; t = m & 255; } else { const int ml = m - MC; bb = ml >> 12; t = ml & 4095; }
    float v[2][16];
    _Pragma("unroll") for (int a = 0; a < 2; ++a)
      _Pragma("unroll") for (int r = 0; r < 16; ++r) v[a][r] = acc[a][b][r];

    auto rmsn = [&](const float* gain) {
      float ss = 0.f;
      _Pragma("unroll") for (int a = 0; a < 2; ++a)
        _Pragma("unroll") for (int r = 0; r < 16; ++r) ss += v[a][r] * v[a][r];
      ss = xhalf_sum(ss);
      const float rinv = rsqrtf(ss * (1.f / 64.f) + EPSN);
      _Pragma("unroll") for (int a = 0; a < 2; ++a)
        _Pragma("unroll") for (int i = 0; i < 4; ++i) {
          const float4 g = *(const float4*)(gain + a * 32 + 8 * i + 4 * hf);
          v[a][4 * i + 0] *= rinv * g.x; v[a][4 * i + 1] *= rinv * g.y; v[a][4 * i + 2] *= rinv * g.z; v[a][4 * i + 3] *= rinv * g.w;
        }
    };
    auto rope64 = [&]() {
      const int trow = t >> 6, tcol = t & 63;
      const float2* rp = (const float2*)((float*)(p.ws + OFF_rope));
      _Pragma("unroll") for (int r = 0; r < 16; ++r) {
        const int j = 8 * (r >> 2) + 4 * hf + (r & 3);
        const int pos = ((r >> 2) < 2) ? trow : tcol;
        const float2 cs = rp[pos * 16 + (j & 15)];
        const float x1 = v[0][r], x2 = v[1][r];
        v[0][r] = x1 * cs.x - x2 * cs.y;
        v[1][r] = x1 * cs.y + x2 * cs.x;
      }
    };
    auto rope32 = [&]() {
      const int trow = t >> 6, tcol = t & 63;
      const float2* rp = (const float2*)((float*)(p.ws + OFF_rope));
      _Pragma("unroll") for (int a = 0; a < 2; ++a)
        _Pragma("unroll") for (int r = 0; r < 8; ++r) {
          const int j = 8 * (r >> 2) + 4 * hf + (r & 3);
          const int pos = ((r >> 2) == 0) ? trow : tcol;
          const float2 cs = rp[pos * 16 + 2 * (j & 7)];
          const float x1 = v[a][r], x2 = v[a][r + 8];
          v[a][r] = x1 * cs.x - x2 * cs.y;
          v[a][r + 8] = x1 * cs.y + x2 * cs.x;
        }
    };
    auto store_nat = [&](u16* dst) {
      _Pragma("unroll") for (int a = 0; a < 2; ++a)
        _Pragma("unroll") for (int i = 0; i < 4; ++i)
          *(uint2*)(stg + l31 * 68 + a * 32 + 8 * i + 4 * hf) = make_uint2(pack2(v[a][4 * i], v[a][4 * i + 1]), pack2(v[a][4 * i + 2], v[a][4 * i + 3]));
      const unsigned long long dp = (unsigned long long)dst;
      _Pragma("unroll") for (int j = 0; j < 8; ++j) {
        const int row = (lane >> 4) + 4 * j;
        const unsigned lo = __shfl((unsigned)dp, row), hi = __shfl((unsigned)(dp >> 32), row);
        u16* rp = (u16*)(((unsigned long long)hi << 32) | lo);
        const uint2 val = *(const uint2*)(stg + row * 68 + (lane & 15) * 4);
        *(uint2*)(rp + (lane & 15) * 4) = val;
      }
    };
    auto store_f32 = [&](float* dst) {
      _Pragma("unroll") for (int a = 0; a < 2; ++a)
        _Pragma("unroll") for (int i = 0; i < 4; ++i)
          *(float4*)(dst + a * 32 + 8 * i + 4 * hf) = make_float4(v[a][4 * i], v[a][4 * i + 1], v[a][4 * i + 2], v[a][4 * i + 3]);
    };
    auto store_T = [&](u16* dst, int ld) {
      _Pragma("unroll") for (int a = 0; a < 2; ++a)
        _Pragma("unroll") for (int r = 0; r < 16; ++r) dst[(size_t)NLOC(a, r) * ld] = f2bf(v[a][r]);
    };

    u16* zrow = ((u16*)(p.ws + OFF_Z)) + (size_t)m * INW + nbase;
    if (nbase < 1024) {
      store_nat(zrow);
    } else if (nbase < 1280) {
      rmsn(p.q_gain + l * 64);
      if (!ctx) rope64();
      store_nat(zrow);
    } else if (nbase < 1408) {
      const int kvh = (nbase - 1280) >> 6;
      rmsn(p.k_gain + l * 64);
      if (ctx) {
        store_f32(p.out + OUT_GK + ((size_t)(bb * 2 + l) * 256 + t) * 128 + kvh * 64);
        store_nat(zrow);
      } else {
        rope64();
        store_nat(((u16*)(p.ws + OFF_KG)) + ((size_t)bb * NKL + 512 + t) * 128 + kvh * 64);
      }
    } else if (nbase < 1536) {
      const int kvh = (nbase - 1408) >> 6;
      if (ctx) {
        store_f32(p.out + OUT_GV + ((size_t)(bb * 2 + l) * 256 + t) * 128 + kvh * 64);
        store_T(((u16*)(p.ws + OFF_VtGc)) + ((size_t)(bb * 2 + kvh) * 64) * 256 + kperm(t), 256);
      } else {
        store_T(((u16*)(p.ws + OFF_VtG)) + ((size_t)(bb * 2 + kvh) * 64) * NKL + 512 + kperm(t), NKL);
      }
    } else if (nbase < 2048) {
      store_nat(zrow);
    } else if (nbase < 2304) {
      _Pragma("unroll") for (int a = 0; a < 2; ++a)
        _Pragma("unroll") for (int r = 0; r < 16; ++r) v[a][r] *= 0.125f;
      store_nat(zrow);
    } else if (nbase < 2560) {
      const int hh = (nbase - 2304) >> 6;
      store_nat(zrow);
      if (ctx) store_T(((u16*)(p.ws + OFF_VtRc)) + ((size_t)(bb * 4 + hh) * 64) * 256 + kperm(t), 256);
      else store_T(((u16*)(p.ws + OFF_VtRl)) + ((size_t)(bb * 4 + hh) * 64) * 4096 + kperm(t), 4096);
    } else if (nbase < 2816) {
      store_nat(zrow);
    } else if (nbase < 3072) {
      if (!ctx) rope32();
      store_nat(zrow);
    } else if (nbase < 3328) {
      const int cb = nbase - 3072;
      if (ctx) {
        store_f32(p.out + OUT_DK + ((size_t)(bb * 2 + l) * 256 + t) * 256 + cb);
        store_nat(zrow);
      } else {
        rope32();
        store_nat(((u16*)(p.ws + OFF_KD)) + ((size_t)bb * NKL + 512 + t) * 256 + cb);
      }
    } else if (nbase < 3584) {
      const int cb = nbase - 3328, hh = cb >> 6;
      if (ctx) {
        store_f32(p.out + OUT_DV + ((size_t)(bb * 2 + l) * 256 + t) * 256 + cb);
        store_T(((u16*)(p.ws + OFF_VtDc)) + ((size_t)(bb * 4 + hh) * 64) * 256 + kperm(t), 256);
      } else {
        store_T(((u16*)(p.ws + OFF_VtD)) + ((size_t)(bb * 4 + hh) * 64) * NKL + 512 + kperm(t), NKL);
      }
    } else {
      store_nat(zrow);
    }
  }
}

DI void phaseA1(CPar& p, int l, unsigned char* smem) {
  const int w = otid() >> 6, wn = w >> 1, wt = w & 1;
  for (int tile = vblock(); tile < 30 * 160; tile += gridDim.x) {
    const int grp = tile / 800, rem = tile - grp * 800;
    const int tm = rem / 5, tn = grp * 5 + (rem - tm * 5);
    f32x16 acc[2][4];
    _Pragma("unroll") for (int a = 0; a < 2; ++a)
      _Pragma("unroll") for (int b = 0; b < 4; ++b) acc[a][b] = zero16();
    gemm_acc<4>(((u16*)(p.ws + OFF_WinT)) + (size_t)l * 3840 * 1024 + ((size_t)(tn * 32) << 12), ((u16*)(p.ws + OFF_H)) + ((size_t)(tm * 2 * 32) << 12), 32 * 4096, 32, acc, (u16*)smem);
    a1_epilogue<4>(p, l, tn * 128 + wn * 64, tm * 256 + wt * 128, acc, smem);
    __syncthreads();
  }
}

DI void ld8(const u16* ptr, float (&f)[8]) {
  const uint4 v = *(const uint4*)ptr;
  f[0] = bflo(v.x); f[1] = bfhi(v.x); f[2] = bflo(v.y); f[3] = bfhi(v.y);
  f[4] = bflo(v.z); f[5] = bfhi(v.z); f[6] = bflo(v.w); f[7] = bfhi(v.w);
}

DI void conv_items(CPar& p, int l) {
  const int gt = blockIdx.x * 256 + otid(), nt = gridDim.x * 256;
  const float* cw = p.conv_w + l * 768;
  for (int idx = gt; idx < MT * 32; idx += nt) {
    const int m = idx >> 5, c8 = (idx & 31) * 8;
    int t, T;
    if (m < MC) { t = m & 255; T = 256; } else { t = (m - MC) & 4095; T = 4096; }
    const u16* zr = ((u16*)(p.ws + OFF_Z)) + (size_t)m * INW + c8;
    float bg[8], gt8[8], cgc[8], uc[8], gp[8], gn[8];
    ld8(zr, bg); ld8(zr + 768, gt8); ld8(zr + 256, cgc); ld8(zr + 512, uc);
    if (t > 0) { float a[8], b[8]; ld8(zr - INW + 256, a); ld8(zr - INW + 512, b); _Pragma("unroll") for (int i = 0; i < 8; ++i) gp[i] = a[i] * b[i]; }
    else { _Pragma("unroll") for (int i = 0; i < 8; ++i) gp[i] = 0.f; }
    if (t < T - 1) { float a[8], b[8]; ld8(zr + INW + 256, a); ld8(zr + INW + 512, b); _Pragma("unroll") for (int i = 0; i < 8; ++i) gn[i] = a[i] * b[i]; }
    else { _Pragma("unroll") for (int i = 0; i < 8; ++i) gn[i] = 0.f; }
    float y[8];
    _Pragma("unroll") for (int i = 0; i < 8; ++i) {
      const float w0 = cw[c8 + i], w1 = cw[256 + c8 + i], w2 = cw[512 + c8 + i];
      const float g = cgc[i] * uc[i];
      y[i] = bg[i] * (w0 * gp[i] + w1 * g + w2 * gn[i]) * silu_f(gt8[i]);
    }
    *(uint4*)(((u16*)(p.ws + OFF_Y)) + tix(m, c8, 32)) = make_uint4(pack2(y[0], y[1]), pack2(y[2], y[3]), pack2(y[4], y[5]), pack2(y[6], y[7]));
  }
}

DI float log_gamma(CPar& p, int l, int dir, int h) {
  const float x = p.ret_decay[(l * 2 + dir) * 4 + h];
  return -log1pf(expf(-x));
}

DI void ret_decode(int item, bool& ctx, int& bb, int& h, int& c, int& m0) {
  if (item < 256) { ctx = true; c = item & 1; h = (item >> 1) & 3; bb = item >> 3; m0 = bb * 256 + c * 128; }
  else { const int it = item - 256; ctx = false; c = it & 31; h = (it >> 5) & 3; bb = it >> 7; m0 = MC + bb * 4096 + c * 128; }
}

DI void r1_items(CPar& p, int l, unsigned char* smem) {
  const int tid = otid();
  u16* sK = (u16*)smem;
  u16* sV = sK + 128 * 64;
  float* wf = (float*)(sV + 128 * 64);
  float* wb = wf + 128;
  for (int item = blockIdx.x; item < 1280; item += gridDim.x) {
    bool ctx; int bb, h, c, m0;
    ret_decode(item, ctx, bb, h, c, m0);
    const float lgf = log_gamma(p, l, 0, h), lgb = log_gamma(p, l, 1, h);
    __syncthreads();
    _Pragma("unroll") for (int i = 0; i < 4; ++i) {
      const int cidx = tid + 256 * i, row = cidx >> 3, kc = cidx & 7;
      const u16* zr = ((u16*)(p.ws + OFF_Z)) + (size_t)(m0 + row) * INW + h * 64 + kc * 8;
      *(uint4*)(sK + row * 64 + kc * 8) = *(const uint4*)(zr + 2048);
      *(uint4*)(sV + row * 64 + kc * 8) = *(const uint4*)(zr + 2304);
    }
    if (tid < 128) { wf[tid] = expf(lgf * (float)(127 - tid)); wb[tid] = expf(lgb * (float)tid); }
    __syncthreads();
    const int dk0 = (tid >> 4) * 4, dv0 = (tid & 15) * 4;
    float uf[4][4], ub[4][4];
    _Pragma("unroll") for (int i = 0; i < 4; ++i)
      _Pragma("unroll") for (int j = 0; j < 4; ++j) { uf[i][j] = 0.f; ub[i][j] = 0.f; }
    for (int j = 0; j < 128; ++j) {
      const uint2 kv = *(const uint2*)(sK + j * 64 + dk0);
      const uint2 vv = *(const uint2*)(sV + j * 64 + dv0);
      const float k4[4] = {bflo(kv.x), bfhi(kv.x), bflo(kv.y), bfhi(kv.y)};
      const float v4[4] = {bflo(vv.x), bfhi(vv.x), bflo(vv.y), bfhi(vv.y)};
      const float a = wf[j], b = wb[j];
      _Pragma("unroll") for (int i = 0; i < 4; ++i) {
        const float kf = k4[i] * a, kb = k4[i] * b;
        _Pragma("unroll") for (int q = 0; q < 4; ++q) { uf[i][q] += kf * v4[q]; ub[i][q] += kb * v4[q]; }
      }
    }
    float* uo = ((float*)(p.ws + OFF_U)) + (size_t)item * 2 * 4096;
    _Pragma("unroll") for (int i = 0; i < 4; ++i) {
      *(float4*)(uo + (dk0 + i) * 64 + dv0) = make_float4(uf[i][0], uf[i][1], uf[i][2], uf[i][3]);
      *(float4*)(uo + 4096 + (dk0 + i) * 64 + dv0) = make_float4(ub[i][0], ub[i][1], ub[i][2], ub[i][3]);
    }
  }
}

template <bool CTX>
DI void r2_item(CPar& p, int l, int bi) {
  const int tid = otid();
  const int eb = bi & 15, dir = (bi >> 4) & 1, h = (bi >> 5) & 3, bb = bi >> 7;
  const int ep = eb * 256 + tid;
  const int dv = ep >> 6, dk = ep & 63;
  const int e = dk * 64 + dv;
  constexpr int nch = CTX ? 2 : 32;
  const int base = CTX ? (bb * 4 + h) * 2 : 256 + (bb * 4 + h) * 32;
  const float gC = expf(log_gamma(p, l, dir, h) * 128.f);
  float S = CTX ? 0.f : p.state_ret[((((size_t)bb * 2 + l) * 2 + dir) * 4 + h) * 4096 + e];
  float u[nch];
  _Pragma("unroll") for (int i = 0; i < nch; ++i) {
    const int c = dir ? (nch - 1 - i) : i;
    u[i] = ((float*)(p.ws + OFF_U))[((size_t)(base + c) * 2 + dir) * 4096 + e];
  }
  _Pragma("unroll") for (int i = 0; i < nch; ++i) {
    const int c = dir ? (nch - 1 - i) : i;
    ((u16*)(p.ws + OFF_SinT))[((size_t)(base + c) * 2 + dir) * 4096 + ep] = f2bf(S);
    S = S * gC + u[i];
  }
  if (CTX) p.out[OUT_ST + ((((size_t)bb * 2 + l) * 2 + dir) * 4 + h) * 4096 + e] = S;
}

template <bool DIFF>
DI void attn_item(CPar& p, int l, bool ctx, int bb, int unit, int qb, unsigned char* smem) {
  const int tid = otid(), lane = tid & 63, w = tid >> 6, l31 = lane & 31, hf = lane >> 5;
  const int qi = w & 1, qs = w >> 1;
  const int mq = (ctx ? bb * 256 : MC + bb * 4096) + qb * 64 + qs * 32 + l31;
  const int nkeys = ctx ? 256 : NKL;
  const u16* Kp; const u16* Vt; int ldk, ldv;
  if (!DIFF) {
    if (ctx) { Kp = ((u16*)(p.ws + OFF_Z)) + (size_t)(bb * 256) * INW + 1280 + unit * 64; ldk = INW; Vt = ((u16*)(p.ws + OFF_VtGc)) + ((size_t)(bb * 2 + unit) * 64) * 256; ldv = 256; }
    else { Kp = ((u16*)(p.ws + OFF_KG)) + (size_t)bb * NKL * 128 + unit * 64; ldk = 128; Vt = ((u16*)(p.ws + OFF_VtG)) + ((size_t)(bb * 2 + unit) * 64) * NKL; ldv = NKL; }
  } else {
    if (ctx) { Kp = ((u16*)(p.ws + OFF_Z)) + (size_t)(bb * 256) * INW + 3072 + unit * 64; ldk = INW; Vt = ((u16*)(p.ws + OFF_VtDc)) + ((size_t)(bb * 4 + unit) * 64) * 256; ldv = 256; }
    else { Kp = ((u16*)(p.ws + OFF_KD)) + (size_t)bb * NKL * 256 + unit * 64; ldk = 256; Vt = ((u16*)(p.ws + OFF_VtD)) + ((size_t)(bb * 4 + unit) * 64) * NKL; ldv = NKL; }
  }
  constexpr int NS = DIFF ? 2 : 4;
  bf16x8 qf[NS];
  {
    const u16* zq = ((u16*)(p.ws + OFF_Z)) + (size_t)mq * INW + (DIFF ? 2816 + unit * 64 + qi * 32 : 1024 + (unit * 2 + qi) * 64) + hf * 8;
    _Pragma("unroll") for (int s = 0; s < NS; ++s) qf[s] = *(const bf16x8*)(zq + s * 16);
  }
  const float sc = (DIFF ? 0.17677669529663687f : 0.125f) * 1.4426950408889634f;
  f32x16 O[2];
  O[0] = zero16(); O[1] = zero16();
  float mref = -1e30f, lsum = 0.f;

  char* smb = (char*)smem;
  constexpr int STGB = 16384;
  const int lr = tid >> 3, gch = (tid & 7) ^ ((lr >> 1) & 7);
  const u16* gk = Kp + (size_t)lr * ldk + gch * 8;
  const u16* gv = Vt + (size_t)lr * ldv + gch * 8;
  const int wv = __builtin_amdgcn_readfirstlane(w);
  char* smw = smb + wv * 1024;
  const u16* pk0 = gk; const u16* pk1 = gk + (size_t)32 * ldk;
  const u16* pv0 = gv; const u16* pv1 = gv + (size_t)32 * ldv;
  const size_t kstep = (size_t)64 * ldk;
#define ATT_STAGE(ST) do { \
    __builtin_amdgcn_global_load_lds((const unsigned*)pk0, (unsigned*)(smw + (ST) * STGB), 16, 0, 0); pk0 += kstep; \
    __builtin_amdgcn_global_load_lds((const unsigned*)pk1, (unsigned*)(smw + (ST) * STGB + 4096), 16, 0, 0); pk1 += kstep; \
    __builtin_amdgcn_global_load_lds((const unsigned*)pv0, (unsigned*)(smw + (ST) * STGB + 8192), 16, 0, 0); pv0 += 64; \
    __builtin_amdgcn_global_load_lds((const unsigned*)pv1, (unsigned*)(smw + (ST) * STGB + 8192 + 4096), 16, 0, 0); pv1 += 64; \
  } while (0)
  const int nt = nkeys >> 6;
  __syncthreads();
  VMWAIT(0);
  ATT_STAGE(0); ATT_STAGE(1);
  const int sw = (l31 >> 1) & 7;
  const int kq0 = DIFF ? qi * 4 : 0;
  const f32x16 zc = {0.f, 0.f, 0.f, 0.f, 0.f, 0.f, 0.f, 0.f, 0.f, 0.f, 0.f, 0.f, 0.f, 0.f, 0.f, 0.f};
  auto softmax_pv = [&](f32x16 (&S)[2], const char* sV) {
    bf16x8 vfr[2][4];
    _Pragma("unroll") for (int a = 0; a < 2; ++a)
      _Pragma("unroll") for (int s2 = 0; s2 < 4; ++s2)
        vfr[a][s2] = *(const bf16x8*)(sV + (a * 32 + l31) * 128 + (((2 * s2 + hf) ^ sw) << 4));
    float mx = S[0][0];
    _Pragma("unroll") for (int k2 = 0; k2 < 2; ++k2)
      _Pragma("unroll") for (int r = 0; r < 16; ++r) mx = fmaxf(mx, S[k2][r]);
    mx = xhalf_max(mx);
    const float mxs = mx * sc;
    if (__builtin_amdgcn_ballot_w64(mxs > mref + 8.f) != 0ull) {
      const float mnew = (mxs > mref + 8.f) ? mxs : mref;
      const float alpha = __builtin_amdgcn_exp2f(mref - mnew);
      mref = mnew;
      lsum *= alpha;
      _Pragma("unroll") for (int a = 0; a < 2; ++a)
        _Pragma("unroll") for (int r = 0; r < 16; ++r) O[a][r] *= alpha;
    }
    const f32x2 sc2 = {sc, sc}, nm2 = {-mref, -mref};
    f32x2 ps2 = {0.f, 0.f};
    bf16x8 pf[4];
    _Pragma("unroll") for (int k2 = 0; k2 < 2; ++k2)
      _Pragma("unroll") for (int u = 0; u < 2; ++u) {
        u32x4 pk;
        _Pragma("unroll") for (int j = 0; j < 4; ++j) {
          f32x2 v = {S[k2][8 * u + 2 * j], S[k2][8 * u + 2 * j + 1]};
          v = v * sc2 + nm2;
          f32x2 e;
          e.x = __builtin_amdgcn_exp2f(v.x);
          e.y = __builtin_amdgcn_exp2f(v.y);
          ps2 += e;
          pk[j] = pack2(e.x, e.y);
        }
        pf[2 * k2 + u] = __builtin_bit_cast(bf16x8, pk);
      }
    lsum += ps2.x + ps2.y;
    _Pragma("unroll") for (int a = 0; a < 2; ++a)
      _Pragma("unroll") for (int s2 = 0; s2 < 4; ++s2) O[a] = MFMA32(vfr[a][s2], pf[s2], O[a]);
  };
  for (int kt2 = 0; kt2 < nt; kt2 += 2) {
    VMWAIT(0);
    RAW_BARRIER();
    if (kt2 + 2 < nt) { ATT_STAGE((kt2 + 2) & 3); ATT_STAGE((kt2 + 3) & 3); }
    __builtin_amdgcn_sched_barrier(0);
    const char* sK0 = smb + (kt2 & 3) * STGB;
    const char* sK1 = smb + ((kt2 + 1) & 3) * STGB;
    f32x16 S0[2], S1[2];
    {
      bf16x8 kfa[NS][2], kfb[NS][2];
      _Pragma("unroll") for (int s = 0; s < NS; ++s)
        _Pragma("unroll") for (int k2 = 0; k2 < 2; ++k2)
          kfa[s][k2] = *(const bf16x8*)(sK0 + (k2 * 32 + l31) * 128 + (((kq0 + 2 * s + hf) ^ sw) << 4));
      _Pragma("unroll") for (int s = 0; s < NS; ++s)
        _Pragma("unroll") for (int k2 = 0; k2 < 2; ++k2)
          kfb[s][k2] = *(const bf16x8*)(sK1 + (k2 * 32 + l31) * 128 + (((kq0 + 2 * s + hf) ^ sw) << 4));
      __builtin_amdgcn_sched_barrier(0);
      _Pragma("unroll") for (int s = 0; s < NS; ++s)
        _Pragma("unroll") for (int k2 = 0; k2 < 2; ++k2)
          S0[k2] = MFMA32(kfa[s][k2], qf[s], s == 0 ? zc : S0[k2]);
      _Pragma("unroll") for (int s = 0; s < NS; ++s)
        _Pragma("unroll") for (int k2 = 0; k2 < 2; ++k2)
          S1[k2] = MFMA32(kfb[s][k2], qf[s], s == 0 ? zc : S1[k2]);
    }
    softmax_pv(S0, sK0 + 8192);
    softmax_pv(S1, sK1 + 8192);
  }
  RAW_BARRIER();
#undef ATT_STAGE
  const float inv = 1.f / xhalf_sum(lsum);
  const u16* zg = ((u16*)(p.ws + OFF_Z)) + (size_t)mq * INW;
  if (!DIFF) {
    _Pragma("unroll") for (int a = 0; a < 2; ++a)
      _Pragma("unroll") for (int i = 0; i < 4; ++i) {
        const int col = (unit * 2 + qi) * 64 + a * 32 + 8 * i + 4 * hf;
        const uint2 gv2 = *(const uint2*)(zg + 1536 + col);
        const float y0 = O[a][4 * i + 0] * inv * silu_f(bflo(gv2.x));
        const float y1 = O[a][4 * i + 1] * inv * silu_f(bfhi(gv2.x));
        const float y2 = O[a][4 * i + 2] * inv * silu_f(bflo(gv2.y));
        const float y3 = O[a][4 * i + 3] * inv * silu_f(bfhi(gv2.y));
        *(uint2*)(((u16*)(p.ws + OFF_Y)) + tix(mq, 256 + col, 32)) = make_uint2(pack2(y0, y1), pack2(y2, y3));
      }
  } else {
    float* xb = (float*)smem + qs * 32 * 64;
    if (qi == 1) {
      _Pragma("unroll") for (int a = 0; a < 2; ++a)
        _Pragma("unroll") for (int r = 0; r < 16; ++r) xb[(a * 16 + r) * 64 + lane] = O[a][r] * inv;
    }
    __syncthreads();
    if (qi == 0) {
      const float* lp = p.diff_lambda + l * 128;
      float d1 = 0.f, d2 = 0.f;
      for (int i = 0; i < 32; ++i) { d1 += lp[i] * lp[32 + i]; d2 += lp[64 + i] * lp[96 + i]; }
      const float lam_init = 0.8f - 0.6f * expf(-0.3f * (float)l);
      const float lam = expf(d1) - expf(d2) + lam_init;
      float ss = 0.f;
      _Pragma("unroll") for (int a = 0; a < 2; ++a)
        _Pragma("unroll") for (int r = 0; r < 16; ++r) {
          const float o = O[a][r] * inv - lam * xb[(a * 16 + r) * 64 + lane];
          O[a][r] = o;
          ss += o * o;
        }
      ss = xhalf_sum(ss);
      const float rinv = rsqrtf(ss * (1.f / 64.f) + EPSN) * (1.f - lam_init);
      const float* gn = p.diff_gain + l * 64;
      _Pragma("unroll") for (int a = 0; a < 2; ++a)
        _Pragma("unroll") for (int i = 0; i < 4; ++i) {
          const int nl = a * 32 + 8 * i + 4 * hf;
          const int col = unit * 64 + nl;
          const uint2 gv2 = *(const uint2*)(zg + 3584 + col);
          const float4 g4 = *(const float4*)(gn + nl);
          const float y0 = O[a][4 * i + 0] * rinv * g4.x * silu_f(bflo(gv2.x));
          const float y1 = O[a][4 * i + 1] * rinv * g4.y * silu_f(bfhi(gv2.x));
          const float y2 = O[a][4 * i + 2] * rinv * g4.z * silu_f(bflo(gv2.y));
          const float y3 = O[a][4 * i + 3] * rinv * g4.w * silu_f(bfhi(gv2.y));
          *(uint2*)(((u16*)(p.ws + OFF_Y)) + tix(mq, 768 + col, 32)) = make_uint2(pack2(y0, y1), pack2(y2, y3));
        }
    }
  }
}

DI void r3_item(CPar& p, int l, int item, unsigned char* smem) {
  const int tid = otid(), lane = tid & 63, w = tid >> 6, l31 = lane & 31, hf = lane >> 5;
  bool ctx; int bb, h, c, m0;
  ret_decode(item, ctx, bb, h, c, m0);
  const int iq = w * 32 + l31;
  const int mq = m0 + iq;
  const float LOG2E = 1.4426950408889634f;
  const float lf2 = log_gamma(p, l, 0, h) * LOG2E, lb2 = log_gamma(p, l, 1, h) * LOG2E;
  u16* sK = (u16*)smem;
  u16* sV = sK + 128 * LSTR;
  constexpr int VSTR = 136;
  const u16* Vt = ctx ? ((u16*)(p.ws + OFF_VtRc)) + ((size_t)(bb * 4 + h) * 64) * 256 + c * 128 : ((u16*)(p.ws + OFF_VtRl)) + ((size_t)(bb * 4 + h) * 64) * 4096 + c * 128;
  const int ldv = ctx ? 256 : 4096;
  __syncthreads();
  _Pragma("unroll") for (int i = 0; i < 4; ++i) {
    const int cidx = tid + 256 * i;
    { const int row = cidx >> 3, kc = cidx & 7;
      *(uint4*)(sK + row * LSTR + kc * 8) = *(const uint4*)(((u16*)(p.ws + OFF_Z)) + (size_t)(m0 + row) * INW + 2048 + h * 64 + kc * 8); }
    { const int dv = cidx >> 4, kc = cidx & 15;
      *(uint4*)(sV + dv * VSTR + kc * 8) = *(const uint4*)(Vt + (size_t)dv * ldv + kc * 8); }
  }
  bf16x8 qf[4];
  {
    const u16* zq = ((u16*)(p.ws + OFF_Z)) + (size_t)mq * INW + 1792 + h * 64 + hf * 8;
    _Pragma("unroll") for (int s = 0; s < 4; ++s) qf[s] = *(const bf16x8*)(zq + s * 16);
  }
  __syncthreads();
  f32x16 O[2];
  O[0] = zero16(); O[1] = zero16();
  _Pragma("unroll 1") for (int kt = 0; kt < 2; ++kt) {
    f32x16 S[2];
    S[0] = zero16(); S[1] = zero16();
    _Pragma("unroll") for (int s = 0; s < 4; ++s)
      _Pragma("unroll") for (int k2 = 0; k2 < 2; ++k2) {
        const bf16x8 kf = *(const bf16x8*)(sK + (kt * 64 + k2 * 32 + l31) * LSTR + s * 16 + hf * 8);
        S[k2] = MFMA32(kf, qf[s], S[k2]);
      }
    bf16x8 pf[4];
    _Pragma("unroll") for (int k2 = 0; k2 < 2; ++k2) {
      _Pragma("unroll") for (int r = 0; r < 16; ++r) {
        const int jk = kt * 64 + k2 * 32 + 8 * (r >> 2) + 4 * hf + (r & 3);
        const int d = iq - jk;
        float wgt;
        if (d > 0) wgt = __builtin_amdgcn_exp2f(lf2 * (float)d);
        else if (d < 0) wgt = __builtin_amdgcn_exp2f(lb2 * (float)(-d));
        else wgt = 2.f;
        S[k2][r] *= wgt;
      }
      _Pragma("unroll") for (int u = 0; u < 2; ++u) {
        u32x4 pk;
        pk[0] = pack2(S[k2][8 * u + 0], S[k2][8 * u + 1]);
        pk[1] = pack2(S[k2][8 * u + 2], S[k2][8 * u + 3]);
        pk[2] = pack2(S[k2][8 * u + 4], S[k2][8 * u + 5]);
        pk[3] = pack2(S[k2][8 * u + 6], S[k2][8 * u + 7]);
        pf[2 * k2 + u] = __builtin_bit_cast(bf16x8, pk);
      }
    }
    _Pragma("unroll") for (int a = 0; a < 2; ++a)
      _Pragma("unroll") for (int s2 = 0; s2 < 4; ++s2) {
        const bf16x8 vf = *(const bf16x8*)(sV + (a * 32 + l31) * VSTR + kt * 64 + 16 * s2 + 8 * hf);
        O[a] = MFMA32(vf, pf[s2], O[a]);
      }
  }
  _Pragma("unroll") for (int dir = 0; dir < 2; ++dir) {
    const u16* st = ((u16*)(p.ws + OFF_SinT)) + ((size_t)item * 2 + dir) * 4096;
    const float dq = dir == 0 ? __builtin_amdgcn_exp2f(lf2 * (float)(iq + 1)) : __builtin_amdgcn_exp2f(lb2 * (float)(128 - iq));
    _Pragma("unroll") for (int a = 0; a < 2; ++a) {
      f32x16 X = zero16();
      _Pragma("unroll") for (int s = 0; s < 4; ++s) {
        const bf16x8 sf = *(const bf16x8*)(st + (a * 32 + l31) * 64 + s * 16 + hf * 8);
        X = MFMA32(sf, qf[s], X);
      }
      _Pragma("unroll") for (int r = 0; r < 16; ++r) O[a][r] += X[r] * dq;
    }
  }
  float ss = 0.f;
  _Pragma("unroll") for (int a = 0; a < 2; ++a)
    _Pragma("unroll") for (int r = 0; r < 16; ++r) ss += O[a][r] * O[a][r];
  ss = xhalf_sum(ss);
  const float rinv = rsqrtf(ss * (1.f / 64.f) + EPSN);
  const u16* zg = ((u16*)(p.ws + OFF_Z)) + (size_t)mq * INW + 2560 + h * 64;
  _Pragma("unroll") for (int a = 0; a < 2; ++a)
    _Pragma("unroll") for (int i = 0; i < 4; ++i) {
      const int nl = a * 32 + 8 * i + 4 * hf;
      const uint2 gv2 = *(const uint2*)(zg + nl);
      const float y0 = O[a][4 * i + 0] * rinv * silu_f(bflo(gv2.x));
      const float y1 = O[a][4 * i + 1] * rinv * silu_f(bfhi(gv2.x));
      const float y2 = O[a][4 * i + 2] * rinv * silu_f(bflo(gv2.y));
      const float y3 = O[a][4 * i + 3] * rinv * silu_f(bfhi(gv2.y));
      *(uint2*)(((u16*)(p.ws + OFF_Y)) + tix(mq, 512 + h * 64 + nl, 32)) = make_uint2(pack2(y0, y1), pack2(y2, y3));
    }
}

DI void phaseC(CPar& p, int l, unsigned char* smem) {
  const int lane = otid() & 63, w = otid() >> 6, wn = w >> 1, wt = w & 1, l31 = lane & 31, hf = lane >> 5;
  u16* Mg = ((u16*)(p.ws + OFF_Z));
  for (int tile = vblock(); tile < 8 * 320; tile += gridDim.x) {
    const int grp = tile / 640, rem = tile - grp * 640;
    const int tm = rem >> 1, tn = grp * 2 + (rem & 1);
    unsigned mgp[2][2][8];
    _Pragma("unroll") for (int a = 0; a < 2; ++a)
      _Pragma("unroll") for (int b = 0; b < 2; ++b)
        _Pragma("unroll") for (int r = 0; r < 8; ++r) mgp[a][b][r] = 0u;
    const u16* Ht = ((u16*)(p.ws + OFF_H)) + ((size_t)(tm * 32) << 12);
    _Pragma("unroll 1") for (int pr = 0; pr < 2; ++pr) {
      unsigned gp[2][4][8];
      {
        f32x16 acc[2][4];
        _Pragma("unroll") for (int a = 0; a < 2; ++a)
          _Pragma("unroll") for (int b = 0; b < 4; ++b) acc[a][b] = zero16();
        gemm_acc<4, true, true>(Ht, ((u16*)(p.ws + OFF_WgT)) + (size_t)l * 4096 * 1024 + ((size_t)((pr * 16 + tn) * 32) << 12), 8 * 32 * 4096, 32, acc, (u16*)smem);
        _Pragma("unroll") for (int a = 0; a < 2; ++a)
          _Pragma("unroll") for (int b = 0; b < 4; ++b)
            _Pragma("unroll") for (int r = 0; r < 8; ++r) gp[a][b][r] = pack2(sigmoid_f(acc[a][b][2 * r]), sigmoid_f(acc[a][b][2 * r + 1]));
      }
      _Pragma("unroll") for (int bh = 0; bh < 2; ++bh) {
        const int br = pr * 2 + bh;
        f32x16 acc[2][2];
        _Pragma("unroll") for (int a = 0; a < 2; ++a)
          _Pragma("unroll") for (int b = 0; b < 2; ++b) acc[a][b] = zero16();
        gemm_acc<2, false, true>(((u16*)(p.ws + OFF_Y)) + ((size_t)(tm * 32 + br * 8) << 12), ((u16*)(p.ws + OFF_WbT)) + (size_t)l * 1024 * 1024 + ((size_t)(tn * 32 + br * 8) << 12), 0, 8, acc, (u16*)smem);
        _Pragma("unroll") for (int a = 0; a < 2; ++a)
          _Pragma("unroll") for (int b = 0; b < 2; ++b)
            _Pragma("unroll") for (int r = 0; r < 8; ++r)
              mgp[a][b][r] = pack2(bflo(mgp[a][b][r]) + bflo(gp[a][bh * 2 + b][r]) * acc[a][b][2 * r], bfhi(mgp[a][b][r]) + bfhi(gp[a][bh * 2 + b][r]) * acc[a][b][2 * r + 1]);
      }
    }
    _Pragma("unroll") for (int a = 0; a < 2; ++a)
      _Pragma("unroll") for (int b = 0; b < 2; ++b) {
        const int n = tn * 128 + wt * 64 + b * 32 + l31;
        _Pragma("unroll") for (int r = 0; r < 8; ++r) {
          const int t0 = tm * 128 + wn * 64 + a * 32 + 8 * ((2 * r) >> 2) + 4 * hf + ((2 * r) & 3);
          Mg[tix(t0, n, 32)] = (u16)(mgp[a][b][r] & 0xffffu);
          Mg[tix(t0 + 1, n, 32)] = (u16)(mgp[a][b][r] >> 16);
        }
      }
  }
}

template <int TB>
DI void d_epilogue(CPar& p, int l, int tm, int nb0, f32x16 (&acc)[2][TB]) {
  const int lane = otid() & 63, w = otid() >> 6, wn = w >> 1, wt = w & 1, l31 = lane & 31, hf = lane >> 5;
  const int m0 = tm * 128 + wn * 64;
  const int j = m0 < MC ? 0 : 1 + ((m0 - MC) >> 12);
  const float* gate = ((float*)(p.ws + OFF_mod)) + (l * 9 + j) * 3072 + 2048;
  const float* xsrc = (l == 0) ? (m0 < MC ? p.x_prompt : p.x_sample - (size_t)MC * 1024) : p.out;
  _Pragma("unroll") for (int b = 0; b < TB; ++b) {
    const int n = (TB == 2) ? nb0 + wt * 64 + b * 32 + l31 : nb0 + (b >> 1) * 128 + wt * 64 + (b & 1) * 32 + l31;
    const float gv = gate[n];
    const size_t o0 = (size_t)(m0 + 4 * hf) * 1024 + n;
    const float* xp = xsrc + o0;
    float* op = p.out + o0;
    _Pragma("unroll") for (int a = 0; a < 2; ++a)
      _Pragma("unroll") for (int i = 0; i < 4; ++i) {
        float xv[4];
        _Pragma("unroll") for (int q = 0; q < 4; ++q) xv[q] = xp[q * 1024];
        _Pragma("unroll") for (int q = 0; q < 4; ++q) op[q * 1024] = xv[q] + gv * acc[a][b][4 * i + q];
        xp += 8 * 1024; op += 8 * 1024;
        asm volatile("" : "+v"(xp), "+v"(op));
      }
  }
}

DI void phaseD(CPar& p, int l, unsigned char* smem) {
  const u16* Mg = ((u16*)(p.ws + OFF_Z));
  const u16* Wo = ((u16*)(p.ws + OFF_WoT)) + (size_t)l * 1024 * 1024;
  for (int tile = vblock(); tile < 1024 + 512; tile += gridDim.x) {
    if (tile < 1024) {
      const int np = tile & 3, tm = tile >> 2;
      f32x16 acc[2][4];
      _Pragma("unroll") for (int a = 0; a < 2; ++a)
        _Pragma("unroll") for (int b = 0; b < 4; ++b) acc[a][b] = zero16();
      gemm_acc<4, true>(Mg + ((size_t)(tm * 32) << 12), Wo + ((size_t)(np * 2 * 32) << 12), 32 * 4096, 32, acc, (u16*)smem);
      d_epilogue<4>(p, l, tm, np * 256, acc);
    } else {
      const int t2 = tile - 1024, big = 1024 + (t2 >> 1), np = big & 3, tm = big >> 2, tn = np * 2 + (t2 & 1);
      f32x16 acc[2][2];
      _Pragma("unroll") for (int a = 0; a < 2; ++a)
        _Pragma("unroll") for (int b = 0; b < 2; ++b) acc[a][b] = zero16();
      gemm_acc<2>(Mg + ((size_t)(tm * 32) << 12), Wo + ((size_t)(tn * 32) << 12), 0, 32, acc, (u16*)smem);
      d_epilogue<2>(p, l, tm, tn * 128, acc);
    }
  }
}

DI void phaseFinal(CPar& p) {
  const int tid = otid(), lane = tid & 63;
  const int gw = blockIdx.x * 4 + (tid >> 6), nw = gridDim.x * 4;
  for (int row = gw; row < MT; row += nw) {
    float* xr = p.out + (size_t)row * 1024;
    float4 v[4];
    float ss = 0.f;
    _Pragma("unroll") for (int i = 0; i < 4; ++i) {
      v[i] = ((const float4*)xr)[lane + 64 * i];
      ss += v[i].x * v[i].x + v[i].y * v[i].y + v[i].z * v[i].z + v[i].w * v[i].w;
    }
    ss = wave_sum(ss);
    const float rstd = rsqrtf(ss * (1.f / 1024.f) + EPSN);
    _Pragma("unroll") for (int i = 0; i < 4; ++i) {
      const float4 g = *(const float4*)(p.final_gain + 4 * (lane + 64 * i));
      ((float4*)xr)[lane + 64 * i] = make_float4(v[i].x * rstd * g.x, v[i].y * rstd * g.y, v[i].z * rstd * g.z, v[i].w * rstd * g.w);
    }
  }
}

__global__ void __launch_bounds__(256, 2) hybrid_megakernel(Params p_unused) {
  cg::grid_group grid = cg::this_grid();
  __shared__ __attribute__((aligned(16))) unsigned char smem[SMEM_BYTES];
  __shared__ uint4 xb_words;
  if (threadIdx.x == 0) xb_words = make_uint4(0u, 0u, 0u, 0u);
  __syncthreads();
  XcdBarrier xb = xcd_barrier_post(((unsigned*)(PP().ws + OFF_bar)), (volatile LAS unsigned*)&xb_words);
  phase0(PP(), smem);
  grid.sync();
  _Pragma("unroll 1") for (int l = 0; l < 2; ++l) {
    phaseA0(PP(), l);
    xcd_barrier(xb);
    phaseA1(PP(), l, smem);
    xcd_barrier(xb);
    conv_items(PP(), l);
    r1_items(PP(), l, smem);
    xcd_barrier(xb);
    for (int rep = 0; rep < REP_B2; ++rep)
    for (int it = vblock(); it < 1024 + 1024 + 2048 + 256 + 512 + 4096; it += gridDim.x) {
      if (it < 1024) r2_item<false>(PP(), l, it);
      else if (it < 2048) { const int i = it - 1024; attn_item<false>(PP(), l, false, i >> 7, (i >> 6) & 1, i & 63, smem); }
      else if (it < 4096) { const int i = it - 2048; attn_item<true>(PP(), l, false, i >> 8, (i >> 6) & 3, i & 63, smem); }
      else if (it < 4352) { const int i = it - 4096; attn_item<false>(PP(), l, true, i >> 3, (i >> 2) & 1, i & 3, smem); }
      else if (it < 4864) { const int i = it - 4352; attn_item<true>(PP(), l, true, i >> 4, (i >> 2) & 3, i & 3, smem); }
      else r2_item<true>(PP(), l, it - 4864);
    }
    xcd_barrier(xb);
    for (int it = vblock(); it < 1280; it += gridDim.x) r3_item(PP(), l, it, smem);
    xcd_barrier(xb);
    phaseC(PP(), l, smem);
    xcd_barrier(xb);
    phaseD(PP(), l, smem);
    xcd_barrier(xb);
  }
  phaseFinal(PP());
}

extern "C" void kernel_launch(void* const* d_in, const int* in_sizes, int n_in, void* d_out, int out_size, void* d_ws, size_t ws_size,
                              hipStream_t stream) {
  static int grid_blocks = 0;
  if (!grid_blocks) {
    int dev = 0, cus = 0, per_cu = 0;
    (void)hipGetDevice(&dev);
    (void)hipDeviceGetAttribute(&cus, hipDeviceAttributeMultiprocessorCount, dev);
    (void)hipOccupancyMaxActiveBlocksPerMultiprocessor(&per_cu, hybrid_megakernel, 256, 0);
    if (per_cu > 2) per_cu = 2;
    if (per_cu < 1) per_cu = 1;
    grid_blocks = cus * per_cu;
  }
  Params p{};
  const float** fin = (const float**)&p.x_prompt;
  for (int i = 0; i < 23; ++i) fin[i] = (const float*)d_in[i];
  p.out = (float*)d_out;
  p.ws = (unsigned char*)d_ws;
  const size_t off = WS_NEED;
  if (off > ws_size) { fprintf(stderr, "workspace too small: need %zu have %zu\n", off, ws_size); return; }
  (void)hipMemsetAsync(p.ws + OFF_bar, 0, XCD_BAR_WORDS * 4, stream);
  void* args[] = {&p};
  hipError_t e = hipLaunchCooperativeKernel((void*)hybrid_megakernel, dim3(grid_blocks), dim3(256), args, 0, stream);
  if (e != hipSuccess) fprintf(stderr, "cooperative launch failed: %s (grid %d)\n", hipGetErrorString(e), grid_blocks);
}
```

```cpp
#include <hip/hip_runtime.h>
#include <hip/hip_bf16.h>
#include <hip/hip_cooperative_groups.h>
#include <cstdio>
namespace cg = cooperative_groups;

typedef unsigned short u16;
using bf16x8 = __attribute__((ext_vector_type(8))) short;
using f32x16 = __attribute__((ext_vector_type(16))) float;
using u32x4 = __attribute__((ext_vector_type(4))) unsigned;
using u32x2 = __attribute__((ext_vector_type(2))) unsigned;

#define DI __device__ __forceinline__
#define MFMA32(a, b, c) __builtin_amdgcn_mfma_f32_32x32x16_bf16((a), (b), (c), 0, 0, 0)

#ifndef REP_A1
#define REP_A1 1
#endif
#ifndef REP_B2
#define REP_B2 1
#endif
#ifndef PIPE_C
#define PIPE_C true
#endif
constexpr int DM = 1024;
constexpr int INW = 3840;
constexpr int MC = 8192;
constexpr int MT = 40960;
constexpr int NKL = 4608;
constexpr int LSTR = 72;
constexpr float EPSN = 1e-6f;
constexpr int SMEM_BYTES = 2 * 2 * 128 * LSTR * 2;

constexpr size_t OUT_GK = 41943040ull;
constexpr size_t OUT_GV = 44040192ull;
constexpr size_t OUT_DK = 46137344ull;
constexpr size_t OUT_DV = 50331648ull;
constexpr size_t OUT_ST = 54525952ull;

constexpr size_t OFF_WinT = 0ull;
constexpr size_t OFF_WgT = 15728640ull;
constexpr size_t OFF_WbT = 32505856ull;
constexpr size_t OFF_WoT = 36700160ull;
constexpr size_t OFF_mod = 40894464ull;
constexpr size_t OFF_rope = 41115648ull;
constexpr size_t OFF_H = 41123840ull;
constexpr size_t OFF_Z = 125009920ull;
constexpr size_t OFF_KG = 439582720ull;
constexpr size_t OFF_VtG = 449019904ull;
constexpr size_t OFF_KD = 458457088ull;
constexpr size_t OFF_VtD = 477331456ull;
constexpr size_t OFF_VtGc = 496205824ull;
constexpr size_t OFF_VtDc = 498302976ull;
constexpr size_t OFF_VtRc = 502497280ull;
constexpr size_t OFF_VtRl = 506691584ull;
constexpr size_t OFF_U = 523468800ull;
constexpr size_t OFF_SinT = 565411840ull;
constexpr size_t OFF_Y = 586383360ull;
constexpr size_t OFF_bar = 670269440ull;
constexpr size_t OFF_KtRc = 670283264ull;
constexpr size_t OFF_KtRl = 674477568ull;
constexpr size_t OFF_tctr = 691254784ull;
constexpr size_t WS_NEED = 691255040ull;
struct Params {
  const float *x_prompt, *x_sample, *cache_gk, *cache_gv, *cache_dk, *cache_dv, *state_ret, *c, *c_ctx, *w_ada, *b_ada,
      *norm_gain, *w_in, *conv_w, *q_gain, *k_gain, *ret_decay, *diff_lambda, *diff_gain, *w_branch, *w_mgate, *w_out, *final_gain;
  float* out;
  unsigned char* ws;
};

typedef float f32x2 __attribute__((ext_vector_type(2)));
typedef __bf16 bf16x2_t __attribute__((ext_vector_type(2)));
typedef const Params __attribute__((address_space(4))) CPar;
DI CPar& PP() { CPar* q = (CPar*)__builtin_amdgcn_kernarg_segment_ptr(); asm volatile("" : "+s"(q)); return *q; }
DI unsigned pack2(float a, float b) {
  const f32x2 v = {a, b};
  return __builtin_bit_cast(unsigned, __builtin_convertvector(v, bf16x2_t));
}
DI u16 f2bf(float a) { return (u16)(pack2(a, 0.f) & 0xffffu); }
DI float bflo(unsigned v) { return __uint_as_float(v << 16); }
DI float bfhi(unsigned v) { return __uint_as_float(v & 0xffff0000u); }
DI float silu_f(float x) { return x / (1.f + __expf(-x)); }
DI float sigmoid_f(float x) { return 1.f / (1.f + __expf(-x)); }
DI f32x16 zero16() { f32x16 z; _Pragma("unroll") for (int i = 0; i < 16; ++i) z[i] = 0.f; return z; }
DI int otid() { int t = (int)__builtin_amdgcn_workitem_id_x(); asm volatile("" : "+v"(t)); return t; }
DI int vblock() { const int b = (int)blockIdx.x, g = (int)gridDim.x; return ((g & 7) == 0) ? (b & 7) * (g >> 3) + (b >> 3) : b; }
DI size_t tix(int r, int k, int ksl) { return ((size_t)((r >> 7) * ksl + (k >> 5)) << 12) + ((r & 127) << 5) + (k & 31); }
#define XB_TMO      128
#define XB_XCNT(j)  (256  + 64 * (j))
#define XB_XSUB(j)  (1280 + 64 * (j))
#define XB_XGEN(j)  (2304 + 64 * (j))
#define XB_TOP      3328
#define XB_TOPGEN   3392
#define XCD_BAR_WORDS 3456
#define XB_SPIN_CAP (1u << 18)
#define LAS __attribute__((address_space(3)))

__device__ __forceinline__ unsigned xb_ld(unsigned* p)              { return __hip_atomic_load(p, __ATOMIC_RELAXED, __HIP_MEMORY_SCOPE_AGENT); }
__device__ __forceinline__ unsigned xb_add(unsigned* p, unsigned v) { return __hip_atomic_fetch_add(p, v, __ATOMIC_RELAXED, __HIP_MEMORY_SCOPE_AGENT); }
__device__ __forceinline__ unsigned xb_xcc_id() { return (unsigned)__builtin_amdgcn_s_getreg((3 << 11) | 20) & 0xFu; }
#define XB_SPIN(cond, bar) do { unsigned _sp = 0; while (cond) { __builtin_amdgcn_s_sleep(1); \
    if ((++_sp & 255u) == 0u) { if (xb_ld(&(bar)[XB_TMO])) break; if (_sp > XB_SPIN_CAP) { atomicAdd(&(bar)[XB_TMO], 1u); break; } } } } while (0)

struct XcdBarrier {
    unsigned* bar; unsigned x;
    volatile LAS unsigned* st;
};

__device__ __forceinline__ XcdBarrier xcd_barrier_post(unsigned* bar, volatile LAS unsigned* st) {
    XcdBarrier b; b.bar = bar; b.x = xb_xcc_id(); b.st = st;
    if (threadIdx.x == 0) (void)xb_add(&bar[XB_XCNT(b.x)], 1u);
    return b;
}
__device__ __forceinline__ void xcd_barrier_complete(unsigned* bar, unsigned x, unsigned& nloc, unsigned& nx) {
    const unsigned G = gridDim.x * gridDim.y * gridDim.z;
    unsigned sum, cnt, mine, sp = 0u;
    for (;;) {
        sum = 0u; cnt = 0u; mine = 0u;
#pragma unroll
        for (unsigned j = 0; j < 16; ++j) { const unsigned c = xb_ld(&bar[XB_XCNT(j)]); sum += c; cnt += (c > 0u) ? 1u : 0u; mine = (j == x) ? c : mine; }
        if (sum == G) break;
        __builtin_amdgcn_s_sleep(1);
        if ((++sp & 255u) == 0u) { if (xb_ld(&bar[XB_TMO])) break; if (sp > XB_SPIN_CAP) { atomicAdd(&bar[XB_TMO], 1u); break; } }
    }
    nloc = mine > 0u ? mine : 1u; nx = cnt > 0u ? cnt : 1u;
}

__device__ __forceinline__ void xcd_barrier(const XcdBarrier& b) {
    asm volatile("s_waitcnt vmcnt(0)" ::: "memory");
    __syncthreads();
    if (threadIdx.x == 0) {
        unsigned* bar = b.bar;
        __builtin_amdgcn_s_waitcnt(0);
        unsigned nloc = b.st[0], nx = b.st[1];
        if (nloc == 0u) { xcd_barrier_complete(bar, b.x, nloc, nx); b.st[0] = nloc; b.st[1] = nx; }
        const unsigned old = xb_add(&bar[XB_XSUB(b.x)], 1u);
        const unsigned gen = old / nloc;
        if (old + 1u == (gen + 1u) * nloc) {
            __builtin_amdgcn_fence(__ATOMIC_RELEASE, "agent");
            asm volatile("s_waitcnt vmcnt(0)" ::: "memory");
            const unsigned og = xb_add(&bar[XB_TOP], 1u);
            const unsigned tg = og / nx;
            if (og + 1u == (tg + 1u) * nx) xb_add(&bar[XB_TOPGEN], 1u);
            else XB_SPIN(xb_ld(&bar[XB_TOPGEN]) == tg, bar);
            __builtin_amdgcn_fence(__ATOMIC_ACQUIRE, "agent");
            xb_add(&bar[XB_XGEN(b.x)], 1u);
            asm volatile("s_waitcnt vmcnt(0)" ::: "memory");
        } else {
            XB_SPIN(xb_ld(&bar[XB_XGEN(b.x)]) == gen, bar);
            __builtin_amdgcn_fence(__ATOMIC_ACQUIRE, "agent");
            asm volatile("s_waitcnt vmcnt(0)" ::: "memory");
        }
    }
    __syncthreads();
}


DI int kperm(int t) { return (t & ~12) | ((t & 4) << 1) | ((t & 8) >> 1); }
DI float xhalf_max(float x) {
  const auto r = __builtin_amdgcn_permlane32_swap(__float_as_uint(x), __float_as_uint(x), false, false);
  return fmaxf(__uint_as_float(r[0]), __uint_as_float(r[1]));
}
DI float xhalf_sum(float x) {
  const auto r = __builtin_amdgcn_permlane32_swap(__float_as_uint(x), __float_as_uint(x), false, false);
  return __uint_as_float(r[0]) + __uint_as_float(r[1]);
}
DI float wave_sum(float v) {
  _Pragma("unroll") for (int o = 1; o < 64; o <<= 1) v += __shfl_xor(v, o);
  return v;
}

#define VMWAIT(N) asm volatile("s_waitcnt vmcnt(" #N ")" ::: "memory")
#define RAW_BARRIER() do { asm volatile("s_waitcnt lgkmcnt(0)" ::: "memory"); __builtin_amdgcn_s_barrier(); } while (0)
template <int TB, bool BMAP = false, bool LEAN = false>
DI void gemm_acc(const u16* __restrict__ A, const u16* __restrict__ B, int bstride, int nk, f32x16 (&acc)[2][TB], u16* sm) {
  const int tid = otid(), lane = tid & 63, w = tid >> 6, wn = w >> 1, wt = w & 1, l31 = lane & 31, hf = lane >> 5;
  constexpr int NSTG = (TB == 2) ? 4 : 3;
  constexpr int RB = 64 * TB;
  constexpr int STGB = (128 + RB) * 64;
  constexpr int LPB = RB / 64;
  const int lr = tid >> 2, gsl = (tid & 3) ^ ((lr >> 2) & 3);
  const u16* ga = A + lr * 32 + gsl * 8;
  const u16* gb = B + lr * 32 + gsl * 8;
  char* smb = (char*)sm;
  const int wv = __builtin_amdgcn_readfirstlane(w);
  char* smw = smb + wv * 1024;
  const u16* pa[2];
  const u16* pb[LPB];
  _Pragma("unroll") for (int i = 0; i < 2; ++i) pa[i] = ga + 2048 * i;
  _Pragma("unroll") for (int i = 0; i < LPB; ++i) pb[i] = BMAP ? gb + (size_t)(i & 1) * bstride + 2048 * (i >> 1) : gb + (size_t)(i >> 1) * bstride + 2048 * (i & 1);
#define GEMM_STAGE(ST) do { \
    _Pragma("unroll") for (int i = 0; i < 2; ++i) { \
      __builtin_amdgcn_global_load_lds((const unsigned*)pa[i], (unsigned*)(smw + (ST) * STGB + i * 4096), 16, 0, 0); pa[i] += 4096; } \
    _Pragma("unroll") for (int i = 0; i < LPB; ++i) { \
      __builtin_amdgcn_global_load_lds((const unsigned*)pb[i], (unsigned*)(smw + (ST) * STGB + 8192 + i * 4096), 16, 0, 0); pb[i] += 4096; } \
  } while (0)
  VMWAIT(0);
  _Pragma("unroll") for (int s0 = 0; s0 < NSTG - 1; ++s0) GEMM_STAGE(s0);
  const int sw = (l31 >> 2) & 3;
  const int oa0 = (wn * 64 + l31) * 64 + ((hf ^ sw) << 4), oa1 = (wn * 64 + l31) * 64 + (((2 + hf) ^ sw) << 4);
  const int ob0 = 8192 + (wt * 32 * TB + l31) * 64 + ((hf ^ sw) << 4), ob1 = 8192 + (wt * 32 * TB + l31) * 64 + (((2 + hf) ^ sw) << 4);
  int st = 0, stn = NSTG - 1;
  bf16x8 dfa[2], dfb[TB];
  _Pragma("unroll") for (int a = 0; a < 2; ++a) dfa[a] = bf16x8{0, 0, 0, 0, 0, 0, 0, 0};
  _Pragma("unroll") for (int b = 0; b < TB; ++b) dfb[b] = bf16x8{0, 0, 0, 0, 0, 0, 0, 0};
  for (int kt = 0; kt < nk; ++kt) {
    if (kt + NSTG - 2 < nk) { if (TB == 2) VMWAIT(8); else VMWAIT(6); }
    else if (NSTG == 4 && kt + 1 < nk) VMWAIT(4);
    else VMWAIT(0);
    RAW_BARRIER();
    if (kt + NSTG - 1 < nk) GEMM_STAGE(stn);
    __builtin_amdgcn_sched_barrier(0);
    const char* sb = smb + st * STGB;
    if (!LEAN) {
      bf16x8 fa0[2], fb0[TB], fa1[2], fb1[TB];
      _Pragma("unroll") for (int a = 0; a < 2; ++a) fa0[a] = *(const bf16x8*)(sb + oa0 + a * 2048);
      _Pragma("unroll") for (int b = 0; b < TB; ++b) fb0[b] = *(const bf16x8*)(sb + ob0 + b * 2048);
      _Pragma("unroll") for (int a = 0; a < 2; ++a) fa1[a] = *(const bf16x8*)(sb + oa1 + a * 2048);
      _Pragma("unroll") for (int b = 0; b < TB; ++b) fb1[b] = *(const bf16x8*)(sb + ob1 + b * 2048);
      __builtin_amdgcn_sched_barrier(0);
      _Pragma("unroll") for (int a = 0; a < 2; ++a)
        _Pragma("unroll") for (int b = 0; b < TB; ++b) acc[a][b] = MFMA32(dfa[a], dfb[b], acc[a][b]);
      __builtin_amdgcn_sched_barrier(0);
      _Pragma("unroll") for (int a = 0; a < 2; ++a)
        _Pragma("unroll") for (int b = 0; b < TB; ++b) acc[a][b] = MFMA32(fa0[a], fb0[b], acc[a][b]);
      __builtin_amdgcn_sched_barrier(0);
      _Pragma("unroll") for (int a = 0; a < 2; ++a) dfa[a] = fa1[a];
      _Pragma("unroll") for (int b = 0; b < TB; ++b) dfb[b] = fb1[b];
    } else {
      _Pragma("unroll") for (int ks = 0; ks < 2; ++ks) {
        bf16x8 fa[2], fb[TB];
        _Pragma("unroll") for (int a = 0; a < 2; ++a) fa[a] = *(const bf16x8*)(sb + (ks ? oa1 : oa0) + a * 2048);
        _Pragma("unroll") for (int b = 0; b < TB; ++b) fb[b] = *(const bf16x8*)(sb + (ks ? ob1 : ob0) + b * 2048);
        __builtin_amdgcn_sched_barrier(0);
        _Pragma("unroll") for (int a = 0; a < 2; ++a)
          _Pragma("unroll") for (int b = 0; b < TB; ++b) acc[a][b] = MFMA32(fa[a], fb[b], acc[a][b]);
        __builtin_amdgcn_sched_barrier(0);
      }
    }
    st = (st + 1 == NSTG) ? 0 : st + 1;
    stn = (stn + 1 == NSTG) ? 0 : stn + 1;
  }
  if (!LEAN) {
    _Pragma("unroll") for (int a = 0; a < 2; ++a)
      _Pragma("unroll") for (int b = 0; b < TB; ++b) acc[a][b] = MFMA32(dfa[a], dfb[b], acc[a][b]);
  }
  RAW_BARRIER();
#undef GEMM_STAGE
}

DI void phase0(CPar& p, unsigned char* smem) {
  const int tid = otid();
  float* tile = (float*)smem;
  for (int job = blockIdx.x; job < 4992; job += gridDim.x) {
    const int l = job / 2496;
    int rem = job - l * 2496;
    const float* src; u16* dst; int C;
    if (rem < 960) { src = p.w_in + (size_t)l * 1024 * 3840; dst = ((u16*)(p.ws + OFF_WinT)) + (size_t)l * 3840 * 1024; C = 3840; }
    else if (rem < 1984) { rem -= 960; src = p.w_mgate + (size_t)l * 1024 * 4096; dst = ((u16*)(p.ws + OFF_WgT)) + (size_t)l * 4096 * 1024; C = 4096; }
    else if (rem < 2240) { rem -= 1984; src = p.w_branch + (size_t)l * 1024 * 1024; dst = ((u16*)(p.ws + OFF_WbT)) + (size_t)l * 1024 * 1024; C = 1024; }
    else { rem -= 2240; src = p.w_out + (size_t)l * 1024 * 1024; dst = ((u16*)(p.ws + OFF_WoT)) + (size_t)l * 1024 * 1024; C = 1024; }
    const int tr = rem & 15, tc = rem >> 4;
    const int r0 = tr * 64, c0 = tc * 64;
    __syncthreads();
    _Pragma("unroll") for (int i = 0; i < 4; ++i) {
      const int rr = (tid >> 4) + 16 * i, cc = (tid & 15) * 4;
      const float4 v = *(const float4*)(src + (size_t)(r0 + rr) * C + c0 + cc);
      tile[rr * 65 + cc + 0] = v.x; tile[rr * 65 + cc + 1] = v.y; tile[rr * 65 + cc + 2] = v.z; tile[rr * 65 + cc + 3] = v.w;
    }
    __syncthreads();
    {
      const int n = tid >> 2, kq = (tid & 3) * 16;
      unsigned wv[8];
      _Pragma("unroll") for (int j = 0; j < 8; ++j) wv[j] = pack2(tile[(kq + 2 * j) * 65 + n], tile[(kq + 2 * j + 1) * 65 + n]);
      u16* d = dst + tix(c0 + n, r0 + kq, 32);
      *(uint4*)d = make_uint4(wv[0], wv[1], wv[2], wv[3]);
      *(uint4*)(d + 8) = make_uint4(wv[4], wv[5], wv[6], wv[7]);
    }
  }
  __syncthreads();
  if (blockIdx.x < 384) {
  {
    float* sc = (float*)smem;
    float* red = sc + 9 * 1024;
    for (int i = tid; i < 9 * 1024; i += 256) {
      const int j = i >> 10, k = i & 1023;
      const float cv = (j == 0) ? p.c_ctx[k] : p.c[(j - 1) * 1024 + k];
      sc[i] = silu_f(cv);
    }
    __syncthreads();
    for (int item = blockIdx.x; item < 384; item += gridDim.x) {
    const int lane = tid & 63, w = tid >> 6;
    const int l = item / 192, n = (item % 192) * 16 + (lane & 15);
    const int kbeg = (w * 4 + (lane >> 4)) * 64;
    float acc[9];
    _Pragma("unroll") for (int j = 0; j < 9; ++j) acc[j] = 0.f;
    const float* wp = p.w_ada + (size_t)l * 1024 * 3072 + n;
    for (int k = kbeg; k < kbeg + 64; k += 8) {
      float wv[8];
      _Pragma("unroll") for (int u = 0; u < 8; ++u) wv[u] = wp[(size_t)(k + u) * 3072];
      _Pragma("unroll") for (int u = 0; u < 8; ++u)
        _Pragma("unroll") for (int j = 0; j < 9; ++j) acc[j] += sc[j * 1024 + k + u] * wv[u];
    }
    _Pragma("unroll") for (int j = 0; j < 9; ++j) {
      acc[j] += __shfl_xor(acc[j], 16);
      acc[j] += __shfl_xor(acc[j], 32);
    }
    if (lane < 16) {
      _Pragma("unroll") for (int j = 0; j < 9; ++j) red[(w * 9 + j) * 16 + lane] = acc[j];
    }
    __syncthreads();
    if (tid < 144) {
      const int j = tid >> 4, nn = tid & 15;
      const int n2 = (item % 192) * 16 + nn;
      const float v = red[(0 * 9 + j) * 16 + nn] + red[(1 * 9 + j) * 16 + nn] + red[(2 * 9 + j) * 16 + nn] + red[(3 * 9 + j) * 16 + nn];
      ((float*)(p.ws + OFF_mod))[(l * 9 + j) * 3072 + n2] = v + p.b_ada[l * 3072 + n2];
    }
    __syncthreads();
    }
  }
  }
  if (blockIdx.x == gridDim.x - 1) {
    for (int i = tid; i < 1024; i += 256) {
      const int pos = i >> 4, f = i & 15;
      const float inv = powf(10000.f, -(float)f / 16.f);
      const float ang = (float)pos * inv;
      ((float*)(p.ws + OFF_rope))[2 * i] = cosf(ang);
      ((float*)(p.ws + OFF_rope))[2 * i + 1] = sinf(ang);
    }
  }
}

DI void phaseA0(CPar& p, int l) {
  const int tid = otid(), lane = tid & 63;
  const int gw = blockIdx.x * 4 + (tid >> 6), nw = gridDim.x * 4;
  const float* ng = p.norm_gain + l * 1024;
  for (int row = gw; row < MT; row += nw) {
    const float* xr = (l == 0) ? (row < MC ? p.x_prompt + (size_t)row * 1024 : p.x_sample + (size_t)(row - MC) * 1024)
                               : p.out + (size_t)row * 1024;
    float4 v[4];
    float ss = 0.f;
    _Pragma("unroll") for (int i = 0; i < 4; ++i) {
      v[i] = ((const float4*)xr)[lane + 64 * i];
      ss += v[i].x * v[i].x + v[i].y * v[i].y + v[i].z * v[i].z + v[i].w * v[i].w;
    }
    ss = wave_sum(ss);
    const float rstd = rsqrtf(ss * (1.f / 1024.f) + EPSN);
    const int j = row < MC ? 0 : 1 + ((row - MC) >> 12);
    const float* shift = ((float*)(p.ws + OFF_mod)) + (l * 9 + j) * 3072;
    const float* scale = shift + 1024;
    _Pragma("unroll") for (int i = 0; i < 4; ++i) {
      const int k = 4 * (lane + 64 * i);
      const float4 g = *(const float4*)(ng + k);
      const float4 s = *(const float4*)(scale + k);
      const float4 sh = *(const float4*)(shift + k);
      const float h0 = v[i].x * rstd * g.x * (1.f + s.x) + sh.x;
      const float h1 = v[i].y * rstd * g.y * (1.f + s.y) + sh.y;
      const float h2 = v[i].z * rstd * g.z * (1.f + s.z) + sh.z;
      const float h3 = v[i].w * rstd * g.w * (1.f + s.w) + sh.w;
      *(uint2*)(((u16*)(p.ws + OFF_H)) + tix(row, k, 32)) = make_uint2(pack2(h0, h1), pack2(h2, h3));
    }
  }
  const int gt = blockIdx.x * 256 + tid, nt = gridDim.x * 256;
  for (int idx = gt; idx < 8 * 65536; idx += nt) {
    const int b = idx >> 16, rem = idx & 65535;
    ((u16*)(p.ws + OFF_KG))[(size_t)b * NKL * 128 + rem] = f2bf(p.cache_gk[(size_t)(b * 2 + l) * 65536 + rem]);
  }
  for (int idx = gt; idx < 8 * 131072; idx += nt) {
    const int b = idx >> 17, rem = idx & 131071;
    ((u16*)(p.ws + OFF_KD))[(size_t)b * NKL * 256 + rem] = f2bf(p.cache_dk[(size_t)(b * 2 + l) * 131072 + rem]);
  }
  for (int idx = gt; idx < 8 * 2 * 64 * 512; idx += nt) {
    const int pk = idx & 511, dv = (idx >> 9) & 63, g = (idx >> 15) & 1, b = idx >> 16;
    ((u16*)(p.ws + OFF_VtG))[((size_t)(b * 2 + g) * 64 + dv) * NKL + kperm(pk)] = f2bf(p.cache_gv[((size_t)(b * 2 + l) * 512 + pk) * 128 + g * 64 + dv]);
  }
  for (int idx = gt; idx < 8 * 4 * 64 * 512; idx += nt) {
    const int pk = idx & 511, dv = (idx >> 9) & 63, h = (idx >> 15) & 3, b = idx >> 17;
    ((u16*)(p.ws + OFF_VtD))[((size_t)(b * 4 + h) * 64 + dv) * NKL + kperm(pk)] = f2bf(p.cache_dv[((size_t)(b * 2 + l) * 512 + pk) * 256 + h * 64 + dv]);
  }
}

#define NLOC(a, r) ((a) * 32 + 8 * ((r) >> 2) + 4 * hf + ((r) & 3))

template <int NB>
DI void a1_epilogue(CPar& p, int l, int nbase, int m0w, f32x16 (&acc)[2][NB], unsigned char* smem) {
  const int lane = otid() & 63, l31 = lane & 31, hf = lane >> 5;
  u16* stg = (u16*)smem + (otid() >> 6) * (32 * 68);
  _Pragma("unroll") for (int b = 0; b < NB; ++b) {
    const int m = m0w + b * 32 + l31;
    const bool ctx = m < MC;
    int bb, t;
    if (ctx) { bb = m >> 8; t = m & 255; } else { const int ml = m - MC; bb = ml >> 12; t = ml & 4095; }
    float v[2][16];
    _Pragma("unroll") for (int a = 0; a < 2; ++a)
      _Pragma("unroll") for (int r = 0; r < 16; ++r) v[a][r] = acc[a][b][r];

    auto rmsn = [&](const float* gain) {
      float ss = 0.f;
      _Pragma("unroll") for (int a = 0; a < 2; ++a)
        _Pragma("unroll") for (int r = 0; r < 16; ++r) ss += v[a][r] * v[a][r];
      ss = xhalf_sum(ss);
      const float rinv = rsqrtf(ss * (1.f / 64.f) + EPSN);
      _Pragma("unroll") for (int a = 0; a < 2; ++a)
        _Pragma("unroll") for (int i = 0; i < 4; ++i) {
          const float4 g = *(const float4*)(gain + a * 32 + 8 * i + 4 * hf);
          v[a][4 * i + 0] *= rinv * g.x; v[a][4 * i + 1] *= rinv * g.y; v[a][4 * i + 2] *= rinv * g.z; v[a][4 * i + 3] *= rinv * g.w;
        }
    };
    auto rope64 = [&]() {
      const int trow = t >> 6, tcol = t & 63;
      const float2* rp = (const float2*)((float*)(p.ws + OFF_rope));
      _Pragma("unroll") for (int r = 0; r < 16; ++r) {
        const int j = 8 * (r >> 2) + 4 * hf + (r & 3);
        const int pos = ((r >> 2) < 2) ? trow : tcol;
        const float2 cs = rp[pos * 16 + (j & 15)];
        const float x1 = v[0][r], x2 = v[1][r];
        v[0][r] = x1 * cs.x - x2 * cs.y;
        v[1][r] = x1 * cs.y + x2 * cs.x;
      }
    };
    auto rope32 = [&]() {
      const int trow = t >> 6, tcol = t & 63;
      const float2* rp = (const float2*)((float*)(p.ws + OFF_rope));
      _Pragma("unroll") for (int a = 0; a < 2; ++a)
        _Pragma("unroll") for (int r = 0; r < 8; ++r) {
          const int j = 8 * (r >> 2) + 4 * hf + (r & 3);
          const int pos = ((r >> 2) == 0) ? trow : tcol;
          const float2 cs = rp[pos * 16 + 2 * (j & 7)];
          const float x1 = v[a][r], x2 = v[a][r + 8];
          v[a][r] = x1 * cs.x - x2 * cs.y;
          v[a][r + 8] = x1 * cs.y + x2 * cs.x;
        }
    };
    auto store_nat = [&](u16* dst) {
      _Pragma("unroll") for (int a = 0; a < 2; ++a)
        _Pragma("unroll") for (int i = 0; i < 4; ++i)
          *(uint2*)(stg + l31 * 68 + a * 32 + 8 * i + 4 * hf) = make_uint2(pack2(v[a][4 * i], v[a][4 * i + 1]), pack2(v[a][4 * i + 2], v[a][4 * i + 3]));
      const unsigned long long dp = (unsigned long long)dst;
      _Pragma("unroll") for (int j = 0; j < 8; ++j) {
        const int row = (lane >> 4) + 4 * j;
        const unsigned lo = __shfl((unsigned)dp, row), hi = __shfl((unsigned)(dp >> 32), row);
        u16* rp = (u16*)(((unsigned long long)hi << 32) | lo);
        const uint2 val = *(const uint2*)(stg + row * 68 + (lane & 15) * 4);
        *(uint2*)(rp + (lane & 15) * 4) = val;
      }
    };
    auto store_f32 = [&](float* dst) {
      _Pragma("unroll") for (int a = 0; a < 2; ++a)
        _Pragma("unroll") for (int i = 0; i < 4; ++i)
          *(float4*)(dst + a * 32 + 8 * i + 4 * hf) = make_float4(v[a][4 * i], v[a][4 * i + 1], v[a][4 * i + 2], v[a][4 * i + 3]);
    };
    auto store_T = [&](u16* dst, int ld) {
      _Pragma("unroll") for (int a = 0; a < 2; ++a)
        _Pragma("unroll") for (int r = 0; r < 16; ++r) dst[(size_t)NLOC(a, r) * ld] = f2bf(v[a][r]);
    };

    u16* zrow = ((u16*)(p.ws + OFF_Z)) + (size_t)m * INW + nbase;
    if (nbase < 1024) {
      store_nat(zrow);
    } else if (nbase < 1280) {
      rmsn(p.q_gain + l * 64);
      if (!ctx) rope64();
      store_nat(zrow);
    } else if (nbase < 1408) {
      const int kvh = (nbase - 1280) >> 6;
      rmsn(p.k_gain + l * 64);
      if (ctx) {
        store_f32(p.out + OUT_GK + ((size_t)(bb * 2 + l) * 256 + t) * 128 + kvh * 64);
        store_nat(zrow);
      } else {
        rope64();
        store_nat(((u16*)(p.ws + OFF_KG)) + ((size_t)bb * NKL + 512 + t) * 128 + kvh * 64);
      }
    } else if (nbase < 1536) {
      const int kvh = (nbase - 1408) >> 6;
      if (ctx) {
        store_f32(p.out + OUT_GV + ((size_t)(bb * 2 + l) * 256 + t) * 128 + kvh * 64);
        store_T(((u16*)(p.ws + OFF_VtGc)) + ((size_t)(bb * 2 + kvh) * 64) * 256 + kperm(t), 256);
      } else {
        store_T(((u16*)(p.ws + OFF_VtG)) + ((size_t)(bb * 2 + kvh) * 64) * NKL + 512 + kperm(t), NKL);
      }
    } else if (nbase < 2048) {
      store_nat(zrow);
    } else if (nbase < 2304) {
      const int hh = (nbase - 2048) >> 6;
      _Pragma("unroll") for (int a = 0; a < 2; ++a)
        _Pragma("unroll") for (int r = 0; r < 16; ++r) v[a][r] *= 0.125f;
      store_nat(zrow);
      if (ctx) store_T(((u16*)(p.ws + OFF_KtRc)) + ((size_t)(bb * 4 + hh) * 64) * 256 + kperm(t), 256);
      else store_T(((u16*)(p.ws + OFF_KtRl)) + ((size_t)(bb * 4 + hh) * 64) * 4096 + kperm(t), 4096);
    } else if (nbase < 2560) {
      const int hh = (nbase - 2304) >> 6;
      store_nat(zrow);
      if (ctx) store_T(((u16*)(p.ws + OFF_VtRc)) + ((size_t)(bb * 4 + hh) * 64) * 256 + kperm(t), 256);
      else store_T(((u16*)(p.ws + OFF_VtRl)) + ((size_t)(bb * 4 + hh) * 64) * 4096 + kperm(t), 4096);
    } else if (nbase < 2816) {
      store_nat(zrow);
    } else if (nbase < 3072) {
      if (!ctx) rope32();
      store_nat(zrow);
    } else if (nbase < 3328) {
      const int cb = nbase - 3072;
      if (ctx) {
        store_f32(p.out + OUT_DK + ((size_t)(bb * 2 + l) * 256 + t) * 256 + cb);
        store_nat(zrow);
      } else {
        rope32();
        store_nat(((u16*)(p.ws + OFF_KD)) + ((size_t)bb * NKL + 512 + t) * 256 + cb);
      }
    } else if (nbase < 3584) {
      const int cb = nbase - 3328, hh = cb >> 6;
      if (ctx) {
        store_f32(p.out + OUT_DV + ((size_t)(bb * 2 + l) * 256 + t) * 256 + cb);
        store_T(((u16*)(p.ws + OFF_VtDc)) + ((size_t)(bb * 4 + hh) * 64) * 256 + kperm(t), 256);
      } else {
        store_T(((u16*)(p.ws + OFF_VtD)) + ((size_t)(bb * 4 + hh) * 64) * NKL + 512 + kperm(t), NKL);
      }
    } else {
      store_nat(zrow);
    }
  }
}

DI void phaseA1(CPar& p, int l, unsigned char* smem) {
  const int w = otid() >> 6, wn = w >> 1, wt = w & 1;
  for (int tile = vblock(); tile < 30 * 160; tile += gridDim.x) {
    const int grp = tile / 800, rem = tile - grp * 800;
    const int tm = rem / 5, tn = grp * 5 + (rem - tm * 5);
    f32x16 acc[2][4];
    _Pragma("unroll") for (int a = 0; a < 2; ++a)
      _Pragma("unroll") for (int b = 0; b < 4; ++b) acc[a][b] = zero16();
    gemm_acc<4>(((u16*)(p.ws + OFF_WinT)) + (size_t)l * 3840 * 1024 + ((size_t)(tn * 32) << 12), ((u16*)(p.ws + OFF_H)) + ((size_t)(tm * 2 * 32) << 12), 32 * 4096, 32, acc, (u16*)smem);
    a1_epilogue<4>(p, l, tn * 128 + wn * 64, tm * 256 + wt * 128, acc, smem);
    __syncthreads();
  }
}

DI void ld8(const u16* ptr, float (&f)[8]) {
  const uint4 v = *(const uint4*)ptr;
  f[0] = bflo(v.x); f[1] = bfhi(v.x); f[2] = bflo(v.y); f[3] = bfhi(v.y);
  f[4] = bflo(v.z); f[5] = bfhi(v.z); f[6] = bflo(v.w); f[7] = bfhi(v.w);
}

DI void conv_item(CPar& p, int l, int item) {
  const int gt = item * 256 + otid(), nt = MT * 32;
  const float* cw = p.conv_w + l * 768;
  for (int idx = gt; idx < MT * 32; idx += nt) {
    const int m = idx >> 5, c8 = (idx & 31) * 8;
    int t, T;
    if (m < MC) { t = m & 255; T = 256; } else { t = (m - MC) & 4095; T = 4096; }
    const u16* zr = ((u16*)(p.ws + OFF_Z)) + (size_t)m * INW + c8;
    float bg[8], gt8[8], cgc[8], uc[8], gp[8], gn[8];
    ld8(zr, bg); ld8(zr + 768, gt8); ld8(zr + 256, cgc); ld8(zr + 512, uc);
    if (t > 0) { float a[8], b[8]; ld8(zr - INW + 256, a); ld8(zr - INW + 512, b); _Pragma("unroll") for (int i = 0; i < 8; ++i) gp[i] = a[i] * b[i]; }
    else { _Pragma("unroll") for (int i = 0; i < 8; ++i) gp[i] = 0.f; }
    if (t < T - 1) { float a[8], b[8]; ld8(zr + INW + 256, a); ld8(zr + INW + 512, b); _Pragma("unroll") for (int i = 0; i < 8; ++i) gn[i] = a[i] * b[i]; }
    else { _Pragma("unroll") for (int i = 0; i < 8; ++i) gn[i] = 0.f; }
    float y[8];
    _Pragma("unroll") for (int i = 0; i < 8; ++i) {
      const float w0 = cw[c8 + i], w1 = cw[256 + c8 + i], w2 = cw[512 + c8 + i];
      const float g = cgc[i] * uc[i];
      y[i] = bg[i] * (w0 * gp[i] + w1 * g + w2 * gn[i]) * silu_f(gt8[i]);
    }
    *(uint4*)(((u16*)(p.ws + OFF_Y)) + tix(m, c8, 32)) = make_uint4(pack2(y[0], y[1]), pack2(y[2], y[3]), pack2(y[4], y[5]), pack2(y[6], y[7]));
  }
}

DI float log_gamma(CPar& p, int l, int dir, int h) {
  const float x = p.ret_decay[(l * 2 + dir) * 4 + h];
  return -log1pf(expf(-x));
}

DI void ret_decode(int item, bool& ctx, int& bb, int& h, int& c, int& m0) {
  if (item < 256) { ctx = true; c = item & 1; h = (item >> 1) & 3; bb = item >> 3; m0 = bb * 256 + c * 128; }
  else { const int it = item - 256; ctx = false; c = it & 31; h = (it >> 5) & 3; bb = it >> 7; m0 = MC + bb * 4096 + c * 128; }
}

DI void r1_items(CPar& p, int l, unsigned char* smem) {
  const int tid = otid(), lane = tid & 63, w = tid >> 6, l31 = lane & 31, hf = lane >> 5;
  const int ti = w >> 1, tj = w & 1;
  const float LOG2E = 1.4426950408889634f;
  for (int item = blockIdx.x; item < 1280; item += gridDim.x) {
    bool ctx; int bb, h, c, m0;
    ret_decode(item, ctx, bb, h, c, m0);
    const float lf2 = log_gamma(p, l, 0, h) * LOG2E, lb2 = log_gamma(p, l, 1, h) * LOG2E;
    const int ld = ctx ? 256 : 4096;
    const size_t hb = ctx ? ((size_t)(bb * 4 + h) * 64) * 256 + c * 128 : ((size_t)(bb * 4 + h) * 64) * 4096 + c * 128;
    const u16* Kt = (ctx ? (const u16*)(p.ws + OFF_KtRc) : (const u16*)(p.ws + OFF_KtRl)) + hb + (size_t)(ti * 32 + l31) * ld + 8 * hf;
    const u16* Vt = (ctx ? (const u16*)(p.ws + OFF_VtRc) : (const u16*)(p.ws + OFF_VtRl)) + hb + (size_t)(tj * 32 + l31) * ld + 8 * hf;
    f32x16 Uf = zero16(), Ub = zero16();
    _Pragma("unroll") for (int s8 = 0; s8 < 8; ++s8) {
      const bf16x8 af = *(const bf16x8*)(Kt + 16 * s8);
      const u32x4 bv = *(const u32x4*)(Vt + 16 * s8);
      u32x4 bfw, bbw;
      _Pragma("unroll") for (int q = 0; q < 4; ++q) {
        const int j0 = 16 * s8 + 8 * ((2 * q) >> 2) + 4 * hf + ((2 * q) & 3);
        const float v0 = bflo(bv[q]), v1 = bfhi(bv[q]);
        const float wf0 = __builtin_amdgcn_exp2f(lf2 * (float)(127 - j0)), wf1 = __builtin_amdgcn_exp2f(lf2 * (float)(126 - j0));
        const float wb0 = __builtin_amdgcn_exp2f(lb2 * (float)j0), wb1 = __builtin_amdgcn_exp2f(lb2 * (float)(j0 + 1));
        bfw[q] = pack2(v0 * wf0, v1 * wf1);
        bbw[q] = pack2(v0 * wb0, v1 * wb1);
      }
      Uf = MFMA32(af, __builtin_bit_cast(bf16x8, bfw), Uf);
      Ub = MFMA32(af, __builtin_bit_cast(bf16x8, bbw), Ub);
    }
    float* uo = ((float*)(p.ws + OFF_U)) + (size_t)item * 2 * 4096 + tj * 32 + l31;
    _Pragma("unroll") for (int r = 0; r < 16; ++r) {
      const int dk = ti * 32 + 8 * (r >> 2) + 4 * hf + (r & 3);
      uo[dk * 64] = Uf[r];
      uo[4096 + dk * 64] = Ub[r];
    }
  }
}

template <bool CTX>
DI void r2_item(CPar& p, int l, int bi) {
  const int tid = otid();
  const int eb = bi & 15, dir = (bi >> 4) & 1, h = (bi >> 5) & 3, bb = bi >> 7;
  const int ep = eb * 256 + tid;
  const int dv = ep >> 6, dk = ep & 63;
  const int e = dk * 64 + dv;
  constexpr int nch = CTX ? 2 : 32;
  const int base = CTX ? (bb * 4 + h) * 2 : 256 + (bb * 4 + h) * 32;
  const float gC = expf(log_gamma(p, l, dir, h) * 128.f);
  float S = CTX ? 0.f : p.state_ret[((((size_t)bb * 2 + l) * 2 + dir) * 4 + h) * 4096 + e];
  float u[nch];
  _Pragma("unroll") for (int i = 0; i < nch; ++i) {
    const int c = dir ? (nch - 1 - i) : i;
    u[i] = ((float*)(p.ws + OFF_U))[((size_t)(base + c) * 2 + dir) * 4096 + e];
  }
  _Pragma("unroll") for (int i = 0; i < nch; ++i) {
    const int c = dir ? (nch - 1 - i) : i;
    ((u16*)(p.ws + OFF_SinT))[((size_t)(base + c) * 2 + dir) * 4096 + ep] = f2bf(S);
    S = S * gC + u[i];
  }
  if (CTX) p.out[OUT_ST + ((((size_t)bb * 2 + l) * 2 + dir) * 4 + h) * 4096 + e] = S;
}

template <bool DIFF>
DI void attn_item(CPar& p, int l, bool ctx, int bb, int unit, int qb, unsigned char* smem) {
  const int tid = otid(), lane = tid & 63, w = tid >> 6, l31 = lane & 31, hf = lane >> 5;
  const int qi = w & 1, qs = w >> 1;
  const int mq = (ctx ? bb * 256 : MC + bb * 4096) + qb * 64 + qs * 32 + l31;
  const int nkeys = ctx ? 256 : NKL;
  const u16* Kp; const u16* Vt; int ldk, ldv;
  if (!DIFF) {
    if (ctx) { Kp = ((u16*)(p.ws + OFF_Z)) + (size_t)(bb * 256) * INW + 1280 + unit * 64; ldk = INW; Vt = ((u16*)(p.ws + OFF_VtGc)) + ((size_t)(bb * 2 + unit) * 64) * 256; ldv = 256; }
    else { Kp = ((u16*)(p.ws + OFF_KG)) + (size_t)bb * NKL * 128 + unit * 64; ldk = 128; Vt = ((u16*)(p.ws + OFF_VtG)) + ((size_t)(bb * 2 + unit) * 64) * NKL; ldv = NKL; }
  } else {
    if (ctx) { Kp = ((u16*)(p.ws + OFF_Z)) + (size_t)(bb * 256) * INW + 3072 + unit * 64; ldk = INW; Vt = ((u16*)(p.ws + OFF_VtDc)) + ((size_t)(bb * 4 + unit) * 64) * 256; ldv = 256; }
    else { Kp = ((u16*)(p.ws + OFF_KD)) + (size_t)bb * NKL * 256 + unit * 64; ldk = 256; Vt = ((u16*)(p.ws + OFF_VtD)) + ((size_t)(bb * 4 + unit) * 64) * NKL; ldv = NKL; }
  }
  constexpr int NS = DIFF ? 2 : 4;
  bf16x8 qf[NS];
  {
    const u16* zq = ((u16*)(p.ws + OFF_Z)) + (size_t)mq * INW + (DIFF ? 2816 + unit * 64 + qi * 32 : 1024 + (unit * 2 + qi) * 64) + hf * 8;
    _Pragma("unroll") for (int s = 0; s < NS; ++s) qf[s] = *(const bf16x8*)(zq + s * 16);
  }
  const float sc = (DIFF ? 0.17677669529663687f : 0.125f) * 1.4426950408889634f;
  f32x16 O[2];
  O[0] = zero16(); O[1] = zero16();
  float mref = -1e30f, lsum = 0.f;

  char* smb = (char*)smem;
  constexpr int STGB = 16384;
  const int lr = tid >> 3, gch = (tid & 7) ^ ((lr >> 1) & 7);
  const u16* gk = Kp + (size_t)lr * ldk + gch * 8;
  const u16* gv = Vt + (size_t)lr * ldv + gch * 8;
  const int wv = __builtin_amdgcn_readfirstlane(w);
  char* smw = smb + wv * 1024;
  const u16* pk0 = gk; const u16* pk1 = gk + (size_t)32 * ldk;
  const u16* pv0 = gv; const u16* pv1 = gv + (size_t)32 * ldv;
  const size_t kstep = (size_t)64 * ldk;
#define ATT_STAGE(ST) do { \
    __builtin_amdgcn_global_load_lds((const unsigned*)pk0, (unsigned*)(smw + (ST) * STGB), 16, 0, 0); pk0 += kstep; \
    __builtin_amdgcn_global_load_lds((const unsigned*)pk1, (unsigned*)(smw + (ST) * STGB + 4096), 16, 0, 0); pk1 += kstep; \
    __builtin_amdgcn_global_load_lds((const unsigned*)pv0, (unsigned*)(smw + (ST) * STGB + 8192), 16, 0, 0); pv0 += 64; \
    __builtin_amdgcn_global_load_lds((const unsigned*)pv1, (unsigned*)(smw + (ST) * STGB + 8192 + 4096), 16, 0, 0); pv1 += 64; \
  } while (0)
  const int nt = nkeys >> 6;
  __syncthreads();
  VMWAIT(0);
  ATT_STAGE(0); ATT_STAGE(1);
  const int sw = (l31 >> 1) & 7;
  const int kq0 = DIFF ? qi * 4 : 0;
  const f32x16 zc = {0.f, 0.f, 0.f, 0.f, 0.f, 0.f, 0.f, 0.f, 0.f, 0.f, 0.f, 0.f, 0.f, 0.f, 0.f, 0.f};
  auto softmax_pv = [&](f32x16 (&S)[2], const char* sV) {
    bf16x8 vfr[2][4];
    _Pragma("unroll") for (int a = 0; a < 2; ++a)
      _Pragma("unroll") for (int s2 = 0; s2 < 4; ++s2)
        vfr[a][s2] = *(const bf16x8*)(sV + (a * 32 + l31) * 128 + (((2 * s2 + hf) ^ sw) << 4));
    float mx = S[0][0];
    _Pragma("unroll") for (int k2 = 0; k2 < 2; ++k2)
      _Pragma("unroll") for (int r = 0; r < 16; ++r) mx = fmaxf(mx, S[k2][r]);
    mx = xhalf_max(mx);
    const float mxs = mx * sc;
    if (__builtin_amdgcn_ballot_w64(mxs > mref + 8.f) != 0ull) {
      const float mnew = (mxs > mref + 8.f) ? mxs : mref;
      const float alpha = __builtin_amdgcn_exp2f(mref - mnew);
      mref = mnew;
      lsum *= alpha;
      _Pragma("unroll") for (int a = 0; a < 2; ++a)
        _Pragma("unroll") for (int r = 0; r < 16; ++r) O[a][r] *= alpha;
    }
    const f32x2 sc2 = {sc, sc}, nm2 = {-mref, -mref};
    f32x2 ps2 = {0.f, 0.f};
    bf16x8 pf[4];
    _Pragma("unroll") for (int k2 = 0; k2 < 2; ++k2)
      _Pragma("unroll") for (int u = 0; u < 2; ++u) {
        u32x4 pk;
        _Pragma("unroll") for (int j = 0; j < 4; ++j) {
          f32x2 v = {S[k2][8 * u + 2 * j], S[k2][8 * u + 2 * j + 1]};
          v = v * sc2 + nm2;
          f32x2 e;
          e.x = __builtin_amdgcn_exp2f(v.x);
          e.y = __builtin_amdgcn_exp2f(v.y);
          ps2 += e;
          pk[j] = pack2(e.x, e.y);
        }
        pf[2 * k2 + u] = __builtin_bit_cast(bf16x8, pk);
      }
    lsum += ps2.x + ps2.y;
    _Pragma("unroll") for (int a = 0; a < 2; ++a)
      _Pragma("unroll") for (int s2 = 0; s2 < 4; ++s2) O[a] = MFMA32(vfr[a][s2], pf[s2], O[a]);
  };
  for (int kt2 = 0; kt2 < nt; kt2 += 2) {
    VMWAIT(0);
    RAW_BARRIER();
    if (kt2 + 2 < nt) { ATT_STAGE((kt2 + 2) & 3); ATT_STAGE((kt2 + 3) & 3); }
    __builtin_amdgcn_sched_barrier(0);
    const char* sK0 = smb + (kt2 & 3) * STGB;
    const char* sK1 = smb + ((kt2 + 1) & 3) * STGB;
    f32x16 S0[2], S1[2];
    {
      bf16x8 kfa[NS][2], kfb[NS][2];
      _Pragma("unroll") for (int s = 0; s < NS; ++s)
        _Pragma("unroll") for (int k2 = 0; k2 < 2; ++k2)
          kfa[s][k2] = *(const bf16x8*)(sK0 + (k2 * 32 + l31) * 128 + (((kq0 + 2 * s + hf) ^ sw) << 4));
      _Pragma("unroll") for (int s = 0; s < NS; ++s)
        _Pragma("unroll") for (int k2 = 0; k2 < 2; ++k2)
          kfb[s][k2] = *(const bf16x8*)(sK1 + (k2 * 32 + l31) * 128 + (((kq0 + 2 * s + hf) ^ sw) << 4));
      __builtin_amdgcn_sched_barrier(0);
      _Pragma("unroll") for (int s = 0; s < NS; ++s)
        _Pragma("unroll") for (int k2 = 0; k2 < 2; ++k2)
          S0[k2] = MFMA32(kfa[s][k2], qf[s], s == 0 ? zc : S0[k2]);
      _Pragma("unroll") for (int s = 0; s < NS; ++s)
        _Pragma("unroll") for (int k2 = 0; k2 < 2; ++k2)
          S1[k2] = MFMA32(kfb[s][k2], qf[s], s == 0 ? zc : S1[k2]);
    }
    softmax_pv(S0, sK0 + 8192);
    softmax_pv(S1, sK1 + 8192);
  }
  RAW_BARRIER();
#undef ATT_STAGE
  const float inv = 1.f / xhalf_sum(lsum);
  const u16* zg = ((u16*)(p.ws + OFF_Z)) + (size_t)mq * INW;
  if (!DIFF) {
    _Pragma("unroll") for (int a = 0; a < 2; ++a)
      _Pragma("unroll") for (int i = 0; i < 4; ++i) {
        const int col = (unit * 2 + qi) * 64 + a * 32 + 8 * i + 4 * hf;
        const uint2 gv2 = *(const uint2*)(zg + 1536 + col);
        const float y0 = O[a][4 * i + 0] * inv * silu_f(bflo(gv2.x));
        const float y1 = O[a][4 * i + 1] * inv * silu_f(bfhi(gv2.x));
        const float y2 = O[a][4 * i + 2] * inv * silu_f(bflo(gv2.y));
        const float y3 = O[a][4 * i + 3] * inv * silu_f(bfhi(gv2.y));
        *(uint2*)(((u16*)(p.ws + OFF_Y)) + tix(mq, 256 + col, 32)) = make_uint2(pack2(y0, y1), pack2(y2, y3));
      }
  } else {
    float* xb = (float*)smem + qs * 32 * 64;
    if (qi == 1) {
      _Pragma("unroll") for (int a = 0; a < 2; ++a)
        _Pragma("unroll") for (int r = 0; r < 16; ++r) xb[(a * 16 + r) * 64 + lane] = O[a][r] * inv;
    }
    __syncthreads();
    if (qi == 0) {
      const float* lp = p.diff_lambda + l * 128;
      float d1 = 0.f, d2 = 0.f;
      for (int i = 0; i < 32; ++i) { d1 += lp[i] * lp[32 + i]; d2 += lp[64 + i] * lp[96 + i]; }
      const float lam_init = 0.8f - 0.6f * expf(-0.3f * (float)l);
      const float lam = expf(d1) - expf(d2) + lam_init;
      float ss = 0.f;
      _Pragma("unroll") for (int a = 0; a < 2; ++a)
        _Pragma("unroll") for (int r = 0; r < 16; ++r) {
          const float o = O[a][r] * inv - lam * xb[(a * 16 + r) * 64 + lane];
          O[a][r] = o;
          ss += o * o;
        }
      ss = xhalf_sum(ss);
      const float rinv = rsqrtf(ss * (1.f / 64.f) + EPSN) * (1.f - lam_init);
      const float* gn = p.diff_gain + l * 64;
      _Pragma("unroll") for (int a = 0; a < 2; ++a)
        _Pragma("unroll") for (int i = 0; i < 4; ++i) {
          const int nl = a * 32 + 8 * i + 4 * hf;
          const int col = unit * 64 + nl;
          const uint2 gv2 = *(const uint2*)(zg + 3584 + col);
          const float4 g4 = *(const float4*)(gn + nl);
          const float y0 = O[a][4 * i + 0] * rinv * g4.x * silu_f(bflo(gv2.x));
          const float y1 = O[a][4 * i + 1] * rinv * g4.y * silu_f(bfhi(gv2.x));
          const float y2 = O[a][4 * i + 2] * rinv * g4.z * silu_f(bflo(gv2.y));
          const float y3 = O[a][4 * i + 3] * rinv * g4.w * silu_f(bfhi(gv2.y));
          *(uint2*)(((u16*)(p.ws + OFF_Y)) + tix(mq, 768 + col, 32)) = make_uint2(pack2(y0, y1), pack2(y2, y3));
        }
    }
  }
}

DI void r3_item(CPar& p, int l, int item, unsigned char* smem) {
  const int tid = otid(), lane = tid & 63, w = tid >> 6, l31 = lane & 31, hf = lane >> 5;
  bool ctx; int bb, h, c, m0;
  ret_decode(item, ctx, bb, h, c, m0);
  const int iq = w * 32 + l31;
  const int mq = m0 + iq;
  const float LOG2E = 1.4426950408889634f;
  const float lf2 = log_gamma(p, l, 0, h) * LOG2E, lb2 = log_gamma(p, l, 1, h) * LOG2E;
  u16* sK = (u16*)smem;
  u16* sV = sK + 128 * LSTR;
  constexpr int VSTR = 136;
  const u16* Vt = ctx ? ((u16*)(p.ws + OFF_VtRc)) + ((size_t)(bb * 4 + h) * 64) * 256 + c * 128 : ((u16*)(p.ws + OFF_VtRl)) + ((size_t)(bb * 4 + h) * 64) * 4096 + c * 128;
  const int ldv = ctx ? 256 : 4096;
  __syncthreads();
  _Pragma("unroll") for (int i = 0; i < 4; ++i) {
    const int cidx = tid + 256 * i;
    { const int row = cidx >> 3, kc = cidx & 7;
      *(uint4*)(sK + row * LSTR + kc * 8) = *(const uint4*)(((u16*)(p.ws + OFF_Z)) + (size_t)(m0 + row) * INW + 2048 + h * 64 + kc * 8); }
    { const int dv = cidx >> 4, kc = cidx & 15;
      *(uint4*)(sV + dv * VSTR + kc * 8) = *(const uint4*)(Vt + (size_t)dv * ldv + kc * 8); }
  }
  bf16x8 qf[4];
  {
    const u16* zq = ((u16*)(p.ws + OFF_Z)) + (size_t)mq * INW + 1792 + h * 64 + hf * 8;
    _Pragma("unroll") for (int s = 0; s < 4; ++s) qf[s] = *(const bf16x8*)(zq + s * 16);
  }
  __syncthreads();
  f32x16 O[2];
  O[0] = zero16(); O[1] = zero16();
  _Pragma("unroll 1") for (int kt = 0; kt < 2; ++kt) {
    f32x16 S[2];
    S[0] = zero16(); S[1] = zero16();
    _Pragma("unroll") for (int s = 0; s < 4; ++s)
      _Pragma("unroll") for (int k2 = 0; k2 < 2; ++k2) {
        const bf16x8 kf = *(const bf16x8*)(sK + (kt * 64 + k2 * 32 + l31) * LSTR + s * 16 + hf * 8);
        S[k2] = MFMA32(kf, qf[s], S[k2]);
      }
    bf16x8 pf[4];
    _Pragma("unroll") for (int k2 = 0; k2 < 2; ++k2) {
      _Pragma("unroll") for (int r = 0; r < 16; ++r) {
        const int jk = kt * 64 + k2 * 32 + 8 * (r >> 2) + 4 * hf + (r & 3);
        const int d = iq - jk;
        float wgt;
        if (d > 0) wgt = __builtin_amdgcn_exp2f(lf2 * (float)d);
        else if (d < 0) wgt = __builtin_amdgcn_exp2f(lb2 * (float)(-d));
        else wgt = 2.f;
        S[k2][r] *= wgt;
      }
      _Pragma("unroll") for (int u = 0; u < 2; ++u) {
        u32x4 pk;
        pk[0] = pack2(S[k2][8 * u + 0], S[k2][8 * u + 1]);
        pk[1] = pack2(S[k2][8 * u + 2], S[k2][8 * u + 3]);
        pk[2] = pack2(S[k2][8 * u + 4], S[k2][8 * u + 5]);
        pk[3] = pack2(S[k2][8 * u + 6], S[k2][8 * u + 7]);
        pf[2 * k2 + u] = __builtin_bit_cast(bf16x8, pk);
      }
    }
    _Pragma("unroll") for (int a = 0; a < 2; ++a)
      _Pragma("unroll") for (int s2 = 0; s2 < 4; ++s2) {
        const bf16x8 vf = *(const bf16x8*)(sV + (a * 32 + l31) * VSTR + kt * 64 + 16 * s2 + 8 * hf);
        O[a] = MFMA32(vf, pf[s2], O[a]);
      }
  }
  _Pragma("unroll") for (int dir = 0; dir < 2; ++dir) {
    const u16* st = ((u16*)(p.ws + OFF_SinT)) + ((size_t)item * 2 + dir) * 4096;
    const float dq = dir == 0 ? __builtin_amdgcn_exp2f(lf2 * (float)(iq + 1)) : __builtin_amdgcn_exp2f(lb2 * (float)(128 - iq));
    _Pragma("unroll") for (int a = 0; a < 2; ++a) {
      f32x16 X = zero16();
      _Pragma("unroll") for (int s = 0; s < 4; ++s) {
        const bf16x8 sf = *(const bf16x8*)(st + (a * 32 + l31) * 64 + s * 16 + hf * 8);
        X = MFMA32(sf, qf[s], X);
      }
      _Pragma("unroll") for (int r = 0; r < 16; ++r) O[a][r] += X[r] * dq;
    }
  }
  float ss = 0.f;
  _Pragma("unroll") for (int a = 0; a < 2; ++a)
    _Pragma("unroll") for (int r = 0; r < 16; ++r) ss += O[a][r] * O[a][r];
  ss = xhalf_sum(ss);
  const float rinv = rsqrtf(ss * (1.f / 64.f) + EPSN);
  const u16* zg = ((u16*)(p.ws + OFF_Z)) + (size_t)mq * INW + 2560 + h * 64;
  _Pragma("unroll") for (int a = 0; a < 2; ++a)
    _Pragma("unroll") for (int i = 0; i < 4; ++i) {
      const int nl = a * 32 + 8 * i + 4 * hf;
      const uint2 gv2 = *(const uint2*)(zg + nl);
      const float y0 = O[a][4 * i + 0] * rinv * silu_f(bflo(gv2.x));
      const float y1 = O[a][4 * i + 1] * rinv * silu_f(bfhi(gv2.x));
      const float y2 = O[a][4 * i + 2] * rinv * silu_f(bflo(gv2.y));
      const float y3 = O[a][4 * i + 3] * rinv * silu_f(bfhi(gv2.y));
      *(uint2*)(((u16*)(p.ws + OFF_Y)) + tix(mq, 512 + h * 64 + nl, 32)) = make_uint2(pack2(y0, y1), pack2(y2, y3));
    }
}

DI void phaseC(CPar& p, int l, unsigned char* smem) {
  const int lane = otid() & 63, w = otid() >> 6, wn = w >> 1, wt = w & 1, l31 = lane & 31, hf = lane >> 5;
  u16* Mg = ((u16*)(p.ws + OFF_Z));
  for (int tile = vblock(); tile < 8 * 320; tile += gridDim.x) {
    const int grp = tile / 640, rem = tile - grp * 640;
    const int tm = rem >> 1, tn = grp * 2 + (rem & 1);
    unsigned mgp[2][2][8];
    _Pragma("unroll") for (int a = 0; a < 2; ++a)
      _Pragma("unroll") for (int b = 0; b < 2; ++b)
        _Pragma("unroll") for (int r = 0; r < 8; ++r) mgp[a][b][r] = 0u;
    const u16* Ht = ((u16*)(p.ws + OFF_H)) + ((size_t)(tm * 32) << 12);
    _Pragma("unroll 1") for (int pr = 0; pr < 2; ++pr) {
      unsigned gp[2][4][8];
      {
        f32x16 acc[2][4];
        _Pragma("unroll") for (int a = 0; a < 2; ++a)
          _Pragma("unroll") for (int b = 0; b < 4; ++b) acc[a][b] = zero16();
        gemm_acc<4, true, true>(Ht, ((u16*)(p.ws + OFF_WgT)) + (size_t)l * 4096 * 1024 + ((size_t)((pr * 16 + tn) * 32) << 12), 8 * 32 * 4096, 32, acc, (u16*)smem);
        _Pragma("unroll") for (int a = 0; a < 2; ++a)
          _Pragma("unroll") for (int b = 0; b < 4; ++b)
            _Pragma("unroll") for (int r = 0; r < 8; ++r) gp[a][b][r] = pack2(sigmoid_f(acc[a][b][2 * r]), sigmoid_f(acc[a][b][2 * r + 1]));
      }
      _Pragma("unroll") for (int bh = 0; bh < 2; ++bh) {
        const int br = pr * 2 + bh;
        f32x16 acc[2][2];
        _Pragma("unroll") for (int a = 0; a < 2; ++a)
          _Pragma("unroll") for (int b = 0; b < 2; ++b) acc[a][b] = zero16();
        gemm_acc<2, false, true>(((u16*)(p.ws + OFF_Y)) + ((size_t)(tm * 32 + br * 8) << 12), ((u16*)(p.ws + OFF_WbT)) + (size_t)l * 1024 * 1024 + ((size_t)(tn * 32 + br * 8) << 12), 0, 8, acc, (u16*)smem);
        _Pragma("unroll") for (int a = 0; a < 2; ++a)
          _Pragma("unroll") for (int b = 0; b < 2; ++b)
            _Pragma("unroll") for (int r = 0; r < 8; ++r)
              mgp[a][b][r] = pack2(bflo(mgp[a][b][r]) + bflo(gp[a][bh * 2 + b][r]) * acc[a][b][2 * r], bfhi(mgp[a][b][r]) + bfhi(gp[a][bh * 2 + b][r]) * acc[a][b][2 * r + 1]);
      }
    }
    _Pragma("unroll") for (int a = 0; a < 2; ++a)
      _Pragma("unroll") for (int b = 0; b < 2; ++b) {
        const int n = tn * 128 + wt * 64 + b * 32 + l31;
        _Pragma("unroll") for (int r = 0; r < 8; ++r) {
          const int t0 = tm * 128 + wn * 64 + a * 32 + 8 * ((2 * r) >> 2) + 4 * hf + ((2 * r) & 3);
          Mg[tix(t0, n, 32)] = (u16)(mgp[a][b][r] & 0xffffu);
          Mg[tix(t0 + 1, n, 32)] = (u16)(mgp[a][b][r] >> 16);
        }
      }
  }
}

template <int TB>
DI void d_epilogue(CPar& p, int l, int tm, int nb0, f32x16 (&acc)[2][TB]) {
  const int lane = otid() & 63, w = otid() >> 6, wn = w >> 1, wt = w & 1, l31 = lane & 31, hf = lane >> 5;
  const int m0 = tm * 128 + wn * 64;
  const int j = m0 < MC ? 0 : 1 + ((m0 - MC) >> 12);
  const float* gate = ((float*)(p.ws + OFF_mod)) + (l * 9 + j) * 3072 + 2048;
  const float* xsrc = (l == 0) ? (m0 < MC ? p.x_prompt : p.x_sample - (size_t)MC * 1024) : p.out;
  _Pragma("unroll") for (int b = 0; b < TB; ++b) {
    const int n = (TB == 2) ? nb0 + wt * 64 + b * 32 + l31 : nb0 + (b >> 1) * 128 + wt * 64 + (b & 1) * 32 + l31;
    const float gv = gate[n];
    const size_t o0 = (size_t)(m0 + 4 * hf) * 1024 + n;
    const float* xp = xsrc + o0;
    float* op = p.out + o0;
    _Pragma("unroll") for (int a = 0; a < 2; ++a)
      _Pragma("unroll") for (int i = 0; i < 4; ++i) {
        float xv[4];
        _Pragma("unroll") for (int q = 0; q < 4; ++q) xv[q] = xp[q * 1024];
        _Pragma("unroll") for (int q = 0; q < 4; ++q) op[q * 1024] = xv[q] + gv * acc[a][b][4 * i + q];
        xp += 8 * 1024; op += 8 * 1024;
        asm volatile("" : "+v"(xp), "+v"(op));
      }
  }
}

DI void phaseD(CPar& p, int l, unsigned char* smem) {
  const u16* Mg = ((u16*)(p.ws + OFF_Z));
  const u16* Wo = ((u16*)(p.ws + OFF_WoT)) + (size_t)l * 1024 * 1024;
  for (int tile = vblock(); tile < 1024 + 512; tile += gridDim.x) {
    if (tile < 1024) {
      const int np = tile & 3, tm = tile >> 2;
      f32x16 acc[2][4];
      _Pragma("unroll") for (int a = 0; a < 2; ++a)
        _Pragma("unroll") for (int b = 0; b < 4; ++b) acc[a][b] = zero16();
      gemm_acc<4, true>(Mg + ((size_t)(tm * 32) << 12), Wo + ((size_t)(np * 2 * 32) << 12), 32 * 4096, 32, acc, (u16*)smem);
      d_epilogue<4>(p, l, tm, np * 256, acc);
    } else {
      const int t2 = tile - 1024, big = 1024 + (t2 >> 1), np = big & 3, tm = big >> 2, tn = np * 2 + (t2 & 1);
      f32x16 acc[2][2];
      _Pragma("unroll") for (int a = 0; a < 2; ++a)
        _Pragma("unroll") for (int b = 0; b < 2; ++b) acc[a][b] = zero16();
      gemm_acc<2>(Mg + ((size_t)(tm * 32) << 12), Wo + ((size_t)(tn * 32) << 12), 0, 32, acc, (u16*)smem);
      d_epilogue<2>(p, l, tm, tn * 128, acc);
    }
  }
}

DI void phaseFinal(CPar& p) {
  const int tid = otid(), lane = tid & 63;
  const int gw = blockIdx.x * 4 + (tid >> 6), nw = gridDim.x * 4;
  for (int row = gw; row < MT; row += nw) {
    float* xr = p.out + (size_t)row * 1024;
    float4 v[4];
    float ss = 0.f;
    _Pragma("unroll") for (int i = 0; i < 4; ++i) {
      v[i] = ((const float4*)xr)[lane + 64 * i];
      ss += v[i].x * v[i].x + v[i].y * v[i].y + v[i].z * v[i].z + v[i].w * v[i].w;
    }
    ss = wave_sum(ss);
    const float rstd = rsqrtf(ss * (1.f / 1024.f) + EPSN);
    _Pragma("unroll") for (int i = 0; i < 4; ++i) {
      const float4 g = *(const float4*)(p.final_gain + 4 * (lane + 64 * i));
      ((float4*)xr)[lane + 64 * i] = make_float4(v[i].x * rstd * g.x, v[i].y * rstd * g.y, v[i].z * rstd * g.z, v[i].w * rstd * g.w);
    }
  }
}

__global__ void __launch_bounds__(256, 2) hybrid_megakernel(Params p_unused) {
  cg::grid_group grid = cg::this_grid();
  __shared__ __attribute__((aligned(16))) unsigned char smem[SMEM_BYTES];
  __shared__ uint4 xb_words;
  if (threadIdx.x == 0) xb_words = make_uint4(0u, 0u, 0u, 0u);
  __syncthreads();
  XcdBarrier xb = xcd_barrier_post(((unsigned*)(PP().ws + OFF_bar)), (volatile LAS unsigned*)&xb_words);
  phase0(PP(), smem);
  grid.sync();
  _Pragma("unroll 1") for (int l = 0; l < 2; ++l) {
    phaseA0(PP(), l);
    xcd_barrier(xb);
    phaseA1(PP(), l, smem);
    xcd_barrier(xb);
    r1_items(PP(), l, smem);
    xcd_barrier(xb);
    for (int rep = 0; rep < REP_B2; ++rep)
    for (int it = vblock(); it < 1024 + 1024 + 2048 + 256 + 512 + 4096; it += gridDim.x) {
      if (it < 1024) r2_item<false>(PP(), l, it);
      else if (it < 2048) { const int i = it - 1024; attn_item<false>(PP(), l, false, i >> 7, (i >> 6) & 1, i & 63, smem); }
      else if (it < 4096) { const int i = it - 2048; attn_item<true>(PP(), l, false, i >> 8, (i >> 6) & 3, i & 63, smem); }
      else if (it < 4352) { const int i = it - 4096; attn_item<false>(PP(), l, true, i >> 3, (i >> 2) & 1, i & 3, smem); }
      else if (it < 4864) { const int i = it - 4352; attn_item<true>(PP(), l, true, i >> 4, (i >> 2) & 3, i & 3, smem); }
      else r2_item<true>(PP(), l, it - 4864);
    }
    {
      unsigned* ctr = (unsigned*)(PP().ws + OFF_tctr) + l;
      volatile LAS unsigned* slot = (volatile LAS unsigned*)&xb_words + 2;
      for (;;) {
        __syncthreads();
        if (threadIdx.x == 0) *slot = __hip_atomic_fetch_add(ctr, 1u, __ATOMIC_RELAXED, __HIP_MEMORY_SCOPE_AGENT);
        __syncthreads();
        const int it = (int)*slot;
        if (it >= MT * 32 / 256) break;
        conv_item(PP(), l, it);
      }
    }
    xcd_barrier(xb);
    for (int it = vblock(); it < 1280; it += gridDim.x) r3_item(PP(), l, it, smem);
    xcd_barrier(xb);
    phaseC(PP(), l, smem);
    xcd_barrier(xb);
    phaseD(PP(), l, smem);
    xcd_barrier(xb);
  }
  phaseFinal(PP());
}

extern "C" void kernel_launch(void* const* d_in, const int* in_sizes, int n_in, void* d_out, int out_size, void* d_ws, size_t ws_size,
                              hipStream_t stream) {
  static int grid_blocks = 0;
  if (!grid_blocks) {
    int dev = 0, cus = 0, per_cu = 0;
    (void)hipGetDevice(&dev);
    (void)hipDeviceGetAttribute(&cus, hipDeviceAttributeMultiprocessorCount, dev);
    (void)hipOccupancyMaxActiveBlocksPerMultiprocessor(&per_cu, hybrid_megakernel, 256, 0);
    if (per_cu > 2) per_cu = 2;
    if (per_cu < 1) per_cu = 1;
    grid_blocks = cus * per_cu;
  }
  Params p{};
  const float** fin = (const float**)&p.x_prompt;
  for (int i = 0; i < 23; ++i) fin[i] = (const float*)d_in[i];
  p.out = (float*)d_out;
  p.ws = (unsigned char*)d_ws;
  const size_t off = WS_NEED;
  if (off > ws_size) { fprintf(stderr, "workspace too small: need %zu have %zu\n", off, ws_size); return; }
  (void)hipMemsetAsync(p.ws + OFF_bar, 0, XCD_BAR_WORDS * 4, stream);
  (void)hipMemsetAsync(p.ws + OFF_tctr, 0, 256, stream);
  void* args[] = {&p};
  hipError_t e = hipLaunchCooperativeKernel((void*)hybrid_megakernel, dim3(grid_blocks), dim3(256), args, 0, stream);
  if (e != hipSuccess) fprintf(stderr, "cooperative launch failed: %s (grid %d)\n", hipGetErrorString(e), grid_blocks);
}
```

```cpp
#include <hip/hip_runtime.h>
#include <hip/hip_bf16.h>
#include <hip/hip_cooperative_groups.h>
#include <cstdio>
namespace cg = cooperative_groups;

typedef unsigned short u16;
using bf16x8 = __attribute__((ext_vector_type(8))) short;
using f32x16 = __attribute__((ext_vector_type(16))) float;
using u32x4 = __attribute__((ext_vector_type(4))) unsigned;
using u32x2 = __attribute__((ext_vector_type(2))) unsigned;

#define DI __device__ __forceinline__
#define MFMA32(a, b, c) __builtin_amdgcn_mfma_f32_32x32x16_bf16((a), (b), (c), 0, 0, 0)

#ifndef REP_A1
#define REP_A1 1
#endif
#ifndef REP_B2
#define REP_B2 1
#endif
#ifndef PIPE_C
#define PIPE_C true
#endif
constexpr int DM = 1024;
constexpr int INW = 3840;
constexpr int MC = 8192;
constexpr int MT = 40960;
constexpr int NKL = 4608;
constexpr int LSTR = 72;
constexpr float EPSN = 1e-6f;
constexpr int SMEM_BYTES = 2 * 2 * 128 * LSTR * 2;

constexpr size_t OUT_GK = 41943040ull;
constexpr size_t OUT_GV = 44040192ull;
constexpr size_t OUT_DK = 46137344ull;
constexpr size_t OUT_DV = 50331648ull;
constexpr size_t OUT_ST = 54525952ull;

constexpr size_t OFF_WinT = 0ull;
constexpr size_t OFF_WgT = 15728640ull;
constexpr size_t OFF_WbT = 32505856ull;
constexpr size_t OFF_WoT = 36700160ull;
constexpr size_t OFF_mod = 40894464ull;
constexpr size_t OFF_rope = 41115648ull;
constexpr size_t OFF_H = 41123840ull;
constexpr size_t OFF_Z = 125009920ull;
constexpr size_t OFF_KG = 439582720ull;
constexpr size_t OFF_VtG = 449019904ull;
constexpr size_t OFF_KD = 458457088ull;
constexpr size_t OFF_VtD = 477331456ull;
constexpr size_t OFF_VtGc = 496205824ull;
constexpr size_t OFF_VtDc = 498302976ull;
constexpr size_t OFF_VtRc = 502497280ull;
constexpr size_t OFF_VtRl = 506691584ull;
constexpr size_t OFF_U = 523468800ull;
constexpr size_t OFF_SinT = 565411840ull;
constexpr size_t OFF_Y = 586383360ull;
constexpr size_t OFF_bar = 670269440ull;
constexpr size_t OFF_KtRc = 670283264ull;
constexpr size_t OFF_KtRl = 674477568ull;
constexpr size_t OFF_tctr = 691254784ull;
constexpr size_t WS_NEED = 691255040ull;
struct Params {
  const float *x_prompt, *x_sample, *cache_gk, *cache_gv, *cache_dk, *cache_dv, *state_ret, *c, *c_ctx, *w_ada, *b_ada,
      *norm_gain, *w_in, *conv_w, *q_gain, *k_gain, *ret_decay, *diff_lambda, *diff_gain, *w_branch, *w_mgate, *w_out, *final_gain;
  float* out;
  unsigned char* ws;
};

typedef float f32x2 __attribute__((ext_vector_type(2)));
typedef __bf16 bf16x2_t __attribute__((ext_vector_type(2)));
typedef const Params __attribute__((address_space(4))) CPar;
DI CPar& PP() { CPar* q = (CPar*)__builtin_amdgcn_kernarg_segment_ptr(); asm volatile("" : "+s"(q)); return *q; }
DI unsigned pack2(float a, float b) {
  const f32x2 v = {a, b};
  return __builtin_bit_cast(unsigned, __builtin_convertvector(v, bf16x2_t));
}
DI u16 f2bf(float a) { return (u16)(pack2(a, 0.f) & 0xffffu); }
DI float bflo(unsigned v) { return __uint_as_float(v << 16); }
DI float bfhi(unsigned v) { return __uint_as_float(v & 0xffff0000u); }
DI float silu_f(float x) { return x * __builtin_amdgcn_rcpf(1.f + __expf(-x)); }
DI float sigmoid_f(float x) { return __builtin_amdgcn_rcpf(1.f + __expf(-x)); }
DI f32x16 zero16() { f32x16 z; _Pragma("unroll") for (int i = 0; i < 16; ++i) z[i] = 0.f; return z; }
DI int otid() { int t = (int)__builtin_amdgcn_workitem_id_x(); asm volatile("" : "+v"(t)); return t; }
DI int vblock() { const int b = (int)blockIdx.x, g = (int)gridDim.x; return ((g & 7) == 0) ? (b & 7) * (g >> 3) + (b >> 3) : b; }
DI size_t tix(int r, int k, int ksl) { return ((size_t)((r >> 7) * ksl + (k >> 5)) << 12) + ((r & 127) << 5) + (k & 31); }
#define XB_TMO      128
#define XB_XCNT(j)  (256  + 64 * (j))
#define XB_XSUB(j)  (1280 + 64 * (j))
#define XB_XGEN(j)  (2304 + 64 * (j))
#define XB_TOP      3328
#define XB_TOPGEN   3392
#define XCD_BAR_WORDS 3456
#define XB_SPIN_CAP (1u << 18)
#define LAS __attribute__((address_space(3)))

__device__ __forceinline__ unsigned xb_ld(unsigned* p)              { return __hip_atomic_load(p, __ATOMIC_RELAXED, __HIP_MEMORY_SCOPE_AGENT); }
__device__ __forceinline__ unsigned xb_add(unsigned* p, unsigned v) { return __hip_atomic_fetch_add(p, v, __ATOMIC_RELAXED, __HIP_MEMORY_SCOPE_AGENT); }
__device__ __forceinline__ unsigned xb_xcc_id() { return (unsigned)__builtin_amdgcn_s_getreg((3 << 11) | 20) & 0xFu; }
#define XB_SPIN(cond, bar) do { unsigned _sp = 0; while (cond) { __builtin_amdgcn_s_sleep(1); \
    if ((++_sp & 255u) == 0u) { if (xb_ld(&(bar)[XB_TMO])) break; if (_sp > XB_SPIN_CAP) { atomicAdd(&(bar)[XB_TMO], 1u); break; } } } } while (0)

struct XcdBarrier {
    unsigned* bar; unsigned x;
    volatile LAS unsigned* st;
};

__device__ __forceinline__ XcdBarrier xcd_barrier_post(unsigned* bar, volatile LAS unsigned* st) {
    XcdBarrier b; b.bar = bar; b.x = xb_xcc_id(); b.st = st;
    if (threadIdx.x == 0) (void)xb_add(&bar[XB_XCNT(b.x)], 1u);
    return b;
}
__device__ __forceinline__ void xcd_barrier_complete(unsigned* bar, unsigned x, unsigned& nloc, unsigned& nx) {
    const unsigned G = gridDim.x * gridDim.y * gridDim.z;
    unsigned sum, cnt, mine, sp = 0u;
    for (;;) {
        sum = 0u; cnt = 0u; mine = 0u;
#pragma unroll
        for (unsigned j = 0; j < 16; ++j) { const unsigned c = xb_ld(&bar[XB_XCNT(j)]); sum += c; cnt += (c > 0u) ? 1u : 0u; mine = (j == x) ? c : mine; }
        if (sum == G) break;
        __builtin_amdgcn_s_sleep(1);
        if ((++sp & 255u) == 0u) { if (xb_ld(&bar[XB_TMO])) break; if (sp > XB_SPIN_CAP) { atomicAdd(&bar[XB_TMO], 1u); break; } }
    }
    nloc = mine > 0u ? mine : 1u; nx = cnt > 0u ? cnt : 1u;
}

__device__ __forceinline__ void xcd_barrier(const XcdBarrier& b) {
    asm volatile("s_waitcnt vmcnt(0)" ::: "memory");
    __syncthreads();
    if (threadIdx.x == 0) {
        unsigned* bar = b.bar;
        __builtin_amdgcn_s_waitcnt(0);
        unsigned nloc = b.st[0], nx = b.st[1];
        if (nloc == 0u) { xcd_barrier_complete(bar, b.x, nloc, nx); b.st[0] = nloc; b.st[1] = nx; }
        const unsigned old = xb_add(&bar[XB_XSUB(b.x)], 1u);
        const unsigned gen = old / nloc;
        if (old + 1u == (gen + 1u) * nloc) {
            __builtin_amdgcn_fence(__ATOMIC_RELEASE, "agent");
            asm volatile("s_waitcnt vmcnt(0)" ::: "memory");
            const unsigned og = xb_add(&bar[XB_TOP], 1u);
            const unsigned tg = og / nx;
            if (og + 1u == (tg + 1u) * nx) xb_add(&bar[XB_TOPGEN], 1u);
            else XB_SPIN(xb_ld(&bar[XB_TOPGEN]) == tg, bar);
            __builtin_amdgcn_fence(__ATOMIC_ACQUIRE, "agent");
            xb_add(&bar[XB_XGEN(b.x)], 1u);
            asm volatile("s_waitcnt vmcnt(0)" ::: "memory");
        } else {
            XB_SPIN(xb_ld(&bar[XB_XGEN(b.x)]) == gen, bar);
            __builtin_amdgcn_fence(__ATOMIC_ACQUIRE, "agent");
            asm volatile("s_waitcnt vmcnt(0)" ::: "memory");
        }
    }
    __syncthreads();
}


DI int kperm(int t) { return (t & ~12) | ((t & 4) << 1) | ((t & 8) >> 1); }
DI float xhalf_max(float x) {
  const auto r = __builtin_amdgcn_permlane32_swap(__float_as_uint(x), __float_as_uint(x), false, false);
  return fmaxf(__uint_as_float(r[0]), __uint_as_float(r[1]));
}
DI float xhalf_sum(float x) {
  const auto r = __builtin_amdgcn_permlane32_swap(__float_as_uint(x), __float_as_uint(x), false, false);
  return __uint_as_float(r[0]) + __uint_as_float(r[1]);
}
DI float wave_sum(float v) {
  _Pragma("unroll") for (int o = 1; o < 64; o <<= 1) v += __shfl_xor(v, o);
  return v;
}

#define VMWAIT(N) asm volatile("s_waitcnt vmcnt(" #N ")" ::: "memory")
#define RAW_BARRIER() do { asm volatile("s_waitcnt lgkmcnt(0)" ::: "memory"); __builtin_amdgcn_s_barrier(); } while (0)
template <int TB, bool BMAP = false, bool LEAN = false>
DI void gemm_acc(const u16* __restrict__ A, const u16* __restrict__ B, int bstride, int nk, f32x16 (&acc)[2][TB], u16* sm) {
  const int tid = otid(), lane = tid & 63, w = tid >> 6, wn = w >> 1, wt = w & 1, l31 = lane & 31, hf = lane >> 5;
  constexpr int NSTG = (TB == 2) ? 4 : 3;
  constexpr int RB = 64 * TB;
  constexpr int STGB = (128 + RB) * 64;
  constexpr int LPB = RB / 64;
  const int lr = tid >> 2, gsl = (tid & 3) ^ ((lr >> 2) & 3);
  const u16* ga = A + lr * 32 + gsl * 8;
  const u16* gb = B + lr * 32 + gsl * 8;
  char* smb = (char*)sm;
  const int wv = __builtin_amdgcn_readfirstlane(w);
  char* smw = smb + wv * 1024;
  const u16* pa[2];
  const u16* pb[LPB];
  _Pragma("unroll") for (int i = 0; i < 2; ++i) pa[i] = ga + 2048 * i;
  _Pragma("unroll") for (int i = 0; i < LPB; ++i) pb[i] = BMAP ? gb + (size_t)(i & 1) * bstride + 2048 * (i >> 1) : gb + (size_t)(i >> 1) * bstride + 2048 * (i & 1);
#define GEMM_STAGE(ST) do { \
    _Pragma("unroll") for (int i = 0; i < 2; ++i) { \
      __builtin_amdgcn_global_load_lds((const unsigned*)pa[i], (unsigned*)(smw + (ST) * STGB + i * 4096), 16, 0, 0); pa[i] += 4096; } \
    _Pragma("unroll") for (int i = 0; i < LPB; ++i) { \
      __builtin_amdgcn_global_load_lds((const unsigned*)pb[i], (unsigned*)(smw + (ST) * STGB + 8192 + i * 4096), 16, 0, 0); pb[i] += 4096; } \
  } while (0)
  VMWAIT(0);
  _Pragma("unroll") for (int s0 = 0; s0 < NSTG - 1; ++s0) GEMM_STAGE(s0);
  const int sw = (l31 >> 2) & 3;
  const int oa0 = (wn * 64 + l31) * 64 + ((hf ^ sw) << 4), oa1 = (wn * 64 + l31) * 64 + (((2 + hf) ^ sw) << 4);
  const int ob0 = 8192 + (wt * 32 * TB + l31) * 64 + ((hf ^ sw) << 4), ob1 = 8192 + (wt * 32 * TB + l31) * 64 + (((2 + hf) ^ sw) << 4);
  int st = 0, stn = NSTG - 1;
  bf16x8 dfa[2], dfb[TB];
  _Pragma("unroll") for (int a = 0; a < 2; ++a) dfa[a] = bf16x8{0, 0, 0, 0, 0, 0, 0, 0};
  _Pragma("unroll") for (int b = 0; b < TB; ++b) dfb[b] = bf16x8{0, 0, 0, 0, 0, 0, 0, 0};
  for (int kt = 0; kt < nk; ++kt) {
    if (kt + NSTG - 2 < nk) { if (TB == 2) VMWAIT(8); else VMWAIT(6); }
    else if (NSTG == 4 && kt + 1 < nk) VMWAIT(4);
    else VMWAIT(0);
    RAW_BARRIER();
    if (kt + NSTG - 1 < nk) GEMM_STAGE(stn);
    __builtin_amdgcn_sched_barrier(0);
    const char* sb = smb + st * STGB;
    if (!LEAN) {
      bf16x8 fa0[2], fb0[TB], fa1[2], fb1[TB];
      _Pragma("unroll") for (int a = 0; a < 2; ++a) fa0[a] = *(const bf16x8*)(sb + oa0 + a * 2048);
      _Pragma("unroll") for (int b = 0; b < TB; ++b) fb0[b] = *(const bf16x8*)(sb + ob0 + b * 2048);
      _Pragma("unroll") for (int a = 0; a < 2; ++a) fa1[a] = *(const bf16x8*)(sb + oa1 + a * 2048);
      _Pragma("unroll") for (int b = 0; b < TB; ++b) fb1[b] = *(const bf16x8*)(sb + ob1 + b * 2048);
      __builtin_amdgcn_sched_barrier(0);
      _Pragma("unroll") for (int a = 0; a < 2; ++a)
        _Pragma("unroll") for (int b = 0; b < TB; ++b) acc[a][b] = MFMA32(dfa[a], dfb[b], acc[a][b]);
      __builtin_amdgcn_sched_barrier(0);
      _Pragma("unroll") for (int a = 0; a < 2; ++a)
        _Pragma("unroll") for (int b = 0; b < TB; ++b) acc[a][b] = MFMA32(fa0[a], fb0[b], acc[a][b]);
      __builtin_amdgcn_sched_barrier(0);
      _Pragma("unroll") for (int a = 0; a < 2; ++a) dfa[a] = fa1[a];
      _Pragma("unroll") for (int b = 0; b < TB; ++b) dfb[b] = fb1[b];
    } else {
      _Pragma("unroll") for (int ks = 0; ks < 2; ++ks) {
        bf16x8 fa[2], fb[TB];
        _Pragma("unroll") for (int a = 0; a < 2; ++a) fa[a] = *(const bf16x8*)(sb + (ks ? oa1 : oa0) + a * 2048);
        _Pragma("unroll") for (int b = 0; b < TB; ++b) fb[b] = *(const bf16x8*)(sb + (ks ? ob1 : ob0) + b * 2048);
        __builtin_amdgcn_sched_barrier(0);
        _Pragma("unroll") for (int a = 0; a < 2; ++a)
          _Pragma("unroll") for (int b = 0; b < TB; ++b) acc[a][b] = MFMA32(fa[a], fb[b], acc[a][b]);
        __builtin_amdgcn_sched_barrier(0);
      }
    }
    st = (st + 1 == NSTG) ? 0 : st + 1;
    stn = (stn + 1 == NSTG) ? 0 : stn + 1;
  }
  if (!LEAN) {
    _Pragma("unroll") for (int a = 0; a < 2; ++a)
      _Pragma("unroll") for (int b = 0; b < TB; ++b) acc[a][b] = MFMA32(dfa[a], dfb[b], acc[a][b]);
  }
  RAW_BARRIER();
#undef GEMM_STAGE
}

DI void phase0(CPar& p, unsigned char* smem) {
  const int tid = otid();
  float* tile = (float*)smem;
  for (int job = blockIdx.x; job < 4992; job += gridDim.x) {
    const int l = job / 2496;
    int rem = job - l * 2496;
    const float* src; u16* dst; int C;
    if (rem < 960) { src = p.w_in + (size_t)l * 1024 * 3840; dst = ((u16*)(p.ws + OFF_WinT)) + (size_t)l * 3840 * 1024; C = 3840; }
    else if (rem < 1984) { rem -= 960; src = p.w_mgate + (size_t)l * 1024 * 4096; dst = ((u16*)(p.ws + OFF_WgT)) + (size_t)l * 4096 * 1024; C = 4096; }
    else if (rem < 2240) { rem -= 1984; src = p.w_branch + (size_t)l * 1024 * 1024; dst = ((u16*)(p.ws + OFF_WbT)) + (size_t)l * 1024 * 1024; C = 1024; }
    else { rem -= 2240; src = p.w_out + (size_t)l * 1024 * 1024; dst = ((u16*)(p.ws + OFF_WoT)) + (size_t)l * 1024 * 1024; C = 1024; }
    const int tr = rem & 15, tc = rem >> 4;
    const int r0 = tr * 64, c0 = tc * 64;
    __syncthreads();
    _Pragma("unroll") for (int i = 0; i < 4; ++i) {
      const int rr = (tid >> 4) + 16 * i, cc = (tid & 15) * 4;
      const float4 v = *(const float4*)(src + (size_t)(r0 + rr) * C + c0 + cc);
      tile[rr * 65 + cc + 0] = v.x; tile[rr * 65 + cc + 1] = v.y; tile[rr * 65 + cc + 2] = v.z; tile[rr * 65 + cc + 3] = v.w;
    }
    __syncthreads();
    {
      const int n = tid >> 2, kq = (tid & 3) * 16;
      unsigned wv[8];
      _Pragma("unroll") for (int j = 0; j < 8; ++j) wv[j] = pack2(tile[(kq + 2 * j) * 65 + n], tile[(kq + 2 * j + 1) * 65 + n]);
      u16* d = dst + tix(c0 + n, r0 + kq, 32);
      *(uint4*)d = make_uint4(wv[0], wv[1], wv[2], wv[3]);
      *(uint4*)(d + 8) = make_uint4(wv[4], wv[5], wv[6], wv[7]);
    }
  }
  __syncthreads();
  if (blockIdx.x < 384) {
  {
    float* sc = (float*)smem;
    float* red = sc + 9 * 1024;
    for (int i = tid; i < 9 * 1024; i += 256) {
      const int j = i >> 10, k = i & 1023;
      const float cv = (j == 0) ? p.c_ctx[k] : p.c[(j - 1) * 1024 + k];
      sc[i] = silu_f(cv);
    }
    __syncthreads();
    for (int item = blockIdx.x; item < 384; item += gridDim.x) {
    const int lane = tid & 63, w = tid >> 6;
    const int l = item / 192, n = (item % 192) * 16 + (lane & 15);
    const int kbeg = (w * 4 + (lane >> 4)) * 64;
    float acc[9];
    _Pragma("unroll") for (int j = 0; j < 9; ++j) acc[j] = 0.f;
    const float* wp = p.w_ada + (size_t)l * 1024 * 3072 + n;
    for (int k = kbeg; k < kbeg + 64; k += 8) {
      float wv[8];
      _Pragma("unroll") for (int u = 0; u < 8; ++u) wv[u] = wp[(size_t)(k + u) * 3072];
      _Pragma("unroll") for (int u = 0; u < 8; ++u)
        _Pragma("unroll") for (int j = 0; j < 9; ++j) acc[j] += sc[j * 1024 + k + u] * wv[u];
    }
    _Pragma("unroll") for (int j = 0; j < 9; ++j) {
      acc[j] += __shfl_xor(acc[j], 16);
      acc[j] += __shfl_xor(acc[j], 32);
    }
    if (lane < 16) {
      _Pragma("unroll") for (int j = 0; j < 9; ++j) red[(w * 9 + j) * 16 + lane] = acc[j];
    }
    __syncthreads();
    if (tid < 144) {
      const int j = tid >> 4, nn = tid & 15;
      const int n2 = (item % 192) * 16 + nn;
      const float v = red[(0 * 9 + j) * 16 + nn] + red[(1 * 9 + j) * 16 + nn] + red[(2 * 9 + j) * 16 + nn] + red[(3 * 9 + j) * 16 + nn];
      ((float*)(p.ws + OFF_mod))[(l * 9 + j) * 3072 + n2] = v + p.b_ada[l * 3072 + n2];
    }
    __syncthreads();
    }
  }
  }
  if (blockIdx.x == gridDim.x - 1) {
    for (int i = tid; i < 1024; i += 256) {
      const int pos = i >> 4, f = i & 15;
      const float inv = powf(10000.f, -(float)f / 16.f);
      const float ang = (float)pos * inv;
      ((float*)(p.ws + OFF_rope))[2 * i] = cosf(ang);
      ((float*)(p.ws + OFF_rope))[2 * i + 1] = sinf(ang);
    }
  }
}

DI void phaseA0(CPar& p, int l) {
  const int tid = otid(), lane = tid & 63;
  const int gw = blockIdx.x * 4 + (tid >> 6), nw = gridDim.x * 4;
  const float* ng = p.norm_gain + l * 1024;
  for (int row = gw; row < MT; row += nw) {
    const float* xr = (l == 0) ? (row < MC ? p.x_prompt + (size_t)row * 1024 : p.x_sample + (size_t)(row - MC) * 1024)
                               : p.out + (size_t)row * 1024;
    float4 v[4];
    float ss = 0.f;
    _Pragma("unroll") for (int i = 0; i < 4; ++i) {
      v[i] = ((const float4*)xr)[lane + 64 * i];
      ss += v[i].x * v[i].x + v[i].y * v[i].y + v[i].z * v[i].z + v[i].w * v[i].w;
    }
    ss = wave_sum(ss);
    const float rstd = rsqrtf(ss * (1.f / 1024.f) + EPSN);
    const int j = row < MC ? 0 : 1 + ((row - MC) >> 12);
    const float* shift = ((float*)(p.ws + OFF_mod)) + (l * 9 + j) * 3072;
    const float* scale = shift + 1024;
    _Pragma("unroll") for (int i = 0; i < 4; ++i) {
      const int k = 4 * (lane + 64 * i);
      const float4 g = *(const float4*)(ng + k);
      const float4 s = *(const float4*)(scale + k);
      const float4 sh = *(const float4*)(shift + k);
      const float h0 = v[i].x * rstd * g.x * (1.f + s.x) + sh.x;
      const float h1 = v[i].y * rstd * g.y * (1.f + s.y) + sh.y;
      const float h2 = v[i].z * rstd * g.z * (1.f + s.z) + sh.z;
      const float h3 = v[i].w * rstd * g.w * (1.f + s.w) + sh.w;
      *(uint2*)(((u16*)(p.ws + OFF_H)) + tix(row, k, 32)) = make_uint2(pack2(h0, h1), pack2(h2, h3));
    }
  }
  const int gt = blockIdx.x * 256 + tid, nt = gridDim.x * 256;
  for (int idx = gt; idx < 8 * 65536; idx += nt) {
    const int b = idx >> 16, rem = idx & 65535;
    ((u16*)(p.ws + OFF_KG))[(size_t)b * NKL * 128 + rem] = f2bf(p.cache_gk[(size_t)(b * 2 + l) * 65536 + rem]);
  }
  for (int idx = gt; idx < 8 * 131072; idx += nt) {
    const int b = idx >> 17, rem = idx & 131071;
    ((u16*)(p.ws + OFF_KD))[(size_t)b * NKL * 256 + rem] = f2bf(p.cache_dk[(size_t)(b * 2 + l) * 131072 + rem]);
  }
  for (int idx = gt; idx < 8 * 2 * 64 * 512; idx += nt) {
    const int pk = idx & 511, dv = (idx >> 9) & 63, g = (idx >> 15) & 1, b = idx >> 16;
    ((u16*)(p.ws + OFF_VtG))[((size_t)(b * 2 + g) * 64 + dv) * NKL + kperm(pk)] = f2bf(p.cache_gv[((size_t)(b * 2 + l) * 512 + pk) * 128 + g * 64 + dv]);
  }
  for (int idx = gt; idx < 8 * 4 * 64 * 512; idx += nt) {
    const int pk = idx & 511, dv = (idx >> 9) & 63, h = (idx >> 15) & 3, b = idx >> 17;
    ((u16*)(p.ws + OFF_VtD))[((size_t)(b * 4 + h) * 64 + dv) * NKL + kperm(pk)] = f2bf(p.cache_dv[((size_t)(b * 2 + l) * 512 + pk) * 256 + h * 64 + dv]);
  }
}

#define NLOC(a, r) ((a) * 32 + 8 * ((r) >> 2) + 4 * hf + ((r) & 3))

template <int NB>
DI void a1_epilogue(CPar& p, int l, int nbase, int m0w, f32x16 (&acc)[2][NB], unsigned char* smem) {
  const int lane = otid() & 63, l31 = lane & 31, hf = lane >> 5;
  u16* stg = (u16*)smem + (otid() >> 6) * (32 * 68);
  _Pragma("unroll") for (int b = 0; b < NB; ++b) {
    const int m = m0w + b * 32 + l31;
    const bool ctx = m < MC;
    int bb, t;
    if (ctx) { bb = m >> 8; t = m & 255; } else { const int ml = m - MC; bb = ml >> 12; t = ml & 4095; }
    float v[2][16];
    _Pragma("unroll") for (int a = 0; a < 2; ++a)
      _Pragma("unroll") for (int r = 0; r < 16; ++r) v[a][r] = acc[a][b][r];

    auto rmsn = [&](const float* gain) {
      float ss = 0.f;
      _Pragma("unroll") for (int a = 0; a < 2; ++a)
        _Pragma("unroll") for (int r = 0; r < 16; ++r) ss += v[a][r] * v[a][r];
      ss = xhalf_sum(ss);
      const float rinv = rsqrtf(ss * (1.f / 64.f) + EPSN);
      _Pragma("unroll") for (int a = 0; a < 2; ++a)
        _Pragma("unroll") for (int i = 0; i < 4; ++i) {
          const float4 g = *(const float4*)(gain + a * 32 + 8 * i + 4 * hf);
          v[a][4 * i + 0] *= rinv * g.x; v[a][4 * i + 1] *= rinv * g.y; v[a][4 * i + 2] *= rinv * g.z; v[a][4 * i + 3] *= rinv * g.w;
        }
    };
    auto rope64 = [&]() {
      const int trow = t >> 6, tcol = t & 63;
      const float2* rp = (const float2*)((float*)(p.ws + OFF_rope));
      _Pragma("unroll") for (int r = 0; r < 16; ++r) {
        const int j = 8 * (r >> 2) + 4 * hf + (r & 3);
        const int pos = ((r >> 2) < 2) ? trow : tcol;
        const float2 cs = rp[pos * 16 + (j & 15)];
        const float x1 = v[0][r], x2 = v[1][r];
        v[0][r] = x1 * cs.x - x2 * cs.y;
        v[1][r] = x1 * cs.y + x2 * cs.x;
      }
    };
    auto rope32 = [&]() {
      const int trow = t >> 6, tcol = t & 63;
      const float2* rp = (const float2*)((float*)(p.ws + OFF_rope));
      _Pragma("unroll") for (int a = 0; a < 2; ++a)
        _Pragma("unroll") for (int r = 0; r < 8; ++r) {
          const int j = 8 * (r >> 2) + 4 * hf + (r & 3);
          const int pos = ((r >> 2) == 0) ? trow : tcol;
          const float2 cs = rp[pos * 16 + 2 * (j & 7)];
          const float x1 = v[a][r], x2 = v[a][r + 8];
          v[a][r] = x1 * cs.x - x2 * cs.y;
          v[a][r + 8] = x1 * cs.y + x2 * cs.x;
        }
    };
    auto store_nat = [&](u16* dst) {
      _Pragma("unroll") for (int a = 0; a < 2; ++a)
        _Pragma("unroll") for (int i = 0; i < 4; ++i)
          *(uint2*)(stg + l31 * 68 + a * 32 + 8 * i + 4 * hf) = make_uint2(pack2(v[a][4 * i], v[a][4 * i + 1]), pack2(v[a][4 * i + 2], v[a][4 * i + 3]));
      const unsigned long long dp = (unsigned long long)dst;
      _Pragma("unroll") for (int j = 0; j < 8; ++j) {
        const int row = (lane >> 4) + 4 * j;
        const unsigned lo = __shfl((unsigned)dp, row), hi = __shfl((unsigned)(dp >> 32), row);
        u16* rp = (u16*)(((unsigned long long)hi << 32) | lo);
        const uint2 val = *(const uint2*)(stg + row * 68 + (lane & 15) * 4);
        *(uint2*)(rp + (lane & 15) * 4) = val;
      }
    };
    auto store_f32 = [&](float* dst) {
      _Pragma("unroll") for (int a = 0; a < 2; ++a)
        _Pragma("unroll") for (int i = 0; i < 4; ++i)
          *(float4*)(dst + a * 32 + 8 * i + 4 * hf) = make_float4(v[a][4 * i], v[a][4 * i + 1], v[a][4 * i + 2], v[a][4 * i + 3]);
    };
    auto store_T = [&](u16* dst, int ld) {
      _Pragma("unroll") for (int a = 0; a < 2; ++a)
        _Pragma("unroll") for (int r = 0; r < 16; ++r) dst[(size_t)NLOC(a, r) * ld] = f2bf(v[a][r]);
    };

    u16* zrow = ((u16*)(p.ws + OFF_Z)) + (size_t)m * INW + nbase;
    if (nbase < 1024) {
      store_nat(zrow);
    } else if (nbase < 1280) {
      rmsn(p.q_gain + l * 64);
      if (!ctx) rope64();
      store_nat(zrow);
    } else if (nbase < 1408) {
      const int kvh = (nbase - 1280) >> 6;
      rmsn(p.k_gain + l * 64);
      if (ctx) {
        store_f32(p.out + OUT_GK + ((size_t)(bb * 2 + l) * 256 + t) * 128 + kvh * 64);
        store_nat(zrow);
      } else {
        rope64();
        store_nat(((u16*)(p.ws + OFF_KG)) + ((size_t)bb * NKL + 512 + t) * 128 + kvh * 64);
      }
    } else if (nbase < 1536) {
      const int kvh = (nbase - 1408) >> 6;
      if (ctx) {
        store_f32(p.out + OUT_GV + ((size_t)(bb * 2 + l) * 256 + t) * 128 + kvh * 64);
        store_T(((u16*)(p.ws + OFF_VtGc)) + ((size_t)(bb * 2 + kvh) * 64) * 256 + kperm(t), 256);
      } else {
        store_T(((u16*)(p.ws + OFF_VtG)) + ((size_t)(bb * 2 + kvh) * 64) * NKL + 512 + kperm(t), NKL);
      }
    } else if (nbase < 2048) {
      store_nat(zrow);
    } else if (nbase < 2304) {
      const int hh = (nbase - 2048) >> 6;
      _Pragma("unroll") for (int a = 0; a < 2; ++a)
        _Pragma("unroll") for (int r = 0; r < 16; ++r) v[a][r] *= 0.125f;
      store_nat(zrow);
      if (ctx) store_T(((u16*)(p.ws + OFF_KtRc)) + ((size_t)(bb * 4 + hh) * 64) * 256 + kperm(t), 256);
      else store_T(((u16*)(p.ws + OFF_KtRl)) + ((size_t)(bb * 4 + hh) * 64) * 4096 + kperm(t), 4096);
    } else if (nbase < 2560) {
      const int hh = (nbase - 2304) >> 6;
      store_nat(zrow);
      if (ctx) store_T(((u16*)(p.ws + OFF_VtRc)) + ((size_t)(bb * 4 + hh) * 64) * 256 + kperm(t), 256);
      else store_T(((u16*)(p.ws + OFF_VtRl)) + ((size_t)(bb * 4 + hh) * 64) * 4096 + kperm(t), 4096);
    } else if (nbase < 2816) {
      store_nat(zrow);
    } else if (nbase < 3072) {
      if (!ctx) rope32();
      store_nat(zrow);
    } else if (nbase < 3328) {
      const int cb = nbase - 3072;
      if (ctx) {
        store_f32(p.out + OUT_DK + ((size_t)(bb * 2 + l) * 256 + t) * 256 + cb);
        store_nat(zrow);
      } else {
        rope32();
        store_nat(((u16*)(p.ws + OFF_KD)) + ((size_t)bb * NKL + 512 + t) * 256 + cb);
      }
    } else if (nbase < 3584) {
      const int cb = nbase - 3328, hh = cb >> 6;
      if (ctx) {
        store_f32(p.out + OUT_DV + ((size_t)(bb * 2 + l) * 256 + t) * 256 + cb);
        store_T(((u16*)(p.ws + OFF_VtDc)) + ((size_t)(bb * 4 + hh) * 64) * 256 + kperm(t), 256);
      } else {
        store_T(((u16*)(p.ws + OFF_VtD)) + ((size_t)(bb * 4 + hh) * 64) * NKL + 512 + kperm(t), NKL);
      }
    } else {
      store_nat(zrow);
    }
  }
}

DI void phaseA1(CPar& p, int l, unsigned char* smem) {
  const int w = otid() >> 6, wn = w >> 1, wt = w & 1;
  for (int tile = vblock(); tile < 30 * 160; tile += gridDim.x) {
    const int grp = tile / 800, rem = tile - grp * 800;
    const int tm = rem / 5, tn = grp * 5 + (rem - tm * 5);
    f32x16 acc[2][4];
    _Pragma("unroll") for (int a = 0; a < 2; ++a)
      _Pragma("unroll") for (int b = 0; b < 4; ++b) acc[a][b] = zero16();
    gemm_acc<4>(((u16*)(p.ws + OFF_WinT)) + (size_t)l * 3840 * 1024 + ((size_t)(tn * 32) << 12), ((u16*)(p.ws + OFF_H)) + ((size_t)(tm * 2 * 32) << 12), 32 * 4096, 32, acc, (u16*)smem);
    a1_epilogue<4>(p, l, tn * 128 + wn * 64, tm * 256 + wt * 128, acc, smem);
    __syncthreads();
  }
}

DI void ld8(const u16* ptr, float (&f)[8]) {
  const uint4 v = *(const uint4*)ptr;
  f[0] = bflo(v.x); f[1] = bfhi(v.x); f[2] = bflo(v.y); f[3] = bfhi(v.y);
  f[4] = bflo(v.z); f[5] = bfhi(v.z); f[6] = bflo(v.w); f[7] = bfhi(v.w);
}

DI void conv_item(CPar& p, int l, int item) {
  const int gt = item * 256 + otid(), nt = MT * 32;
  const float* cw = p.conv_w + l * 768;
  for (int idx = gt; idx < MT * 32; idx += nt) {
    const int m = idx >> 5, c8 = (idx & 31) * 8;
    int t, T;
    if (m < MC) { t = m & 255; T = 256; } else { t = (m - MC) & 4095; T = 4096; }
    const u16* zr = ((u16*)(p.ws + OFF_Z)) + (size_t)m * INW + c8;
    float bg[8], gt8[8], cgc[8], uc[8], gp[8], gn[8];
    ld8(zr, bg); ld8(zr + 768, gt8); ld8(zr + 256, cgc); ld8(zr + 512, uc);
    if (t > 0) { float a[8], b[8]; ld8(zr - INW + 256, a); ld8(zr - INW + 512, b); _Pragma("unroll") for (int i = 0; i < 8; ++i) gp[i] = a[i] * b[i]; }
    else { _Pragma("unroll") for (int i = 0; i < 8; ++i) gp[i] = 0.f; }
    if (t < T - 1) { float a[8], b[8]; ld8(zr + INW + 256, a); ld8(zr + INW + 512, b); _Pragma("unroll") for (int i = 0; i < 8; ++i) gn[i] = a[i] * b[i]; }
    else { _Pragma("unroll") for (int i = 0; i < 8; ++i) gn[i] = 0.f; }
    float y[8];
    _Pragma("unroll") for (int i = 0; i < 8; ++i) {
      const float w0 = cw[c8 + i], w1 = cw[256 + c8 + i], w2 = cw[512 + c8 + i];
      const float g = cgc[i] * uc[i];
      y[i] = bg[i] * (w0 * gp[i] + w1 * g + w2 * gn[i]) * silu_f(gt8[i]);
    }
    *(uint4*)(((u16*)(p.ws + OFF_Y)) + tix(m, c8, 32)) = make_uint4(pack2(y[0], y[1]), pack2(y[2], y[3]), pack2(y[4], y[5]), pack2(y[6], y[7]));
  }
}

DI float log_gamma(CPar& p, int l, int dir, int h) {
  const float x = p.ret_decay[(l * 2 + dir) * 4 + h];
  return -log1pf(expf(-x));
}

DI void ret_decode(int item, bool& ctx, int& bb, int& h, int& c, int& m0) {
  if (item < 256) { ctx = true; c = item & 1; h = (item >> 1) & 3; bb = item >> 3; m0 = bb * 256 + c * 128; }
  else { const int it = item - 256; ctx = false; c = it & 31; h = (it >> 5) & 3; bb = it >> 7; m0 = MC + bb * 4096 + c * 128; }
}

DI void r1_items(CPar& p, int l, unsigned char* smem) {
  const int tid = otid(), lane = tid & 63, w = tid >> 6, l31 = lane & 31, hf = lane >> 5;
  const int ti = w >> 1, tj = w & 1;
  const float LOG2E = 1.4426950408889634f;
  for (int item = blockIdx.x; item < 1280; item += gridDim.x) {
    bool ctx; int bb, h, c, m0;
    ret_decode(item, ctx, bb, h, c, m0);
    const float lf2 = log_gamma(p, l, 0, h) * LOG2E, lb2 = log_gamma(p, l, 1, h) * LOG2E;
    const int ld = ctx ? 256 : 4096;
    const size_t hb = ctx ? ((size_t)(bb * 4 + h) * 64) * 256 + c * 128 : ((size_t)(bb * 4 + h) * 64) * 4096 + c * 128;
    const u16* Kt = (ctx ? (const u16*)(p.ws + OFF_KtRc) : (const u16*)(p.ws + OFF_KtRl)) + hb + (size_t)(ti * 32 + l31) * ld + 8 * hf;
    const u16* Vt = (ctx ? (const u16*)(p.ws + OFF_VtRc) : (const u16*)(p.ws + OFF_VtRl)) + hb + (size_t)(tj * 32 + l31) * ld + 8 * hf;
    f32x16 Uf = zero16(), Ub = zero16();
    _Pragma("unroll") for (int s8 = 0; s8 < 8; ++s8) {
      const bf16x8 af = *(const bf16x8*)(Kt + 16 * s8);
      const u32x4 bv = *(const u32x4*)(Vt + 16 * s8);
      u32x4 bfw, bbw;
      _Pragma("unroll") for (int q = 0; q < 4; ++q) {
        const int j0 = 16 * s8 + 8 * ((2 * q) >> 2) + 4 * hf + ((2 * q) & 3);
        const float v0 = bflo(bv[q]), v1 = bfhi(bv[q]);
        const float wf0 = __builtin_amdgcn_exp2f(lf2 * (float)(127 - j0)), wf1 = __builtin_amdgcn_exp2f(lf2 * (float)(126 - j0));
        const float wb0 = __builtin_amdgcn_exp2f(lb2 * (float)j0), wb1 = __builtin_amdgcn_exp2f(lb2 * (float)(j0 + 1));
        bfw[q] = pack2(v0 * wf0, v1 * wf1);
        bbw[q] = pack2(v0 * wb0, v1 * wb1);
      }
      Uf = MFMA32(af, __builtin_bit_cast(bf16x8, bfw), Uf);
      Ub = MFMA32(af, __builtin_bit_cast(bf16x8, bbw), Ub);
    }
    float* uo = ((float*)(p.ws + OFF_U)) + (size_t)item * 2 * 4096 + tj * 32 + l31;
    _Pragma("unroll") for (int r = 0; r < 16; ++r) {
      const int dk = ti * 32 + 8 * (r >> 2) + 4 * hf + (r & 3);
      uo[dk * 64] = Uf[r];
      uo[4096 + dk * 64] = Ub[r];
    }
  }
}

template <bool CTX>
DI void r2_item(CPar& p, int l, int bi) {
  const int tid = otid();
  const int eb = bi & 15, dir = (bi >> 4) & 1, h = (bi >> 5) & 3, bb = bi >> 7;
  const int ep = eb * 256 + tid;
  const int dv = ep >> 6, dk = ep & 63;
  const int e = dk * 64 + dv;
  constexpr int nch = CTX ? 2 : 32;
  const int base = CTX ? (bb * 4 + h) * 2 : 256 + (bb * 4 + h) * 32;
  const float gC = expf(log_gamma(p, l, dir, h) * 128.f);
  float S = CTX ? 0.f : p.state_ret[((((size_t)bb * 2 + l) * 2 + dir) * 4 + h) * 4096 + e];
  float u[nch];
  _Pragma("unroll") for (int i = 0; i < nch; ++i) {
    const int c = dir ? (nch - 1 - i) : i;
    u[i] = ((float*)(p.ws + OFF_U))[((size_t)(base + c) * 2 + dir) * 4096 + e];
  }
  _Pragma("unroll") for (int i = 0; i < nch; ++i) {
    const int c = dir ? (nch - 1 - i) : i;
    ((u16*)(p.ws + OFF_SinT))[((size_t)(base + c) * 2 + dir) * 4096 + ep] = f2bf(S);
    S = S * gC + u[i];
  }
  if (CTX) p.out[OUT_ST + ((((size_t)bb * 2 + l) * 2 + dir) * 4 + h) * 4096 + e] = S;
}

template <bool DIFF>
DI void attn_item(CPar& p, int l, bool ctx, int bb, int unit, int qb, unsigned char* smem) {
  const int tid = otid(), lane = tid & 63, w = tid >> 6, l31 = lane & 31, hf = lane >> 5;
  const int qi = w & 1, qs = w >> 1;
  const int mq = (ctx ? bb * 256 : MC + bb * 4096) + qb * 64 + qs * 32 + l31;
  const int nkeys = ctx ? 256 : NKL;
  const u16* Kp; const u16* Vt; int ldk, ldv;
  if (!DIFF) {
    if (ctx) { Kp = ((u16*)(p.ws + OFF_Z)) + (size_t)(bb * 256) * INW + 1280 + unit * 64; ldk = INW; Vt = ((u16*)(p.ws + OFF_VtGc)) + ((size_t)(bb * 2 + unit) * 64) * 256; ldv = 256; }
    else { Kp = ((u16*)(p.ws + OFF_KG)) + (size_t)bb * NKL * 128 + unit * 64; ldk = 128; Vt = ((u16*)(p.ws + OFF_VtG)) + ((size_t)(bb * 2 + unit) * 64) * NKL; ldv = NKL; }
  } else {
    if (ctx) { Kp = ((u16*)(p.ws + OFF_Z)) + (size_t)(bb * 256) * INW + 3072 + unit * 64; ldk = INW; Vt = ((u16*)(p.ws + OFF_VtDc)) + ((size_t)(bb * 4 + unit) * 64) * 256; ldv = 256; }
    else { Kp = ((u16*)(p.ws + OFF_KD)) + (size_t)bb * NKL * 256 + unit * 64; ldk = 256; Vt = ((u16*)(p.ws + OFF_VtD)) + ((size_t)(bb * 4 + unit) * 64) * NKL; ldv = NKL; }
  }
  constexpr int NS = DIFF ? 2 : 4;
  bf16x8 qf[NS];
  {
    const u16* zq = ((u16*)(p.ws + OFF_Z)) + (size_t)mq * INW + (DIFF ? 2816 + unit * 64 + qi * 32 : 1024 + (unit * 2 + qi) * 64) + hf * 8;
    _Pragma("unroll") for (int s = 0; s < NS; ++s) qf[s] = *(const bf16x8*)(zq + s * 16);
  }
  const float sc = (DIFF ? 0.17677669529663687f : 0.125f) * 1.4426950408889634f;
  f32x16 O[2];
  O[0] = zero16(); O[1] = zero16();
  float mref = -1e30f, lsum = 0.f;

  char* smb = (char*)smem;
  constexpr int STGB = 16384;
  const int lr = tid >> 3, gch = (tid & 7) ^ ((lr >> 1) & 7);
  const u16* gk = Kp + (size_t)lr * ldk + gch * 8;
  const u16* gv = Vt + (size_t)lr * ldv + gch * 8;
  const int wv = __builtin_amdgcn_readfirstlane(w);
  char* smw = smb + wv * 1024;
  const u16* pk0 = gk; const u16* pk1 = gk + (size_t)32 * ldk;
  const u16* pv0 = gv; const u16* pv1 = gv + (size_t)32 * ldv;
  const size_t kstep = (size_t)64 * ldk;
#define ATT_STAGE(ST) do { \
    __builtin_amdgcn_global_load_lds((const unsigned*)pk0, (unsigned*)(smw + (ST) * STGB), 16, 0, 0); pk0 += kstep; \
    __builtin_amdgcn_global_load_lds((const unsigned*)pk1, (unsigned*)(smw + (ST) * STGB + 4096), 16, 0, 0); pk1 += kstep; \
    __builtin_amdgcn_global_load_lds((const unsigned*)pv0, (unsigned*)(smw + (ST) * STGB + 8192), 16, 0, 0); pv0 += 64; \
    __builtin_amdgcn_global_load_lds((const unsigned*)pv1, (unsigned*)(smw + (ST) * STGB + 8192 + 4096), 16, 0, 0); pv1 += 64; \
  } while (0)
  const int nt = nkeys >> 6;
  __syncthreads();
  VMWAIT(0);
  ATT_STAGE(0); ATT_STAGE(1);
  const int sw = (l31 >> 1) & 7;
  const int kq0 = DIFF ? qi * 4 : 0;
  const f32x16 zc = {0.f, 0.f, 0.f, 0.f, 0.f, 0.f, 0.f, 0.f, 0.f, 0.f, 0.f, 0.f, 0.f, 0.f, 0.f, 0.f};
  auto softmax_pv = [&](f32x16 (&S)[2], const char* sV) {
    bf16x8 vfr[2][4];
    _Pragma("unroll") for (int a = 0; a < 2; ++a)
      _Pragma("unroll") for (int s2 = 0; s2 < 4; ++s2)
        vfr[a][s2] = *(const bf16x8*)(sV + (a * 32 + l31) * 128 + (((2 * s2 + hf) ^ sw) << 4));
    float mx = S[0][0];
    _Pragma("unroll") for (int k2 = 0; k2 < 2; ++k2)
      _Pragma("unroll") for (int r = 0; r < 16; ++r) mx = fmaxf(mx, S[k2][r]);
    mx = xhalf_max(mx);
    const float mxs = mx * sc;
    if (__builtin_amdgcn_ballot_w64(mxs > mref + 8.f) != 0ull) {
      const float mnew = (mxs > mref + 8.f) ? mxs : mref;
      const float alpha = __builtin_amdgcn_exp2f(mref - mnew);
      mref = mnew;
      lsum *= alpha;
      _Pragma("unroll") for (int a = 0; a < 2; ++a)
        _Pragma("unroll") for (int r = 0; r < 16; ++r) O[a][r] *= alpha;
    }
    const f32x2 sc2 = {sc, sc}, nm2 = {-mref, -mref};
    f32x2 ps2 = {0.f, 0.f};
    bf16x8 pf[4];
    _Pragma("unroll") for (int k2 = 0; k2 < 2; ++k2)
      _Pragma("unroll") for (int u = 0; u < 2; ++u) {
        u32x4 pk;
        _Pragma("unroll") for (int j = 0; j < 4; ++j) {
          f32x2 v = {S[k2][8 * u + 2 * j], S[k2][8 * u + 2 * j + 1]};
          v = v * sc2 + nm2;
          f32x2 e;
          e.x = __builtin_amdgcn_exp2f(v.x);
          e.y = __builtin_amdgcn_exp2f(v.y);
          ps2 += e;
          pk[j] = pack2(e.x, e.y);
        }
        pf[2 * k2 + u] = __builtin_bit_cast(bf16x8, pk);
      }
    lsum += ps2.x + ps2.y;
    _Pragma("unroll") for (int a = 0; a < 2; ++a)
      _Pragma("unroll") for (int s2 = 0; s2 < 4; ++s2) O[a] = MFMA32(vfr[a][s2], pf[s2], O[a]);
  };
  for (int kt2 = 0; kt2 < nt; kt2 += 2) {
    VMWAIT(0);
    RAW_BARRIER();
    if (kt2 + 2 < nt) { ATT_STAGE((kt2 + 2) & 3); ATT_STAGE((kt2 + 3) & 3); }
    __builtin_amdgcn_sched_barrier(0);
    const char* sK0 = smb + (kt2 & 3) * STGB;
    const char* sK1 = smb + ((kt2 + 1) & 3) * STGB;
    f32x16 S0[2], S1[2];
    {
      bf16x8 kfa[NS][2], kfb[NS][2];
      _Pragma("unroll") for (int s = 0; s < NS; ++s)
        _Pragma("unroll") for (int k2 = 0; k2 < 2; ++k2)
          kfa[s][k2] = *(const bf16x8*)(sK0 + (k2 * 32 + l31) * 128 + (((kq0 + 2 * s + hf) ^ sw) << 4));
      _Pragma("unroll") for (int s = 0; s < NS; ++s)
        _Pragma("unroll") for (int k2 = 0; k2 < 2; ++k2)
          kfb[s][k2] = *(const bf16x8*)(sK1 + (k2 * 32 + l31) * 128 + (((kq0 + 2 * s + hf) ^ sw) << 4));
      __builtin_amdgcn_sched_barrier(0);
      _Pragma("unroll") for (int s = 0; s < NS; ++s)
        _Pragma("unroll") for (int k2 = 0; k2 < 2; ++k2)
          S0[k2] = MFMA32(kfa[s][k2], qf[s], s == 0 ? zc : S0[k2]);
      _Pragma("unroll") for (int s = 0; s < NS; ++s)
        _Pragma("unroll") for (int k2 = 0; k2 < 2; ++k2)
          S1[k2] = MFMA32(kfb[s][k2], qf[s], s == 0 ? zc : S1[k2]);
    }
    softmax_pv(S0, sK0 + 8192);
    softmax_pv(S1, sK1 + 8192);
  }
  RAW_BARRIER();
#undef ATT_STAGE
  const float inv = __builtin_amdgcn_rcpf(xhalf_sum(lsum));
  const u16* zg = ((u16*)(p.ws + OFF_Z)) + (size_t)mq * INW;
  if (!DIFF) {
    _Pragma("unroll") for (int a = 0; a < 2; ++a)
      _Pragma("unroll") for (int i = 0; i < 4; ++i) {
        const int col = (unit * 2 + qi) * 64 + a * 32 + 8 * i + 4 * hf;
        const uint2 gv2 = *(const uint2*)(zg + 1536 + col);
        const float y0 = O[a][4 * i + 0] * inv * silu_f(bflo(gv2.x));
        const float y1 = O[a][4 * i + 1] * inv * silu_f(bfhi(gv2.x));
        const float y2 = O[a][4 * i + 2] * inv * silu_f(bflo(gv2.y));
        const float y3 = O[a][4 * i + 3] * inv * silu_f(bfhi(gv2.y));
        *(uint2*)(((u16*)(p.ws + OFF_Y)) + tix(mq, 256 + col, 32)) = make_uint2(pack2(y0, y1), pack2(y2, y3));
      }
  } else {
    float* xb = (float*)smem + qs * 32 * 64;
    if (qi == 1) {
      _Pragma("unroll") for (int a = 0; a < 2; ++a)
        _Pragma("unroll") for (int r = 0; r < 16; ++r) xb[(a * 16 + r) * 64 + lane] = O[a][r] * inv;
    }
    __syncthreads();
    if (qi == 0) {
      const float* lp = p.diff_lambda + l * 128;
      float d1 = 0.f, d2 = 0.f;
      for (int i = 0; i < 32; ++i) { d1 += lp[i] * lp[32 + i]; d2 += lp[64 + i] * lp[96 + i]; }
      const float lam_init = 0.8f - 0.6f * expf(-0.3f * (float)l);
      const float lam = expf(d1) - expf(d2) + lam_init;
      float ss = 0.f;
      _Pragma("unroll") for (int a = 0; a < 2; ++a)
        _Pragma("unroll") for (int r = 0; r < 16; ++r) {
          const float o = O[a][r] * inv - lam * xb[(a * 16 + r) * 64 + lane];
          O[a][r] = o;
          ss += o * o;
        }
      ss = xhalf_sum(ss);
      const float rinv = rsqrtf(ss * (1.f / 64.f) + EPSN) * (1.f - lam_init);
      const float* gn = p.diff_gain + l * 64;
      _Pragma("unroll") for (int a = 0; a < 2; ++a)
        _Pragma("unroll") for (int i = 0; i < 4; ++i) {
          const int nl = a * 32 + 8 * i + 4 * hf;
          const int col = unit * 64 + nl;
          const uint2 gv2 = *(const uint2*)(zg + 3584 + col);
          const float4 g4 = *(const float4*)(gn + nl);
          const float y0 = O[a][4 * i + 0] * rinv * g4.x * silu_f(bflo(gv2.x));
          const float y1 = O[a][4 * i + 1] * rinv * g4.y * silu_f(bfhi(gv2.x));
          const float y2 = O[a][4 * i + 2] * rinv * g4.z * silu_f(bflo(gv2.y));
          const float y3 = O[a][4 * i + 3] * rinv * g4.w * silu_f(bfhi(gv2.y));
          *(uint2*)(((u16*)(p.ws + OFF_Y)) + tix(mq, 768 + col, 32)) = make_uint2(pack2(y0, y1), pack2(y2, y3));
        }
    }
  }
}

DI void r3_item(CPar& p, int l, int item, unsigned char* smem) {
  const int tid = otid(), lane = tid & 63, w = tid >> 6, l31 = lane & 31, hf = lane >> 5;
  bool ctx; int bb, h, c, m0;
  ret_decode(item, ctx, bb, h, c, m0);
  const int iq = w * 32 + l31;
  const int mq = m0 + iq;
  const float LOG2E = 1.4426950408889634f;
  const float lf2 = log_gamma(p, l, 0, h) * LOG2E, lb2 = log_gamma(p, l, 1, h) * LOG2E;
  u16* sK = (u16*)smem;
  u16* sV = sK + 128 * LSTR;
  constexpr int VSTR = 136;
  const u16* Vt = ctx ? ((u16*)(p.ws + OFF_VtRc)) + ((size_t)(bb * 4 + h) * 64) * 256 + c * 128 : ((u16*)(p.ws + OFF_VtRl)) + ((size_t)(bb * 4 + h) * 64) * 4096 + c * 128;
  const int ldv = ctx ? 256 : 4096;
  __syncthreads();
  _Pragma("unroll") for (int i = 0; i < 4; ++i) {
    const int cidx = tid + 256 * i;
    { const int row = cidx >> 3, kc = cidx & 7;
      *(uint4*)(sK + row * LSTR + kc * 8) = *(const uint4*)(((u16*)(p.ws + OFF_Z)) + (size_t)(m0 + row) * INW + 2048 + h * 64 + kc * 8); }
    { const int dv = cidx >> 4, kc = cidx & 15;
      *(uint4*)(sV + dv * VSTR + kc * 8) = *(const uint4*)(Vt + (size_t)dv * ldv + kc * 8); }
  }
  bf16x8 qf[4];
  {
    const u16* zq = ((u16*)(p.ws + OFF_Z)) + (size_t)mq * INW + 1792 + h * 64 + hf * 8;
    _Pragma("unroll") for (int s = 0; s < 4; ++s) qf[s] = *(const bf16x8*)(zq + s * 16);
  }
  __syncthreads();
  f32x16 O[2];
  O[0] = zero16(); O[1] = zero16();
  _Pragma("unroll 1") for (int kt = 0; kt < 2; ++kt) {
    f32x16 S[2];
    S[0] = zero16(); S[1] = zero16();
    _Pragma("unroll") for (int s = 0; s < 4; ++s)
      _Pragma("unroll") for (int k2 = 0; k2 < 2; ++k2) {
        const bf16x8 kf = *(const bf16x8*)(sK + (kt * 64 + k2 * 32 + l31) * LSTR + s * 16 + hf * 8);
        S[k2] = MFMA32(kf, qf[s], S[k2]);
      }
    bf16x8 pf[4];
    _Pragma("unroll") for (int k2 = 0; k2 < 2; ++k2) {
      _Pragma("unroll") for (int r = 0; r < 16; ++r) {
        const int jk = kt * 64 + k2 * 32 + 8 * (r >> 2) + 4 * hf + (r & 3);
        const int d = iq - jk;
        float wgt;
        if (d > 0) wgt = __builtin_amdgcn_exp2f(lf2 * (float)d);
        else if (d < 0) wgt = __builtin_amdgcn_exp2f(lb2 * (float)(-d));
        else wgt = 2.f;
        S[k2][r] *= wgt;
      }
      _Pragma("unroll") for (int u = 0; u < 2; ++u) {
        u32x4 pk;
        pk[0] = pack2(S[k2][8 * u + 0], S[k2][8 * u + 1]);
        pk[1] = pack2(S[k2][8 * u + 2], S[k2][8 * u + 3]);
        pk[2] = pack2(S[k2][8 * u + 4], S[k2][8 * u + 5]);
        pk[3] = pack2(S[k2][8 * u + 6], S[k2][8 * u + 7]);
        pf[2 * k2 + u] = __builtin_bit_cast(bf16x8, pk);
      }
    }
    _Pragma("unroll") for (int a = 0; a < 2; ++a)
      _Pragma("unroll") for (int s2 = 0; s2 < 4; ++s2) {
        const bf16x8 vf = *(const bf16x8*)(sV + (a * 32 + l31) * VSTR + kt * 64 + 16 * s2 + 8 * hf);
        O[a] = MFMA32(vf, pf[s2], O[a]);
      }
  }
  _Pragma("unroll") for (int dir = 0; dir < 2; ++dir) {
    const u16* st = ((u16*)(p.ws + OFF_SinT)) + ((size_t)item * 2 + dir) * 4096;
    const float dq = dir == 0 ? __builtin_amdgcn_exp2f(lf2 * (float)(iq + 1)) : __builtin_amdgcn_exp2f(lb2 * (float)(128 - iq));
    _Pragma("unroll") for (int a = 0; a < 2; ++a) {
      f32x16 X = zero16();
      _Pragma("unroll") for (int s = 0; s < 4; ++s) {
        const bf16x8 sf = *(const bf16x8*)(st + (a * 32 + l31) * 64 + s * 16 + hf * 8);
        X = MFMA32(sf, qf[s], X);
      }
      _Pragma("unroll") for (int r = 0; r < 16; ++r) O[a][r] += X[r] * dq;
    }
  }
  float ss = 0.f;
  _Pragma("unroll") for (int a = 0; a < 2; ++a)
    _Pragma("unroll") for (int r = 0; r < 16; ++r) ss += O[a][r] * O[a][r];
  ss = xhalf_sum(ss);
  const float rinv = rsqrtf(ss * (1.f / 64.f) + EPSN);
  const u16* zg = ((u16*)(p.ws + OFF_Z)) + (size_t)mq * INW + 2560 + h * 64;
  _Pragma("unroll") for (int a = 0; a < 2; ++a)
    _Pragma("unroll") for (int i = 0; i < 4; ++i) {
      const int nl = a * 32 + 8 * i + 4 * hf;
      const uint2 gv2 = *(const uint2*)(zg + nl);
      const float y0 = O[a][4 * i + 0] * rinv * silu_f(bflo(gv2.x));
      const float y1 = O[a][4 * i + 1] * rinv * silu_f(bfhi(gv2.x));
      const float y2 = O[a][4 * i + 2] * rinv * silu_f(bflo(gv2.y));
      const float y3 = O[a][4 * i + 3] * rinv * silu_f(bfhi(gv2.y));
      *(uint2*)(((u16*)(p.ws + OFF_Y)) + tix(mq, 512 + h * 64 + nl, 32)) = make_uint2(pack2(y0, y1), pack2(y2, y3));
    }
}

DI void phaseC(CPar& p, int l, unsigned char* smem) {
  const int lane = otid() & 63, w = otid() >> 6, wn = w >> 1, wt = w & 1, l31 = lane & 31, hf = lane >> 5;
  u16* Mg = ((u16*)(p.ws + OFF_Z));
  for (int tile = vblock(); tile < 8 * 320; tile += gridDim.x) {
    const int grp = tile / 640, rem = tile - grp * 640;
    const int tm = rem >> 1, tn = grp * 2 + (rem & 1);
    unsigned mgp[2][2][8];
    _Pragma("unroll") for (int a = 0; a < 2; ++a)
      _Pragma("unroll") for (int b = 0; b < 2; ++b)
        _Pragma("unroll") for (int r = 0; r < 8; ++r) mgp[a][b][r] = 0u;
    const u16* Ht = ((u16*)(p.ws + OFF_H)) + ((size_t)(tm * 32) << 12);
    _Pragma("unroll 1") for (int pr = 0; pr < 2; ++pr) {
      unsigned gp[2][4][8];
      {
        f32x16 acc[2][4];
        _Pragma("unroll") for (int a = 0; a < 2; ++a)
          _Pragma("unroll") for (int b = 0; b < 4; ++b) acc[a][b] = zero16();
        gemm_acc<4, true, true>(Ht, ((u16*)(p.ws + OFF_WgT)) + (size_t)l * 4096 * 1024 + ((size_t)((pr * 16 + tn) * 32) << 12), 8 * 32 * 4096, 32, acc, (u16*)smem);
        _Pragma("unroll") for (int a = 0; a < 2; ++a)
          _Pragma("unroll") for (int b = 0; b < 4; ++b)
            _Pragma("unroll") for (int r = 0; r < 8; ++r) gp[a][b][r] = pack2(sigmoid_f(acc[a][b][2 * r]), sigmoid_f(acc[a][b][2 * r + 1]));
      }
      _Pragma("unroll") for (int bh = 0; bh < 2; ++bh) {
        const int br = pr * 2 + bh;
        f32x16 acc[2][2];
        _Pragma("unroll") for (int a = 0; a < 2; ++a)
          _Pragma("unroll") for (int b = 0; b < 2; ++b) acc[a][b] = zero16();
        gemm_acc<2, false, true>(((u16*)(p.ws + OFF_Y)) + ((size_t)(tm * 32 + br * 8) << 12), ((u16*)(p.ws + OFF_WbT)) + (size_t)l * 1024 * 1024 + ((size_t)(tn * 32 + br * 8) << 12), 0, 8, acc, (u16*)smem);
        _Pragma("unroll") for (int a = 0; a < 2; ++a)
          _Pragma("unroll") for (int b = 0; b < 2; ++b)
            _Pragma("unroll") for (int r = 0; r < 8; ++r)
              mgp[a][b][r] = pack2(bflo(mgp[a][b][r]) + bflo(gp[a][bh * 2 + b][r]) * acc[a][b][2 * r], bfhi(mgp[a][b][r]) + bfhi(gp[a][bh * 2 + b][r]) * acc[a][b][2 * r + 1]);
      }
    }
    _Pragma("unroll") for (int a = 0; a < 2; ++a)
      _Pragma("unroll") for (int b = 0; b < 2; ++b) {
        const int n = tn * 128 + wt * 64 + b * 32 + l31;
        _Pragma("unroll") for (int r = 0; r < 8; ++r) {
          const int t0 = tm * 128 + wn * 64 + a * 32 + 8 * ((2 * r) >> 2) + 4 * hf + ((2 * r) & 3);
          Mg[tix(t0, n, 32)] = (u16)(mgp[a][b][r] & 0xffffu);
          Mg[tix(t0 + 1, n, 32)] = (u16)(mgp[a][b][r] >> 16);
        }
      }
  }
}

template <int TB>
DI void d_epilogue(CPar& p, int l, int tm, int nb0, f32x16 (&acc)[2][TB]) {
  const int lane = otid() & 63, w = otid() >> 6, wn = w >> 1, wt = w & 1, l31 = lane & 31, hf = lane >> 5;
  const int m0 = tm * 128 + wn * 64;
  const int j = m0 < MC ? 0 : 1 + ((m0 - MC) >> 12);
  const float* gate = ((float*)(p.ws + OFF_mod)) + (l * 9 + j) * 3072 + 2048;
  const float* xsrc = (l == 0) ? (m0 < MC ? p.x_prompt : p.x_sample - (size_t)MC * 1024) : p.out;
  _Pragma("unroll") for (int b = 0; b < TB; ++b) {
    const int n = (TB == 2) ? nb0 + wt * 64 + b * 32 + l31 : nb0 + (b >> 1) * 128 + wt * 64 + (b & 1) * 32 + l31;
    const float gv = gate[n];
    const size_t o0 = (size_t)(m0 + 4 * hf) * 1024 + n;
    const float* xp = xsrc + o0;
    float* op = p.out + o0;
    _Pragma("unroll") for (int a = 0; a < 2; ++a)
      _Pragma("unroll") for (int i = 0; i < 4; ++i) {
        float xv[4];
        _Pragma("unroll") for (int q = 0; q < 4; ++q) xv[q] = xp[q * 1024];
        _Pragma("unroll") for (int q = 0; q < 4; ++q) op[q * 1024] = xv[q] + gv * acc[a][b][4 * i + q];
        xp += 8 * 1024; op += 8 * 1024;
        asm volatile("" : "+v"(xp), "+v"(op));
      }
  }
}

DI void phaseD(CPar& p, int l, unsigned char* smem) {
  const u16* Mg = ((u16*)(p.ws + OFF_Z));
  const u16* Wo = ((u16*)(p.ws + OFF_WoT)) + (size_t)l * 1024 * 1024;
  for (int tile = vblock(); tile < 1024 + 512; tile += gridDim.x) {
    if (tile < 1024) {
      const int np = tile & 3, tm = tile >> 2;
      f32x16 acc[2][4];
      _Pragma("unroll") for (int a = 0; a < 2; ++a)
        _Pragma("unroll") for (int b = 0; b < 4; ++b) acc[a][b] = zero16();
      gemm_acc<4, true>(Mg + ((size_t)(tm * 32) << 12), Wo + ((size_t)(np * 2 * 32) << 12), 32 * 4096, 32, acc, (u16*)smem);
      d_epilogue<4>(p, l, tm, np * 256, acc);
    } else {
      const int t2 = tile - 1024, big = 1024 + (t2 >> 1), np = big & 3, tm = big >> 2, tn = np * 2 + (t2 & 1);
      f32x16 acc[2][2];
      _Pragma("unroll") for (int a = 0; a < 2; ++a)
        _Pragma("unroll") for (int b = 0; b < 2; ++b) acc[a][b] = zero16();
      gemm_acc<2>(Mg + ((size_t)(tm * 32) << 12), Wo + ((size_t)(tn * 32) << 12), 0, 32, acc, (u16*)smem);
      d_epilogue<2>(p, l, tm, tn * 128, acc);
    }
  }
}

DI void phaseFinal(CPar& p) {
  const int tid = otid(), lane = tid & 63;
  const int gw = blockIdx.x * 4 + (tid >> 6), nw = gridDim.x * 4;
  for (int row = gw; row < MT; row += nw) {
    float* xr = p.out + (size_t)row * 1024;
    float4 v[4];
    float ss = 0.f;
    _Pragma("unroll") for (int i = 0; i < 4; ++i) {
      v[i] = ((const float4*)xr)[lane + 64 * i];
      ss += v[i].x * v[i].x + v[i].y * v[i].y + v[i].z * v[i].z + v[i].w * v[i].w;
    }
    ss = wave_sum(ss);
    const float rstd = rsqrtf(ss * (1.f / 1024.f) + EPSN);
    _Pragma("unroll") for (int i = 0; i < 4; ++i) {
      const float4 g = *(const float4*)(p.final_gain + 4 * (lane + 64 * i));
      ((float4*)xr)[lane + 64 * i] = make_float4(v[i].x * rstd * g.x, v[i].y * rstd * g.y, v[i].z * rstd * g.z, v[i].w * rstd * g.w);
    }
  }
}

__global__ void __launch_bounds__(256, 2) hybrid_megakernel(Params p_unused) {
  cg::grid_group grid = cg::this_grid();
  __shared__ __attribute__((aligned(16))) unsigned char smem[SMEM_BYTES];
  __shared__ uint4 xb_words;
  if (threadIdx.x == 0) xb_words = make_uint4(0u, 0u, 0u, 0u);
  __syncthreads();
  XcdBarrier xb = xcd_barrier_post(((unsigned*)(PP().ws + OFF_bar)), (volatile LAS unsigned*)&xb_words);
  phase0(PP(), smem);
  grid.sync();
  _Pragma("unroll 1") for (int l = 0; l < 2; ++l) {
    phaseA0(PP(), l);
    xcd_barrier(xb);
    phaseA1(PP(), l, smem);
    xcd_barrier(xb);
    r1_items(PP(), l, smem);
    xcd_barrier(xb);
    for (int rep = 0; rep < REP_B2; ++rep)
    for (int it = vblock(); it < 1024 + 1024 + 2048 + 256 + 512 + 4096; it += gridDim.x) {
      if (it < 1024) r2_item<false>(PP(), l, it);
      else if (it < 2048) { const int i = it - 1024; attn_item<false>(PP(), l, false, i >> 7, (i >> 6) & 1, i & 63, smem); }
      else if (it < 4096) { const int i = it - 2048; attn_item<true>(PP(), l, false, i >> 8, (i >> 6) & 3, i & 63, smem); }
      else if (it < 4352) { const int i = it - 4096; attn_item<false>(PP(), l, true, i >> 3, (i >> 2) & 1, i & 3, smem); }
      else if (it < 4864) { const int i = it - 4352; attn_item<true>(PP(), l, true, i >> 4, (i >> 2) & 3, i & 3, smem); }
      else r2_item<true>(PP(), l, it - 4864);
    }
    {
      unsigned* ctr = (unsigned*)(PP().ws + OFF_tctr) + l;
      volatile LAS unsigned* slot = (volatile LAS unsigned*)&xb_words + 2;
      for (;;) {
        __syncthreads();
        if (threadIdx.x == 0) *slot = __hip_atomic_fetch_add(ctr, 1u, __ATOMIC_RELAXED, __HIP_MEMORY_SCOPE_AGENT);
        __syncthreads();
        const int it = (int)*slot;
        if (it >= MT * 32 / 256) break;
        conv_item(PP(), l, it);
      }
    }
    xcd_barrier(xb);
    for (int it = vblock(); it < 1280; it += gridDim.x) r3_item(PP(), l, it, smem);
    xcd_barrier(xb);
    phaseC(PP(), l, smem);
    xcd_barrier(xb);
    phaseD(PP(), l, smem);
    xcd_barrier(xb);
  }
  phaseFinal(PP());
}

extern "C" void kernel_launch(void* const* d_in, const int* in_sizes, int n_in, void* d_out, int out_size, void* d_ws, size_t ws_size,
                              hipStream_t stream) {
  static int grid_blocks = 0;
  if (!grid_blocks) {
    int dev = 0, cus = 0, per_cu = 0;
    (void)hipGetDevice(&dev);
    (void)hipDeviceGetAttribute(&cus, hipDeviceAttributeMultiprocessorCount, dev);
    (void)hipOccupancyMaxActiveBlocksPerMultiprocessor(&per_cu, hybrid_megakernel, 256, 0);
    if (per_cu > 2) per_cu = 2;
    if (per_cu < 1) per_cu = 1;
    grid_blocks = cus * per_cu;
  }
  Params p{};
  const float** fin = (const float**)&p.x_prompt;
  for (int i = 0; i < 23; ++i) fin[i] = (const float*)d_in[i];
  p.out = (float*)d_out;
  p.ws = (unsigned char*)d_ws;
  const size_t off = WS_NEED;
  if (off > ws_size) { fprintf(stderr, "workspace too small: need %zu have %zu\n", off, ws_size); return; }
  (void)hipMemsetAsync(p.ws + OFF_bar, 0, XCD_BAR_WORDS * 4, stream);
  (void)hipMemsetAsync(p.ws + OFF_tctr, 0, 256, stream);
  void* args[] = {&p};
  hipError_t e = hipLaunchCooperativeKernel((void*)hybrid_megakernel, dim3(grid_blocks), dim3(256), args, 0, stream);
  if (e != hipSuccess) fprintf(stderr, "cooperative launch failed: %s (grid %d)\n", hipGetErrorString(e), grid_blocks);
}
```

```cpp
#include <hip/hip_runtime.h>
#include <hip/hip_bf16.h>
#include <hip/hip_cooperative_groups.h>
#include <cstdio>
namespace cg = cooperative_groups;

typedef unsigned short u16;
using bf16x8 = __attribute__((ext_vector_type(8))) short;
using f32x16 = __attribute__((ext_vector_type(16))) float;
using u32x4 = __attribute__((ext_vector_type(4))) unsigned;
using u32x2 = __attribute__((ext_vector_type(2))) unsigned;

#define DI __device__ __forceinline__
#define MFMA32(a, b, c) __builtin_amdgcn_mfma_f32_32x32x16_bf16((a), (b), (c), 0, 0, 0)

#ifndef REP_A1
#define REP_A1 1
#endif
#ifndef REP_B2
#define REP_B2 1
#endif
#ifndef PIPE_C
#define PIPE_C true
#endif
constexpr int DM = 1024;
constexpr int INW = 3840;
constexpr int MC = 8192;
constexpr int MT = 40960;
constexpr int NKL = 4608;
constexpr int LSTR = 72;
constexpr float EPSN = 1e-6f;
constexpr int SMEM_BYTES = 2 * 2 * 128 * LSTR * 2;

constexpr size_t OUT_GK = 41943040ull;
constexpr size_t OUT_GV = 44040192ull;
constexpr size_t OUT_DK = 46137344ull;
constexpr size_t OUT_DV = 50331648ull;
constexpr size_t OUT_ST = 54525952ull;

constexpr size_t OFF_WinT = 0ull;
constexpr size_t OFF_WgT = 15728640ull;
constexpr size_t OFF_WbT = 32505856ull;
constexpr size_t OFF_WoT = 36700160ull;
constexpr size_t OFF_mod = 40894464ull;
constexpr size_t OFF_rope = 41115648ull;
constexpr size_t OFF_H = 41123840ull;
constexpr size_t OFF_Z = 125009920ull;
constexpr size_t OFF_KG = 439582720ull;
constexpr size_t OFF_VtG = 449019904ull;
constexpr size_t OFF_KD = 458457088ull;
constexpr size_t OFF_VtD = 477331456ull;
constexpr size_t OFF_VtGc = 496205824ull;
constexpr size_t OFF_VtDc = 498302976ull;
constexpr size_t OFF_VtRc = 502497280ull;
constexpr size_t OFF_VtRl = 506691584ull;
constexpr size_t OFF_U = 523468800ull;
constexpr size_t OFF_SinT = 565411840ull;
constexpr size_t OFF_Y = 586383360ull;
constexpr size_t OFF_bar = 670269440ull;
constexpr size_t OFF_KtRc = 670283264ull;
constexpr size_t OFF_KtRl = 674477568ull;
constexpr size_t OFF_tctr = 691254784ull;
constexpr size_t WS_NEED = 691255040ull;
struct Params {
  const float *x_prompt, *x_sample, *cache_gk, *cache_gv, *cache_dk, *cache_dv, *state_ret, *c, *c_ctx, *w_ada, *b_ada,
      *norm_gain, *w_in, *conv_w, *q_gain, *k_gain, *ret_decay, *diff_lambda, *diff_gain, *w_branch, *w_mgate, *w_out, *final_gain;
  float* out;
  unsigned char* ws;
};

typedef float f32x2 __attribute__((ext_vector_type(2)));
typedef __bf16 bf16x2_t __attribute__((ext_vector_type(2)));
typedef const Params __attribute__((address_space(4))) CPar;
DI CPar& PP() { CPar* q = (CPar*)__builtin_amdgcn_kernarg_segment_ptr(); asm volatile("" : "+s"(q)); return *q; }
DI unsigned pack2(float a, float b) {
  const f32x2 v = {a, b};
  return __builtin_bit_cast(unsigned, __builtin_convertvector(v, bf16x2_t));
}
DI u16 f2bf(float a) { return (u16)(pack2(a, 0.f) & 0xffffu); }
DI float bflo(unsigned v) { return __uint_as_float(v << 16); }
DI float bfhi(unsigned v) { return __uint_as_float(v & 0xffff0000u); }
DI float silu_f(float x) { return x * __builtin_amdgcn_rcpf(1.f + __expf(-x)); }
DI float sigmoid_f(float x) { return __builtin_amdgcn_rcpf(1.f + __expf(-x)); }
DI f32x16 zero16() { f32x16 z; _Pragma("unroll") for (int i = 0; i < 16; ++i) z[i] = 0.f; return z; }
DI int otid() { int t = (int)__builtin_amdgcn_workitem_id_x(); asm volatile("" : "+v"(t)); return t; }
DI int vblock() { const int b = (int)blockIdx.x, g = (int)gridDim.x; return ((g & 7) == 0) ? (b & 7) * (g >> 3) + (b >> 3) : b; }
DI size_t tix(int r, int k, int ksl) { return ((size_t)((r >> 7) * ksl + (k >> 5)) << 12) + ((r & 127) << 5) + (k & 31); }
#define XB_TMO      128
#define XB_XCNT(j)  (256  + 64 * (j))
#define XB_XSUB(j)  (1280 + 64 * (j))
#define XB_XGEN(j)  (2304 + 64 * (j))
#define XB_TOP      3328
#define XB_TOPGEN   3392
#define XCD_BAR_WORDS 3456
#define XB_SPIN_CAP (1u << 18)
#define LAS __attribute__((address_space(3)))

__device__ __forceinline__ unsigned xb_ld(unsigned* p)              { return __hip_atomic_load(p, __ATOMIC_RELAXED, __HIP_MEMORY_SCOPE_AGENT); }
__device__ __forceinline__ unsigned xb_add(unsigned* p, unsigned v) { return __hip_atomic_fetch_add(p, v, __ATOMIC_RELAXED, __HIP_MEMORY_SCOPE_AGENT); }
__device__ __forceinline__ unsigned xb_xcc_id() { return (unsigned)__builtin_amdgcn_s_getreg((3 << 11) | 20) & 0xFu; }
#define XB_SPIN(cond, bar) do { unsigned _sp = 0; while (cond) { __builtin_amdgcn_s_sleep(1); \
    if ((++_sp & 255u) == 0u) { if (xb_ld(&(bar)[XB_TMO])) break; if (_sp > XB_SPIN_CAP) { atomicAdd(&(bar)[XB_TMO], 1u); break; } } } } while (0)

struct XcdBarrier {
    unsigned* bar; unsigned x;
    volatile LAS unsigned* st;
};

__device__ __forceinline__ XcdBarrier xcd_barrier_post(unsigned* bar, volatile LAS unsigned* st) {
    XcdBarrier b; b.bar = bar; b.x = xb_xcc_id(); b.st = st;
    if (threadIdx.x == 0) (void)xb_add(&bar[XB_XCNT(b.x)], 1u);
    return b;
}
__device__ __forceinline__ void xcd_barrier_complete(unsigned* bar, unsigned x, unsigned& nloc, unsigned& nx) {
    const unsigned G = gridDim.x * gridDim.y * gridDim.z;
    unsigned sum, cnt, mine, sp = 0u;
    for (;;) {
        sum = 0u; cnt = 0u; mine = 0u;
#pragma unroll
        for (unsigned j = 0; j < 16; ++j) { const unsigned c = xb_ld(&bar[XB_XCNT(j)]); sum += c; cnt += (c > 0u) ? 1u : 0u; mine = (j == x) ? c : mine; }
        if (sum == G) break;
        __builtin_amdgcn_s_sleep(1);
        if ((++sp & 255u) == 0u) { if (xb_ld(&bar[XB_TMO])) break; if (sp > XB_SPIN_CAP) { atomicAdd(&bar[XB_TMO], 1u); break; } }
    }
    nloc = mine > 0u ? mine : 1u; nx = cnt > 0u ? cnt : 1u;
}

__device__ __forceinline__ void xcd_barrier(const XcdBarrier& b) {
    asm volatile("s_waitcnt vmcnt(0)" ::: "memory");
    __syncthreads();
    if (threadIdx.x == 0) {
        unsigned* bar = b.bar;
        __builtin_amdgcn_s_waitcnt(0);
        unsigned nloc = b.st[0], nx = b.st[1];
        if (nloc == 0u) { xcd_barrier_complete(bar, b.x, nloc, nx); b.st[0] = nloc; b.st[1] = nx; }
        const unsigned old = xb_add(&bar[XB_XSUB(b.x)], 1u);
        const unsigned gen = old / nloc;
        if (old + 1u == (gen + 1u) * nloc) {
            __builtin_amdgcn_fence(__ATOMIC_RELEASE, "agent");
            asm volatile("s_waitcnt vmcnt(0)" ::: "memory");
            const unsigned og = xb_add(&bar[XB_TOP], 1u);
            const unsigned tg = og / nx;
            if (og + 1u == (tg + 1u) * nx) xb_add(&bar[XB_TOPGEN], 1u);
            else XB_SPIN(xb_ld(&bar[XB_TOPGEN]) == tg, bar);
            __builtin_amdgcn_fence(__ATOMIC_ACQUIRE, "agent");
            xb_add(&bar[XB_XGEN(b.x)], 1u);
            asm volatile("s_waitcnt vmcnt(0)" ::: "memory");
        } else {
            XB_SPIN(xb_ld(&bar[XB_XGEN(b.x)]) == gen, bar);
            __builtin_amdgcn_fence(__ATOMIC_ACQUIRE, "agent");
            asm volatile("s_waitcnt vmcnt(0)" ::: "memory");
        }
    }
    __syncthreads();
}


DI int kperm(int t) { return (t & ~12) | ((t & 4) << 1) | ((t & 8) >> 1); }
DI float xhalf_max(float x) {
  const auto r = __builtin_amdgcn_permlane32_swap(__float_as_uint(x), __float_as_uint(x), false, false);
  return fmaxf(__uint_as_float(r[0]), __uint_as_float(r[1]));
}
DI float xhalf_sum(float x) {
  const auto r = __builtin_amdgcn_permlane32_swap(__float_as_uint(x), __float_as_uint(x), false, false);
  return __uint_as_float(r[0]) + __uint_as_float(r[1]);
}
DI float wave_sum(float v) {
  _Pragma("unroll") for (int o = 1; o < 64; o <<= 1) v += __shfl_xor(v, o);
  return v;
}

#define VMWAIT(N) asm volatile("s_waitcnt vmcnt(" #N ")" ::: "memory")
#define RAW_BARRIER() do { asm volatile("s_waitcnt lgkmcnt(0)" ::: "memory"); __builtin_amdgcn_s_barrier(); } while (0)
template <int TB, bool BMAP = false, bool LEAN = false>
DI void gemm_acc(const u16* __restrict__ A, const u16* __restrict__ B, int bstride, int nk, f32x16 (&acc)[2][TB], u16* sm) {
  const int tid = otid(), lane = tid & 63, w = tid >> 6, wn = w >> 1, wt = w & 1, l31 = lane & 31, hf = lane >> 5;
  constexpr int NSTG = (TB == 2) ? 4 : 3;
  constexpr int RB = 64 * TB;
  constexpr int STGB = (128 + RB) * 64;
  constexpr int LPB = RB / 64;
  const int lr = tid >> 2, gsl = (tid & 3) ^ ((lr >> 2) & 3);
  const u16* ga = A + lr * 32 + gsl * 8;
  const u16* gb = B + lr * 32 + gsl * 8;
  char* smb = (char*)sm;
  const int wv = __builtin_amdgcn_readfirstlane(w);
  char* smw = smb + wv * 1024;
  const u16* pa[2];
  const u16* pb[LPB];
  _Pragma("unroll") for (int i = 0; i < 2; ++i) pa[i] = ga + 2048 * i;
  _Pragma("unroll") for (int i = 0; i < LPB; ++i) pb[i] = BMAP ? gb + (size_t)(i & 1) * bstride + 2048 * (i >> 1) : gb + (size_t)(i >> 1) * bstride + 2048 * (i & 1);
#define GEMM_STAGE(ST) do { \
    _Pragma("unroll") for (int i = 0; i < 2; ++i) { \
      __builtin_amdgcn_global_load_lds((const unsigned*)pa[i], (unsigned*)(smw + (ST) * STGB + i * 4096), 16, 0, 0); pa[i] += 4096; } \
    _Pragma("unroll") for (int i = 0; i < LPB; ++i) { \
      __builtin_amdgcn_global_load_lds((const unsigned*)pb[i], (unsigned*)(smw + (ST) * STGB + 8192 + i * 4096), 16, 0, 0); pb[i] += 4096; } \
  } while (0)
  VMWAIT(0);
  _Pragma("unroll") for (int s0 = 0; s0 < NSTG - 1; ++s0) GEMM_STAGE(s0);
  const int sw = (l31 >> 2) & 3;
  const int oa0 = (wn * 64 + l31) * 64 + ((hf ^ sw) << 4), oa1 = (wn * 64 + l31) * 64 + (((2 + hf) ^ sw) << 4);
  const int ob0 = 8192 + (wt * 32 * TB + l31) * 64 + ((hf ^ sw) << 4), ob1 = 8192 + (wt * 32 * TB + l31) * 64 + (((2 + hf) ^ sw) << 4);
  int st = 0, stn = NSTG - 1;
  bf16x8 dfa[2], dfb[TB];
  _Pragma("unroll") for (int a = 0; a < 2; ++a) dfa[a] = bf16x8{0, 0, 0, 0, 0, 0, 0, 0};
  _Pragma("unroll") for (int b = 0; b < TB; ++b) dfb[b] = bf16x8{0, 0, 0, 0, 0, 0, 0, 0};
  for (int kt = 0; kt < nk; ++kt) {
    if (kt + NSTG - 2 < nk) { if (TB == 2) VMWAIT(8); else VMWAIT(6); }
    else if (NSTG == 4 && kt + 1 < nk) VMWAIT(4);
    else VMWAIT(0);
    RAW_BARRIER();
    if (kt + NSTG - 1 < nk) GEMM_STAGE(stn);
    __builtin_amdgcn_sched_barrier(0);
    const char* sb = smb + st * STGB;
    if (!LEAN) {
      bf16x8 fa0[2], fb0[TB], fa1[2], fb1[TB];
      _Pragma("unroll") for (int a = 0; a < 2; ++a) fa0[a] = *(const bf16x8*)(sb + oa0 + a * 2048);
      _Pragma("unroll") for (int b = 0; b < TB; ++b) fb0[b] = *(const bf16x8*)(sb + ob0 + b * 2048);
      _Pragma("unroll") for (int a = 0; a < 2; ++a) fa1[a] = *(const bf16x8*)(sb + oa1 + a * 2048);
      _Pragma("unroll") for (int b = 0; b < TB; ++b) fb1[b] = *(const bf16x8*)(sb + ob1 + b * 2048);
      __builtin_amdgcn_sched_barrier(0);
      _Pragma("unroll") for (int a = 0; a < 2; ++a)
        _Pragma("unroll") for (int b = 0; b < TB; ++b) acc[a][b] = MFMA32(dfa[a], dfb[b], acc[a][b]);
      __builtin_amdgcn_sched_barrier(0);
      _Pragma("unroll") for (int a = 0; a < 2; ++a)
        _Pragma("unroll") for (int b = 0; b < TB; ++b) acc[a][b] = MFMA32(fa0[a], fb0[b], acc[a][b]);
      __builtin_amdgcn_sched_barrier(0);
      _Pragma("unroll") for (int a = 0; a < 2; ++a) dfa[a] = fa1[a];
      _Pragma("unroll") for (int b = 0; b < TB; ++b) dfb[b] = fb1[b];
    } else {
      _Pragma("unroll") for (int ks = 0; ks < 2; ++ks) {
        bf16x8 fa[2], fb[TB];
        _Pragma("unroll") for (int a = 0; a < 2; ++a) fa[a] = *(const bf16x8*)(sb + (ks ? oa1 : oa0) + a * 2048);
        _Pragma("unroll") for (int b = 0; b < TB; ++b) fb[b] = *(const bf16x8*)(sb + (ks ? ob1 : ob0) + b * 2048);
        __builtin_amdgcn_sched_barrier(0);
        _Pragma("unroll") for (int a = 0; a < 2; ++a)
          _Pragma("unroll") for (int b = 0; b < TB; ++b) acc[a][b] = MFMA32(fa[a], fb[b], acc[a][b]);
        __builtin_amdgcn_sched_barrier(0);
      }
    }
    st = (st + 1 == NSTG) ? 0 : st + 1;
    stn = (stn + 1 == NSTG) ? 0 : stn + 1;
  }
  if (!LEAN) {
    _Pragma("unroll") for (int a = 0; a < 2; ++a)
      _Pragma("unroll") for (int b = 0; b < TB; ++b) acc[a][b] = MFMA32(dfa[a], dfb[b], acc[a][b]);
  }
  RAW_BARRIER();
#undef GEMM_STAGE
}

DI void phase0(CPar& p, unsigned char* smem) {
  const int tid = otid();
  float* tile = (float*)smem;
  for (int job = blockIdx.x; job < 4992; job += gridDim.x) {
    const int l = job / 2496;
    int rem = job - l * 2496;
    const float* src; u16* dst; int C;
    if (rem < 960) { src = p.w_in + (size_t)l * 1024 * 3840; dst = ((u16*)(p.ws + OFF_WinT)) + (size_t)l * 3840 * 1024; C = 3840; }
    else if (rem < 1984) { rem -= 960; src = p.w_mgate + (size_t)l * 1024 * 4096; dst = ((u16*)(p.ws + OFF_WgT)) + (size_t)l * 4096 * 1024; C = 4096; }
    else if (rem < 2240) { rem -= 1984; src = p.w_branch + (size_t)l * 1024 * 1024; dst = ((u16*)(p.ws + OFF_WbT)) + (size_t)l * 1024 * 1024; C = 1024; }
    else { rem -= 2240; src = p.w_out + (size_t)l * 1024 * 1024; dst = ((u16*)(p.ws + OFF_WoT)) + (size_t)l * 1024 * 1024; C = 1024; }
    const int tr = rem & 15, tc = rem >> 4;
    const int r0 = tr * 64, c0 = tc * 64;
    __syncthreads();
    _Pragma("unroll") for (int i = 0; i < 4; ++i) {
      const int rr = (tid >> 4) + 16 * i, cc = (tid & 15) * 4;
      const float4 v = *(const float4*)(src + (size_t)(r0 + rr) * C + c0 + cc);
      tile[rr * 65 + cc + 0] = v.x; tile[rr * 65 + cc + 1] = v.y; tile[rr * 65 + cc + 2] = v.z; tile[rr * 65 + cc + 3] = v.w;
    }
    __syncthreads();
    {
      const int n = tid >> 2, kq = (tid & 3) * 16;
      unsigned wv[8];
      _Pragma("unroll") for (int j = 0; j < 8; ++j) wv[j] = pack2(tile[(kq + 2 * j) * 65 + n], tile[(kq + 2 * j + 1) * 65 + n]);
      u16* d = dst + tix(c0 + n, r0 + kq, 32);
      *(uint4*)d = make_uint4(wv[0], wv[1], wv[2], wv[3]);
      *(uint4*)(d + 8) = make_uint4(wv[4], wv[5], wv[6], wv[7]);
    }
  }
  __syncthreads();
  if (blockIdx.x < 384) {
  {
    float* sc = (float*)smem;
    float* red = sc + 9 * 1024;
    for (int i = tid; i < 9 * 1024; i += 256) {
      const int j = i >> 10, k = i & 1023;
      const float cv = (j == 0) ? p.c_ctx[k] : p.c[(j - 1) * 1024 + k];
      sc[i] = silu_f(cv);
    }
    __syncthreads();
    for (int item = blockIdx.x; item < 384; item += gridDim.x) {
    const int lane = tid & 63, w = tid >> 6;
    const int l = item / 192, n = (item % 192) * 16 + (lane & 15);
    const int kbeg = (w * 4 + (lane >> 4)) * 64;
    float acc[9];
    _Pragma("unroll") for (int j = 0; j < 9; ++j) acc[j] = 0.f;
    const float* wp = p.w_ada + (size_t)l * 1024 * 3072 + n;
    for (int k = kbeg; k < kbeg + 64; k += 8) {
      float wv[8];
      _Pragma("unroll") for (int u = 0; u < 8; ++u) wv[u] = wp[(size_t)(k + u) * 3072];
      _Pragma("unroll") for (int u = 0; u < 8; ++u)
        _Pragma("unroll") for (int j = 0; j < 9; ++j) acc[j] += sc[j * 1024 + k + u] * wv[u];
    }
    _Pragma("unroll") for (int j = 0; j < 9; ++j) {
      acc[j] += __shfl_xor(acc[j], 16);
      acc[j] += __shfl_xor(acc[j], 32);
    }
    if (lane < 16) {
      _Pragma("unroll") for (int j = 0; j < 9; ++j) red[(w * 9 + j) * 16 + lane] = acc[j];
    }
    __syncthreads();
    if (tid < 144) {
      const int j = tid >> 4, nn = tid & 15;
      const int n2 = (item % 192) * 16 + nn;
      const float v = red[(0 * 9 + j) * 16 + nn] + red[(1 * 9 + j) * 16 + nn] + red[(2 * 9 + j) * 16 + nn] + red[(3 * 9 + j) * 16 + nn];
      ((float*)(p.ws + OFF_mod))[(l * 9 + j) * 3072 + n2] = v + p.b_ada[l * 3072 + n2];
    }
    __syncthreads();
    }
  }
  }
  if (blockIdx.x == gridDim.x - 1) {
    for (int i = tid; i < 1024; i += 256) {
      const int pos = i >> 4, f = i & 15;
      const float inv = powf(10000.f, -(float)f / 16.f);
      const float ang = (float)pos * inv;
      ((float*)(p.ws + OFF_rope))[2 * i] = cosf(ang);
      ((float*)(p.ws + OFF_rope))[2 * i + 1] = sinf(ang);
    }
  }
}

DI void phaseA0(CPar& p, int l) {
  const int tid = otid(), lane = tid & 63;
  const int gw = blockIdx.x * 4 + (tid >> 6), nw = gridDim.x * 4;
  const float* ng = p.norm_gain + l * 1024;
  for (int row = gw; row < MT; row += nw) {
    const float* xr = (l == 0) ? (row < MC ? p.x_prompt + (size_t)row * 1024 : p.x_sample + (size_t)(row - MC) * 1024)
                               : p.out + (size_t)row * 1024;
    float4 v[4];
    float ss = 0.f;
    _Pragma("unroll") for (int i = 0; i < 4; ++i) {
      v[i] = ((const float4*)xr)[lane + 64 * i];
      ss += v[i].x * v[i].x + v[i].y * v[i].y + v[i].z * v[i].z + v[i].w * v[i].w;
    }
    ss = wave_sum(ss);
    const float rstd = rsqrtf(ss * (1.f / 1024.f) + EPSN);
    const int j = row < MC ? 0 : 1 + ((row - MC) >> 12);
    const float* shift = ((float*)(p.ws + OFF_mod)) + (l * 9 + j) * 3072;
    const float* scale = shift + 1024;
    _Pragma("unroll") for (int i = 0; i < 4; ++i) {
      const int k = 4 * (lane + 64 * i);
      const float4 g = *(const float4*)(ng + k);
      const float4 s = *(const float4*)(scale + k);
      const float4 sh = *(const float4*)(shift + k);
      const float h0 = v[i].x * rstd * g.x * (1.f + s.x) + sh.x;
      const float h1 = v[i].y * rstd * g.y * (1.f + s.y) + sh.y;
      const float h2 = v[i].z * rstd * g.z * (1.f + s.z) + sh.z;
      const float h3 = v[i].w * rstd * g.w * (1.f + s.w) + sh.w;
      *(uint2*)(((u16*)(p.ws + OFF_H)) + tix(row, k, 32)) = make_uint2(pack2(h0, h1), pack2(h2, h3));
    }
  }
  const int gt = blockIdx.x * 256 + tid, nt = gridDim.x * 256;
  for (int idx = gt; idx < 8 * 65536; idx += nt) {
    const int b = idx >> 16, rem = idx & 65535;
    ((u16*)(p.ws + OFF_KG))[(size_t)b * NKL * 128 + rem] = f2bf(p.cache_gk[(size_t)(b * 2 + l) * 65536 + rem]);
  }
  for (int idx = gt; idx < 8 * 131072; idx += nt) {
    const int b = idx >> 17, rem = idx & 131071;
    ((u16*)(p.ws + OFF_KD))[(size_t)b * NKL * 256 + rem] = f2bf(p.cache_dk[(size_t)(b * 2 + l) * 131072 + rem]);
  }
  for (int idx = gt; idx < 8 * 2 * 64 * 512; idx += nt) {
    const int pk = idx & 511, dv = (idx >> 9) & 63, g = (idx >> 15) & 1, b = idx >> 16;
    ((u16*)(p.ws + OFF_VtG))[((size_t)(b * 2 + g) * 64 + dv) * NKL + kperm(pk)] = f2bf(p.cache_gv[((size_t)(b * 2 + l) * 512 + pk) * 128 + g * 64 + dv]);
  }
  for (int idx = gt; idx < 8 * 4 * 64 * 512; idx += nt) {
    const int pk = idx & 511, dv = (idx >> 9) & 63, h = (idx >> 15) & 3, b = idx >> 17;
    ((u16*)(p.ws + OFF_VtD))[((size_t)(b * 4 + h) * 64 + dv) * NKL + kperm(pk)] = f2bf(p.cache_dv[((size_t)(b * 2 + l) * 512 + pk) * 256 + h * 64 + dv]);
  }
}

#define NLOC(a, r) ((a) * 32 + 8 * ((r) >> 2) + 4 * hf + ((r) & 3))

template <int NB>
DI void a1_epilogue(CPar& p, int l, int nbase, int m0w, f32x16 (&acc)[2][NB], unsigned char* smem) {
  const int lane = otid() & 63, l31 = lane & 31, hf = lane >> 5;
  u16* stg = (u16*)smem + (otid() >> 6) * (32 * 72);
  _Pragma("unroll") for (int b = 0; b < NB; ++b) {
    const int m = m0w + b * 32 + l31;
    const bool ctx = m < MC;
    int bb, t;
    if (ctx) { bb = m >> 8; t = m & 255; } else { const int ml = m - MC; bb = ml >> 12; t = ml & 4095; }
    float v[2][16];
    _Pragma("unroll") for (int a = 0; a < 2; ++a)
      _Pragma("unroll") for (int r = 0; r < 16; ++r) v[a][r] = acc[a][b][r];

    auto rmsn = [&](const float* gain) {
      float ss = 0.f;
      _Pragma("unroll") for (int a = 0; a < 2; ++a)
        _Pragma("unroll") for (int r = 0; r < 16; ++r) ss += v[a][r] * v[a][r];
      ss = xhalf_sum(ss);
      const float rinv = rsqrtf(ss * (1.f / 64.f) + EPSN);
      _Pragma("unroll") for (int a = 0; a < 2; ++a)
        _Pragma("unroll") for (int i = 0; i < 4; ++i) {
          const float4 g = *(const float4*)(gain + a * 32 + 8 * i + 4 * hf);
          v[a][4 * i + 0] *= rinv * g.x; v[a][4 * i + 1] *= rinv * g.y; v[a][4 * i + 2] *= rinv * g.z; v[a][4 * i + 3] *= rinv * g.w;
        }
    };
    auto rope64 = [&]() {
      const int trow = t >> 6, tcol = t & 63;
      const float2* rp = (const float2*)((float*)(p.ws + OFF_rope));
      _Pragma("unroll") for (int r = 0; r < 16; ++r) {
        const int j = 8 * (r >> 2) + 4 * hf + (r & 3);
        const int pos = ((r >> 2) < 2) ? trow : tcol;
        const float2 cs = rp[pos * 16 + (j & 15)];
        const float x1 = v[0][r], x2 = v[1][r];
        v[0][r] = x1 * cs.x - x2 * cs.y;
        v[1][r] = x1 * cs.y + x2 * cs.x;
      }
    };
    auto rope32 = [&]() {
      const int trow = t >> 6, tcol = t & 63;
      const float2* rp = (const float2*)((float*)(p.ws + OFF_rope));
      _Pragma("unroll") for (int a = 0; a < 2; ++a)
        _Pragma("unroll") for (int r = 0; r < 8; ++r) {
          const int j = 8 * (r >> 2) + 4 * hf + (r & 3);
          const int pos = ((r >> 2) == 0) ? trow : tcol;
          const float2 cs = rp[pos * 16 + 2 * (j & 7)];
          const float x1 = v[a][r], x2 = v[a][r + 8];
          v[a][r] = x1 * cs.x - x2 * cs.y;
          v[a][r + 8] = x1 * cs.y + x2 * cs.x;
        }
    };
    auto store_nat = [&](u16* dst, int stride) {
      _Pragma("unroll") for (int a = 0; a < 2; ++a)
        _Pragma("unroll") for (int i = 0; i < 4; ++i)
          *(uint2*)(stg + l31 * 72 + a * 32 + 8 * i + 4 * hf) = make_uint2(pack2(v[a][4 * i], v[a][4 * i + 1]), pack2(v[a][4 * i + 2], v[a][4 * i + 3]));
      u16* rp = dst + ((lane >> 3) - l31) * stride + (lane & 7) * 8;
      _Pragma("unroll") for (int j = 0; j < 4; ++j) {
        const uint4 val = *(const uint4*)(stg + ((lane >> 3) + 8 * j) * 72 + (lane & 7) * 8);
        *(uint4*)(rp + (size_t)(8 * j) * stride) = val;
      }
    };
    auto store_f32 = [&](float* dst) {
      _Pragma("unroll") for (int a = 0; a < 2; ++a)
        _Pragma("unroll") for (int i = 0; i < 4; ++i)
          *(float4*)(dst + a * 32 + 8 * i + 4 * hf) = make_float4(v[a][4 * i], v[a][4 * i + 1], v[a][4 * i + 2], v[a][4 * i + 3]);
    };
    auto store_T = [&](u16* dst, int ld) {
      _Pragma("unroll") for (int a = 0; a < 2; ++a)
        _Pragma("unroll") for (int r = 0; r < 16; ++r) dst[(size_t)NLOC(a, r) * ld] = f2bf(v[a][r]);
    };

    u16* zrow = ((u16*)(p.ws + OFF_Z)) + (size_t)m * INW + nbase;
    if (nbase < 1024) {
      store_nat(zrow, INW);
    } else if (nbase < 1280) {
      rmsn(p.q_gain + l * 64);
      if (!ctx) rope64();
      store_nat(zrow, INW);
    } else if (nbase < 1408) {
      const int kvh = (nbase - 1280) >> 6;
      rmsn(p.k_gain + l * 64);
      if (ctx) {
        store_f32(p.out + OUT_GK + ((size_t)(bb * 2 + l) * 256 + t) * 128 + kvh * 64);
        store_nat(zrow, INW);
      } else {
        rope64();
        store_nat(((u16*)(p.ws + OFF_KG)) + ((size_t)bb * NKL + 512 + t) * 128 + kvh * 64, 128);
      }
    } else if (nbase < 1536) {
      const int kvh = (nbase - 1408) >> 6;
      if (ctx) {
        store_f32(p.out + OUT_GV + ((size_t)(bb * 2 + l) * 256 + t) * 128 + kvh * 64);
        store_T(((u16*)(p.ws + OFF_VtGc)) + ((size_t)(bb * 2 + kvh) * 64) * 256 + kperm(t), 256);
      } else {
        store_T(((u16*)(p.ws + OFF_VtG)) + ((size_t)(bb * 2 + kvh) * 64) * NKL + 512 + kperm(t), NKL);
      }
    } else if (nbase < 2048) {
      store_nat(zrow, INW);
    } else if (nbase < 2304) {
      const int hh = (nbase - 2048) >> 6;
      _Pragma("unroll") for (int a = 0; a < 2; ++a)
        _Pragma("unroll") for (int r = 0; r < 16; ++r) v[a][r] *= 0.125f;
      store_nat(zrow, INW);
      if (ctx) store_T(((u16*)(p.ws + OFF_KtRc)) + ((size_t)(bb * 4 + hh) * 64) * 256 + kperm(t), 256);
      else store_T(((u16*)(p.ws + OFF_KtRl)) + ((size_t)(bb * 4 + hh) * 64) * 4096 + kperm(t), 4096);
    } else if (nbase < 2560) {
      const int hh = (nbase - 2304) >> 6;
      store_nat(zrow, INW);
      if (ctx) store_T(((u16*)(p.ws + OFF_VtRc)) + ((size_t)(bb * 4 + hh) * 64) * 256 + kperm(t), 256);
      else store_T(((u16*)(p.ws + OFF_VtRl)) + ((size_t)(bb * 4 + hh) * 64) * 4096 + kperm(t), 4096);
    } else if (nbase < 2816) {
      store_nat(zrow, INW);
    } else if (nbase < 3072) {
      if (!ctx) rope32();
      store_nat(zrow, INW);
    } else if (nbase < 3328) {
      const int cb = nbase - 3072;
      if (ctx) {
        store_f32(p.out + OUT_DK + ((size_t)(bb * 2 + l) * 256 + t) * 256 + cb);
        store_nat(zrow, INW);
      } else {
        rope32();
        store_nat(((u16*)(p.ws + OFF_KD)) + ((size_t)bb * NKL + 512 + t) * 256 + cb, 256);
      }
    } else if (nbase < 3584) {
      const int cb = nbase - 3328, hh = cb >> 6;
      if (ctx) {
        store_f32(p.out + OUT_DV + ((size_t)(bb * 2 + l) * 256 + t) * 256 + cb);
        store_T(((u16*)(p.ws + OFF_VtDc)) + ((size_t)(bb * 4 + hh) * 64) * 256 + kperm(t), 256);
      } else {
        store_T(((u16*)(p.ws + OFF_VtD)) + ((size_t)(bb * 4 + hh) * 64) * NKL + 512 + kperm(t), NKL);
      }
    } else {
      store_nat(zrow, INW);
    }
  }
}

DI void phaseA1(CPar& p, int l, unsigned char* smem) {
  const int w = otid() >> 6, wn = w >> 1, wt = w & 1;
  for (int tile = vblock(); tile < 30 * 160; tile += gridDim.x) {
    const int grp = tile / 800, rem = tile - grp * 800;
    const int tm = rem / 5, tn = grp * 5 + (rem - tm * 5);
    f32x16 acc[2][4];
    _Pragma("unroll") for (int a = 0; a < 2; ++a)
      _Pragma("unroll") for (int b = 0; b < 4; ++b) acc[a][b] = zero16();
    gemm_acc<4>(((u16*)(p.ws + OFF_WinT)) + (size_t)l * 3840 * 1024 + ((size_t)(tn * 32) << 12), ((u16*)(p.ws + OFF_H)) + ((size_t)(tm * 2 * 32) << 12), 32 * 4096, 32, acc, (u16*)smem);
    a1_epilogue<4>(p, l, tn * 128 + wn * 64, tm * 256 + wt * 128, acc, smem);
    __syncthreads();
  }
}

DI void ld8(const u16* ptr, float (&f)[8]) {
  const uint4 v = *(const uint4*)ptr;
  f[0] = bflo(v.x); f[1] = bfhi(v.x); f[2] = bflo(v.y); f[3] = bfhi(v.y);
  f[4] = bflo(v.z); f[5] = bfhi(v.z); f[6] = bflo(v.w); f[7] = bfhi(v.w);
}

DI void conv_item(CPar& p, int l, int item) {
  const int gt = item * 256 + otid(), nt = MT * 32;
  const float* cw = p.conv_w + l * 768;
  for (int idx = gt; idx < MT * 32; idx += nt) {
    const int m = idx >> 5, c8 = (idx & 31) * 8;
    int t, T;
    if (m < MC) { t = m & 255; T = 256; } else { t = (m - MC) & 4095; T = 4096; }
    const u16* zr = ((u16*)(p.ws + OFF_Z)) + (size_t)m * INW + c8;
    float bg[8], gt8[8], cgc[8], uc[8], gp[8], gn[8];
    ld8(zr, bg); ld8(zr + 768, gt8); ld8(zr + 256, cgc); ld8(zr + 512, uc);
    if (t > 0) { float a[8], b[8]; ld8(zr - INW + 256, a); ld8(zr - INW + 512, b); _Pragma("unroll") for (int i = 0; i < 8; ++i) gp[i] = a[i] * b[i]; }
    else { _Pragma("unroll") for (int i = 0; i < 8; ++i) gp[i] = 0.f; }
    if (t < T - 1) { float a[8], b[8]; ld8(zr + INW + 256, a); ld8(zr + INW + 512, b); _Pragma("unroll") for (int i = 0; i < 8; ++i) gn[i] = a[i] * b[i]; }
    else { _Pragma("unroll") for (int i = 0; i < 8; ++i) gn[i] = 0.f; }
    float y[8];
    _Pragma("unroll") for (int i = 0; i < 8; ++i) {
      const float w0 = cw[c8 + i], w1 = cw[256 + c8 + i], w2 = cw[512 + c8 + i];
      const float g = cgc[i] * uc[i];
      y[i] = bg[i] * (w0 * gp[i] + w1 * g + w2 * gn[i]) * silu_f(gt8[i]);
    }
    *(uint4*)(((u16*)(p.ws + OFF_Y)) + tix(m, c8, 32)) = make_uint4(pack2(y[0], y[1]), pack2(y[2], y[3]), pack2(y[4], y[5]), pack2(y[6], y[7]));
  }
}

DI float log_gamma(CPar& p, int l, int dir, int h) {
  const float x = p.ret_decay[(l * 2 + dir) * 4 + h];
  return -log1pf(expf(-x));
}

DI void ret_decode(int item, bool& ctx, int& bb, int& h, int& c, int& m0) {
  if (item < 256) { ctx = true; c = item & 1; h = (item >> 1) & 3; bb = item >> 3; m0 = bb * 256 + c * 128; }
  else { const int it = item - 256; ctx = false; c = it & 31; h = (it >> 5) & 3; bb = it >> 7; m0 = MC + bb * 4096 + c * 128; }
}

DI void r1_items(CPar& p, int l, unsigned char* smem) {
  const int tid = otid(), lane = tid & 63, w = tid >> 6, l31 = lane & 31, hf = lane >> 5;
  const int ti = w >> 1, tj = w & 1;
  const float LOG2E = 1.4426950408889634f;
  for (int item = blockIdx.x; item < 1280; item += gridDim.x) {
    bool ctx; int bb, h, c, m0;
    ret_decode(item, ctx, bb, h, c, m0);
    const float lf2 = log_gamma(p, l, 0, h) * LOG2E, lb2 = log_gamma(p, l, 1, h) * LOG2E;
    const int ld = ctx ? 256 : 4096;
    const size_t hb = ctx ? ((size_t)(bb * 4 + h) * 64) * 256 + c * 128 : ((size_t)(bb * 4 + h) * 64) * 4096 + c * 128;
    const u16* Kt = (ctx ? (const u16*)(p.ws + OFF_KtRc) : (const u16*)(p.ws + OFF_KtRl)) + hb + (size_t)(ti * 32 + l31) * ld + 8 * hf;
    const u16* Vt = (ctx ? (const u16*)(p.ws + OFF_VtRc) : (const u16*)(p.ws + OFF_VtRl)) + hb + (size_t)(tj * 32 + l31) * ld + 8 * hf;
    f32x16 Uf = zero16(), Ub = zero16();
    _Pragma("unroll") for (int s8 = 0; s8 < 8; ++s8) {
      const bf16x8 af = *(const bf16x8*)(Kt + 16 * s8);
      const u32x4 bv = *(const u32x4*)(Vt + 16 * s8);
      u32x4 bfw, bbw;
      _Pragma("unroll") for (int q = 0; q < 4; ++q) {
        const int j0 = 16 * s8 + 8 * ((2 * q) >> 2) + 4 * hf + ((2 * q) & 3);
        const float v0 = bflo(bv[q]), v1 = bfhi(bv[q]);
        const float wf0 = __builtin_amdgcn_exp2f(lf2 * (float)(127 - j0)), wf1 = __builtin_amdgcn_exp2f(lf2 * (float)(126 - j0));
        const float wb0 = __builtin_amdgcn_exp2f(lb2 * (float)j0), wb1 = __builtin_amdgcn_exp2f(lb2 * (float)(j0 + 1));
        bfw[q] = pack2(v0 * wf0, v1 * wf1);
        bbw[q] = pack2(v0 * wb0, v1 * wb1);
      }
      Uf = MFMA32(af, __builtin_bit_cast(bf16x8, bfw), Uf);
      Ub = MFMA32(af, __builtin_bit_cast(bf16x8, bbw), Ub);
    }
    float* uo = ((float*)(p.ws + OFF_U)) + (size_t)item * 2 * 4096 + tj * 32 + l31;
    _Pragma("unroll") for (int r = 0; r < 16; ++r) {
      const int dk = ti * 32 + 8 * (r >> 2) + 4 * hf + (r & 3);
      uo[dk * 64] = Uf[r];
      uo[4096 + dk * 64] = Ub[r];
    }
  }
}

template <bool CTX>
DI void r2_item(CPar& p, int l, int bi) {
  const int tid = otid();
  const int eb = bi & 15, dir = (bi >> 4) & 1, h = (bi >> 5) & 3, bb = bi >> 7;
  const int ep = eb * 256 + tid;
  const int dv = ep >> 6, dk = ep & 63;
  const int e = dk * 64 + dv;
  constexpr int nch = CTX ? 2 : 32;
  const int base = CTX ? (bb * 4 + h) * 2 : 256 + (bb * 4 + h) * 32;
  const float gC = expf(log_gamma(p, l, dir, h) * 128.f);
  float S = CTX ? 0.f : p.state_ret[((((size_t)bb * 2 + l) * 2 + dir) * 4 + h) * 4096 + e];
  float u[nch];
  _Pragma("unroll") for (int i = 0; i < nch; ++i) {
    const int c = dir ? (nch - 1 - i) : i;
    u[i] = ((float*)(p.ws + OFF_U))[((size_t)(base + c) * 2 + dir) * 4096 + e];
  }
  _Pragma("unroll") for (int i = 0; i < nch; ++i) {
    const int c = dir ? (nch - 1 - i) : i;
    ((u16*)(p.ws + OFF_SinT))[((size_t)(base + c) * 2 + dir) * 4096 + ep] = f2bf(S);
    S = S * gC + u[i];
  }
  if (CTX) p.out[OUT_ST + ((((size_t)bb * 2 + l) * 2 + dir) * 4 + h) * 4096 + e] = S;
}

template <bool DIFF>
DI void attn_item(CPar& p, int l, bool ctx, int bb, int unit, int qb, unsigned char* smem) {
  const int tid = otid(), lane = tid & 63, w = tid >> 6, l31 = lane & 31, hf = lane >> 5;
  const int qi = w & 1, qs = w >> 1;
  const int mq = (ctx ? bb * 256 : MC + bb * 4096) + qb * 64 + qs * 32 + l31;
  const int nkeys = ctx ? 256 : NKL;
  const u16* Kp; const u16* Vt; int ldk, ldv;
  if (!DIFF) {
    if (ctx) { Kp = ((u16*)(p.ws + OFF_Z)) + (size_t)(bb * 256) * INW + 1280 + unit * 64; ldk = INW; Vt = ((u16*)(p.ws + OFF_VtGc)) + ((size_t)(bb * 2 + unit) * 64) * 256; ldv = 256; }
    else { Kp = ((u16*)(p.ws + OFF_KG)) + (size_t)bb * NKL * 128 + unit * 64; ldk = 128; Vt = ((u16*)(p.ws + OFF_VtG)) + ((size_t)(bb * 2 + unit) * 64) * NKL; ldv = NKL; }
  } else {
    if (ctx) { Kp = ((u16*)(p.ws + OFF_Z)) + (size_t)(bb * 256) * INW + 3072 + unit * 64; ldk = INW; Vt = ((u16*)(p.ws + OFF_VtDc)) + ((size_t)(bb * 4 + unit) * 64) * 256; ldv = 256; }
    else { Kp = ((u16*)(p.ws + OFF_KD)) + (size_t)bb * NKL * 256 + unit * 64; ldk = 256; Vt = ((u16*)(p.ws + OFF_VtD)) + ((size_t)(bb * 4 + unit) * 64) * NKL; ldv = NKL; }
  }
  constexpr int NS = DIFF ? 2 : 4;
  bf16x8 qf[NS];
  {
    const u16* zq = ((u16*)(p.ws + OFF_Z)) + (size_t)mq * INW + (DIFF ? 2816 + unit * 64 + qi * 32 : 1024 + (unit * 2 + qi) * 64) + hf * 8;
    _Pragma("unroll") for (int s = 0; s < NS; ++s) qf[s] = *(const bf16x8*)(zq + s * 16);
  }
  const float sc = (DIFF ? 0.17677669529663687f : 0.125f) * 1.4426950408889634f;
  f32x16 O[2];
  O[0] = zero16(); O[1] = zero16();
  float mref = -1e30f, lsum = 0.f;

  char* smb = (char*)smem;
  constexpr int STGB = 16384;
  const int lr = tid >> 3, gch = (tid & 7) ^ ((lr >> 1) & 7);
  const u16* gk = Kp + (size_t)lr * ldk + gch * 8;
  const u16* gv = Vt + (size_t)lr * ldv + gch * 8;
  const int wv = __builtin_amdgcn_readfirstlane(w);
  char* smw = smb + wv * 1024;
  const u16* pk0 = gk; const u16* pk1 = gk + (size_t)32 * ldk;
  const u16* pv0 = gv; const u16* pv1 = gv + (size_t)32 * ldv;
  const size_t kstep = (size_t)64 * ldk;
#define ATT_STAGE(ST) do { \
    __builtin_amdgcn_global_load_lds((const unsigned*)pk0, (unsigned*)(smw + (ST) * STGB), 16, 0, 0); pk0 += kstep; \
    __builtin_amdgcn_global_load_lds((const unsigned*)pk1, (unsigned*)(smw + (ST) * STGB + 4096), 16, 0, 0); pk1 += kstep; \
    __builtin_amdgcn_global_load_lds((const unsigned*)pv0, (unsigned*)(smw + (ST) * STGB + 8192), 16, 0, 0); pv0 += 64; \
    __builtin_amdgcn_global_load_lds((const unsigned*)pv1, (unsigned*)(smw + (ST) * STGB + 8192 + 4096), 16, 0, 0); pv1 += 64; \
  } while (0)
  const int nt = nkeys >> 6;
  __syncthreads();
  VMWAIT(0);
  ATT_STAGE(0); ATT_STAGE(1);
  const int sw = (l31 >> 1) & 7;
  const int kq0 = DIFF ? qi * 4 : 0;
  const f32x16 zc = {0.f, 0.f, 0.f, 0.f, 0.f, 0.f, 0.f, 0.f, 0.f, 0.f, 0.f, 0.f, 0.f, 0.f, 0.f, 0.f};
  auto softmax_pv = [&](f32x16 (&S)[2], const char* sV) {
    bf16x8 vfr[2][4];
    _Pragma("unroll") for (int a = 0; a < 2; ++a)
      _Pragma("unroll") for (int s2 = 0; s2 < 4; ++s2)
        vfr[a][s2] = *(const bf16x8*)(sV + (a * 32 + l31) * 128 + (((2 * s2 + hf) ^ sw) << 4));
    float mx = S[0][0];
    _Pragma("unroll") for (int k2 = 0; k2 < 2; ++k2)
      _Pragma("unroll") for (int r = 0; r < 16; ++r) mx = fmaxf(mx, S[k2][r]);
    mx = xhalf_max(mx);
    const float mxs = mx * sc;
    if (__builtin_amdgcn_ballot_w64(mxs > mref + 8.f) != 0ull) {
      const float mnew = (mxs > mref + 8.f) ? mxs : mref;
      const float alpha = __builtin_amdgcn_exp2f(mref - mnew);
      mref = mnew;
      lsum *= alpha;
      _Pragma("unroll") for (int a = 0; a < 2; ++a)
        _Pragma("unroll") for (int r = 0; r < 16; ++r) O[a][r] *= alpha;
    }
    const f32x2 sc2 = {sc, sc}, nm2 = {-mref, -mref};
    f32x2 ps2 = {0.f, 0.f};
    bf16x8 pf[4];
    _Pragma("unroll") for (int k2 = 0; k2 < 2; ++k2)
      _Pragma("unroll") for (int u = 0; u < 2; ++u) {
        u32x4 pk;
        _Pragma("unroll") for (int j = 0; j < 4; ++j) {
          f32x2 v = {S[k2][8 * u + 2 * j], S[k2][8 * u + 2 * j + 1]};
          v = v * sc2 + nm2;
          f32x2 e;
          e.x = __builtin_amdgcn_exp2f(v.x);
          e.y = __builtin_amdgcn_exp2f(v.y);
          ps2 += e;
          pk[j] = pack2(e.x, e.y);
        }
        pf[2 * k2 + u] = __builtin_bit_cast(bf16x8, pk);
      }
    lsum += ps2.x + ps2.y;
    _Pragma("unroll") for (int a = 0; a < 2; ++a)
      _Pragma("unroll") for (int s2 = 0; s2 < 4; ++s2) O[a] = MFMA32(vfr[a][s2], pf[s2], O[a]);
  };
  for (int kt2 = 0; kt2 < nt; kt2 += 2) {
    VMWAIT(0);
    RAW_BARRIER();
    if (kt2 + 2 < nt) { ATT_STAGE((kt2 + 2) & 3); ATT_STAGE((kt2 + 3) & 3); }
    __builtin_amdgcn_sched_barrier(0);
    const char* sK0 = smb + (kt2 & 3) * STGB;
    const char* sK1 = smb + ((kt2 + 1) & 3) * STGB;
    f32x16 S0[2], S1[2];
    {
      bf16x8 kfa[NS][2], kfb[NS][2];
      _Pragma("unroll") for (int s = 0; s < NS; ++s)
        _Pragma("unroll") for (int k2 = 0; k2 < 2; ++k2)
          kfa[s][k2] = *(const bf16x8*)(sK0 + (k2 * 32 + l31) * 128 + (((kq0 + 2 * s + hf) ^ sw) << 4));
      _Pragma("unroll") for (int s = 0; s < NS; ++s)
        _Pragma("unroll") for (int k2 = 0; k2 < 2; ++k2)
          kfb[s][k2] = *(const bf16x8*)(sK1 + (k2 * 32 + l31) * 128 + (((kq0 + 2 * s + hf) ^ sw) << 4));
      __builtin_amdgcn_sched_barrier(0);
      _Pragma("unroll") for (int s = 0; s < NS; ++s)
        _Pragma("unroll") for (int k2 = 0; k2 < 2; ++k2)
          S0[k2] = MFMA32(kfa[s][k2], qf[s], s == 0 ? zc : S0[k2]);
      _Pragma("unroll") for (int s = 0; s < NS; ++s)
        _Pragma("unroll") for (int k2 = 0; k2 < 2; ++k2)
          S1[k2] = MFMA32(kfb[s][k2], qf[s], s == 0 ? zc : S1[k2]);
    }
    softmax_pv(S0, sK0 + 8192);
    softmax_pv(S1, sK1 + 8192);
  }
  RAW_BARRIER();
#undef ATT_STAGE
  const float inv = __builtin_amdgcn_rcpf(xhalf_sum(lsum));
  const u16* zg = ((u16*)(p.ws + OFF_Z)) + (size_t)mq * INW;
  if (!DIFF) {
    _Pragma("unroll") for (int a = 0; a < 2; ++a)
      _Pragma("unroll") for (int i = 0; i < 4; ++i) {
        const int col = (unit * 2 + qi) * 64 + a * 32 + 8 * i + 4 * hf;
        const uint2 gv2 = *(const uint2*)(zg + 1536 + col);
        const float y0 = O[a][4 * i + 0] * inv * silu_f(bflo(gv2.x));
        const float y1 = O[a][4 * i + 1] * inv * silu_f(bfhi(gv2.x));
        const float y2 = O[a][4 * i + 2] * inv * silu_f(bflo(gv2.y));
        const float y3 = O[a][4 * i + 3] * inv * silu_f(bfhi(gv2.y));
        *(uint2*)(((u16*)(p.ws + OFF_Y)) + tix(mq, 256 + col, 32)) = make_uint2(pack2(y0, y1), pack2(y2, y3));
      }
  } else {
    float* xb = (float*)smem + qs * 32 * 64;
    if (qi == 1) {
      _Pragma("unroll") for (int a = 0; a < 2; ++a)
        _Pragma("unroll") for (int r = 0; r < 16; ++r) xb[(a * 16 + r) * 64 + lane] = O[a][r] * inv;
    }
    __syncthreads();
    if (qi == 0) {
      const float* lp = p.diff_lambda + l * 128;
      float d1 = 0.f, d2 = 0.f;
      for (int i = 0; i < 32; ++i) { d1 += lp[i] * lp[32 + i]; d2 += lp[64 + i] * lp[96 + i]; }
      const float lam_init = 0.8f - 0.6f * expf(-0.3f * (float)l);
      const float lam = expf(d1) - expf(d2) + lam_init;
      float ss = 0.f;
      _Pragma("unroll") for (int a = 0; a < 2; ++a)
        _Pragma("unroll") for (int r = 0; r < 16; ++r) {
          const float o = O[a][r] * inv - lam * xb[(a * 16 + r) * 64 + lane];
          O[a][r] = o;
          ss += o * o;
        }
      ss = xhalf_sum(ss);
      const float rinv = rsqrtf(ss * (1.f / 64.f) + EPSN) * (1.f - lam_init);
      const float* gn = p.diff_gain + l * 64;
      _Pragma("unroll") for (int a = 0; a < 2; ++a)
        _Pragma("unroll") for (int i = 0; i < 4; ++i) {
          const int nl = a * 32 + 8 * i + 4 * hf;
          const int col = unit * 64 + nl;
          const uint2 gv2 = *(const uint2*)(zg + 3584 + col);
          const float4 g4 = *(const float4*)(gn + nl);
          const float y0 = O[a][4 * i + 0] * rinv * g4.x * silu_f(bflo(gv2.x));
          const float y1 = O[a][4 * i + 1] * rinv * g4.y * silu_f(bfhi(gv2.x));
          const float y2 = O[a][4 * i + 2] * rinv * g4.z * silu_f(bflo(gv2.y));
          const float y3 = O[a][4 * i + 3] * rinv * g4.w * silu_f(bfhi(gv2.y));
          *(uint2*)(((u16*)(p.ws + OFF_Y)) + tix(mq, 768 + col, 32)) = make_uint2(pack2(y0, y1), pack2(y2, y3));
        }
    }
  }
}

DI void r3_item(CPar& p, int l, int item, unsigned char* smem) {
  const int tid = otid(), lane = tid & 63, w = tid >> 6, l31 = lane & 31, hf = lane >> 5;
  bool ctx; int bb, h, c, m0;
  ret_decode(item, ctx, bb, h, c, m0);
  const int iq = w * 32 + l31;
  const int mq = m0 + iq;
  const float LOG2E = 1.4426950408889634f;
  const float lf2 = log_gamma(p, l, 0, h) * LOG2E, lb2 = log_gamma(p, l, 1, h) * LOG2E;
  u16* sK = (u16*)smem;
  u16* sV = sK + 128 * LSTR;
  constexpr int VSTR = 136;
  const u16* Vt = ctx ? ((u16*)(p.ws + OFF_VtRc)) + ((size_t)(bb * 4 + h) * 64) * 256 + c * 128 : ((u16*)(p.ws + OFF_VtRl)) + ((size_t)(bb * 4 + h) * 64) * 4096 + c * 128;
  const int ldv = ctx ? 256 : 4096;
  __syncthreads();
  _Pragma("unroll") for (int i = 0; i < 4; ++i) {
    const int cidx = tid + 256 * i;
    { const int row = cidx >> 3, kc = cidx & 7;
      *(uint4*)(sK + row * LSTR + kc * 8) = *(const uint4*)(((u16*)(p.ws + OFF_Z)) + (size_t)(m0 + row) * INW + 2048 + h * 64 + kc * 8); }
    { const int dv = cidx >> 4, kc = cidx & 15;
      *(uint4*)(sV + dv * VSTR + kc * 8) = *(const uint4*)(Vt + (size_t)dv * ldv + kc * 8); }
  }
  bf16x8 qf[4];
  {
    const u16* zq = ((u16*)(p.ws + OFF_Z)) + (size_t)mq * INW + 1792 + h * 64 + hf * 8;
    _Pragma("unroll") for (int s = 0; s < 4; ++s) qf[s] = *(const bf16x8*)(zq + s * 16);
  }
  __syncthreads();
  f32x16 O[2];
  O[0] = zero16(); O[1] = zero16();
  _Pragma("unroll 1") for (int kt = 0; kt < 2; ++kt) {
    f32x16 S[2];
    S[0] = zero16(); S[1] = zero16();
    _Pragma("unroll") for (int s = 0; s < 4; ++s)
      _Pragma("unroll") for (int k2 = 0; k2 < 2; ++k2) {
        const bf16x8 kf = *(const bf16x8*)(sK + (kt * 64 + k2 * 32 + l31) * LSTR + s * 16 + hf * 8);
        S[k2] = MFMA32(kf, qf[s], S[k2]);
      }
    bf16x8 pf[4];
    _Pragma("unroll") for (int k2 = 0; k2 < 2; ++k2) {
      _Pragma("unroll") for (int r = 0; r < 16; ++r) {
        const int jk = kt * 64 + k2 * 32 + 8 * (r >> 2) + 4 * hf + (r & 3);
        const int d = iq - jk;
        float wgt;
        if (d > 0) wgt = __builtin_amdgcn_exp2f(lf2 * (float)d);
        else if (d < 0) wgt = __builtin_amdgcn_exp2f(lb2 * (float)(-d));
        else wgt = 2.f;
        S[k2][r] *= wgt;
      }
      _Pragma("unroll") for (int u = 0; u < 2; ++u) {
        u32x4 pk;
        pk[0] = pack2(S[k2][8 * u + 0], S[k2][8 * u + 1]);
        pk[1] = pack2(S[k2][8 * u + 2], S[k2][8 * u + 3]);
        pk[2] = pack2(S[k2][8 * u + 4], S[k2][8 * u + 5]);
        pk[3] = pack2(S[k2][8 * u + 6], S[k2][8 * u + 7]);
        pf[2 * k2 + u] = __builtin_bit_cast(bf16x8, pk);
      }
    }
    _Pragma("unroll") for (int a = 0; a < 2; ++a)
      _Pragma("unroll") for (int s2 = 0; s2 < 4; ++s2) {
        const bf16x8 vf = *(const bf16x8*)(sV + (a * 32 + l31) * VSTR + kt * 64 + 16 * s2 + 8 * hf);
        O[a] = MFMA32(vf, pf[s2], O[a]);
      }
  }
  _Pragma("unroll") for (int dir = 0; dir < 2; ++dir) {
    const u16* st = ((u16*)(p.ws + OFF_SinT)) + ((size_t)item * 2 + dir) * 4096;
    const float dq = dir == 0 ? __builtin_amdgcn_exp2f(lf2 * (float)(iq + 1)) : __builtin_amdgcn_exp2f(lb2 * (float)(128 - iq));
    _Pragma("unroll") for (int a = 0; a < 2; ++a) {
      f32x16 X = zero16();
      _Pragma("unroll") for (int s = 0; s < 4; ++s) {
        const bf16x8 sf = *(const bf16x8*)(st + (a * 32 + l31) * 64 + s * 16 + hf * 8);
        X = MFMA32(sf, qf[s], X);
      }
      _Pragma("unroll") for (int r = 0; r < 16; ++r) O[a][r] += X[r] * dq;
    }
  }
  float ss = 0.f;
  _Pragma("unroll") for (int a = 0; a < 2; ++a)
    _Pragma("unroll") for (int r = 0; r < 16; ++r) ss += O[a][r] * O[a][r];
  ss = xhalf_sum(ss);
  const float rinv = rsqrtf(ss * (1.f / 64.f) + EPSN);
  const u16* zg = ((u16*)(p.ws + OFF_Z)) + (size_t)mq * INW + 2560 + h * 64;
  _Pragma("unroll") for (int a = 0; a < 2; ++a)
    _Pragma("unroll") for (int i = 0; i < 4; ++i) {
      const int nl = a * 32 + 8 * i + 4 * hf;
      const uint2 gv2 = *(const uint2*)(zg + nl);
      const float y0 = O[a][4 * i + 0] * rinv * silu_f(bflo(gv2.x));
      const float y1 = O[a][4 * i + 1] * rinv * silu_f(bfhi(gv2.x));
      const float y2 = O[a][4 * i + 2] * rinv * silu_f(bflo(gv2.y));
      const float y3 = O[a][4 * i + 3] * rinv * silu_f(bfhi(gv2.y));
      *(uint2*)(((u16*)(p.ws + OFF_Y)) + tix(mq, 512 + h * 64 + nl, 32)) = make_uint2(pack2(y0, y1), pack2(y2, y3));
    }
}

DI void phaseC(CPar& p, int l, unsigned char* smem) {
  const int lane = otid() & 63, w = otid() >> 6, wn = w >> 1, wt = w & 1, l31 = lane & 31, hf = lane >> 5;
  u16* Mg = ((u16*)(p.ws + OFF_Z));
  for (int tile = vblock(); tile < 8 * 320; tile += gridDim.x) {
    const int grp = tile / 640, rem = tile - grp * 640;
    const int tm = rem >> 1, tn = grp * 2 + (rem & 1);
    unsigned mgp[2][2][8];
    _Pragma("unroll") for (int a = 0; a < 2; ++a)
      _Pragma("unroll") for (int b = 0; b < 2; ++b)
        _Pragma("unroll") for (int r = 0; r < 8; ++r) mgp[a][b][r] = 0u;
    const u16* Ht = ((u16*)(p.ws + OFF_H)) + ((size_t)(tm * 32) << 12);
    _Pragma("unroll 1") for (int pr = 0; pr < 2; ++pr) {
      unsigned gp[2][4][8];
      {
        f32x16 acc[2][4];
        _Pragma("unroll") for (int a = 0; a < 2; ++a)
          _Pragma("unroll") for (int b = 0; b < 4; ++b) acc[a][b] = zero16();
        gemm_acc<4, true, true>(Ht, ((u16*)(p.ws + OFF_WgT)) + (size_t)l * 4096 * 1024 + ((size_t)((pr * 16 + tn) * 32) << 12), 8 * 32 * 4096, 32, acc, (u16*)smem);
        _Pragma("unroll") for (int a = 0; a < 2; ++a)
          _Pragma("unroll") for (int b = 0; b < 4; ++b)
            _Pragma("unroll") for (int r = 0; r < 8; ++r) gp[a][b][r] = pack2(sigmoid_f(acc[a][b][2 * r]), sigmoid_f(acc[a][b][2 * r + 1]));
      }
      _Pragma("unroll") for (int bh = 0; bh < 2; ++bh) {
        const int br = pr * 2 + bh;
        f32x16 acc[2][2];
        _Pragma("unroll") for (int a = 0; a < 2; ++a)
          _Pragma("unroll") for (int b = 0; b < 2; ++b) acc[a][b] = zero16();
        gemm_acc<2, false, true>(((u16*)(p.ws + OFF_Y)) + ((size_t)(tm * 32 + br * 8) << 12), ((u16*)(p.ws + OFF_WbT)) + (size_t)l * 1024 * 1024 + ((size_t)(tn * 32 + br * 8) << 12), 0, 8, acc, (u16*)smem);
        _Pragma("unroll") for (int a = 0; a < 2; ++a)
          _Pragma("unroll") for (int b = 0; b < 2; ++b)
            _Pragma("unroll") for (int r = 0; r < 8; ++r)
              mgp[a][b][r] = pack2(bflo(mgp[a][b][r]) + bflo(gp[a][bh * 2 + b][r]) * acc[a][b][2 * r], bfhi(mgp[a][b][r]) + bfhi(gp[a][bh * 2 + b][r]) * acc[a][b][2 * r + 1]);
      }
    }
    _Pragma("unroll") for (int a = 0; a < 2; ++a)
      _Pragma("unroll") for (int b = 0; b < 2; ++b) {
        const int n = tn * 128 + wt * 64 + b * 32 + l31;
        _Pragma("unroll") for (int r = 0; r < 8; ++r) {
          const int t0 = tm * 128 + wn * 64 + a * 32 + 8 * ((2 * r) >> 2) + 4 * hf + ((2 * r) & 3);
          Mg[tix(t0, n, 32)] = (u16)(mgp[a][b][r] & 0xffffu);
          Mg[tix(t0 + 1, n, 32)] = (u16)(mgp[a][b][r] >> 16);
        }
      }
  }
}

template <int TB>
DI void d_epilogue(CPar& p, int l, int tm, int nb0, f32x16 (&acc)[2][TB]) {
  const int lane = otid() & 63, w = otid() >> 6, wn = w >> 1, wt = w & 1, l31 = lane & 31, hf = lane >> 5;
  const int m0 = tm * 128 + wn * 64;
  const int j = m0 < MC ? 0 : 1 + ((m0 - MC) >> 12);
  const float* gate = ((float*)(p.ws + OFF_mod)) + (l * 9 + j) * 3072 + 2048;
  const float* xsrc = (l == 0) ? (m0 < MC ? p.x_prompt : p.x_sample - (size_t)MC * 1024) : p.out;
  _Pragma("unroll") for (int b = 0; b < TB; ++b) {
    const int n = (TB == 2) ? nb0 + wt * 64 + b * 32 + l31 : nb0 + (b >> 1) * 128 + wt * 64 + (b & 1) * 32 + l31;
    const float gv = gate[n];
    const size_t o0 = (size_t)(m0 + 4 * hf) * 1024 + n;
    const float* xp = xsrc + o0;
    float* op = p.out + o0;
    _Pragma("unroll") for (int a = 0; a < 2; ++a)
      _Pragma("unroll") for (int i = 0; i < 4; ++i) {
        float xv[4];
        _Pragma("unroll") for (int q = 0; q < 4; ++q) xv[q] = xp[q * 1024];
        _Pragma("unroll") for (int q = 0; q < 4; ++q) op[q * 1024] = xv[q] + gv * acc[a][b][4 * i + q];
        xp += 8 * 1024; op += 8 * 1024;
        asm volatile("" : "+v"(xp), "+v"(op));
      }
  }
}

DI void phaseD(CPar& p, int l, unsigned char* smem) {
  const u16* Mg = ((u16*)(p.ws + OFF_Z));
  const u16* Wo = ((u16*)(p.ws + OFF_WoT)) + (size_t)l * 1024 * 1024;
  for (int tile = vblock(); tile < 1024 + 512; tile += gridDim.x) {
    if (tile < 1024) {
      const int np = tile & 3, tm = tile >> 2;
      f32x16 acc[2][4];
      _Pragma("unroll") for (int a = 0; a < 2; ++a)
        _Pragma("unroll") for (int b = 0; b < 4; ++b) acc[a][b] = zero16();
      gemm_acc<4, true>(Mg + ((size_t)(tm * 32) << 12), Wo + ((size_t)(np * 2 * 32) << 12), 32 * 4096, 32, acc, (u16*)smem);
      d_epilogue<4>(p, l, tm, np * 256, acc);
    } else {
      const int t2 = tile - 1024, big = 1024 + (t2 >> 1), np = big & 3, tm = big >> 2, tn = np * 2 + (t2 & 1);
      f32x16 acc[2][2];
      _Pragma("unroll") for (int a = 0; a < 2; ++a)
        _Pragma("unroll") for (int b = 0; b < 2; ++b) acc[a][b] = zero16();
      gemm_acc<2>(Mg + ((size_t)(tm * 32) << 12), Wo + ((size_t)(tn * 32) << 12), 0, 32, acc, (u16*)smem);
      d_epilogue<2>(p, l, tm, tn * 128, acc);
    }
  }
}

DI void phaseFinal(CPar& p) {
  const int tid = otid(), lane = tid & 63;
  const int gw = blockIdx.x * 4 + (tid >> 6), nw = gridDim.x * 4;
  for (int row = gw; row < MT; row += nw) {
    float* xr = p.out + (size_t)row * 1024;
    float4 v[4];
    float ss = 0.f;
    _Pragma("unroll") for (int i = 0; i < 4; ++i) {
      v[i] = ((const float4*)xr)[lane + 64 * i];
      ss += v[i].x * v[i].x + v[i].y * v[i].y + v[i].z * v[i].z + v[i].w * v[i].w;
    }
    ss = wave_sum(ss);
    const float rstd = rsqrtf(ss * (1.f / 1024.f) + EPSN);
    _Pragma("unroll") for (int i = 0; i < 4; ++i) {
      const float4 g = *(const float4*)(p.final_gain + 4 * (lane + 64 * i));
      ((float4*)xr)[lane + 64 * i] = make_float4(v[i].x * rstd * g.x, v[i].y * rstd * g.y, v[i].z * rstd * g.z, v[i].w * rstd * g.w);
    }
  }
}

__global__ void __launch_bounds__(256, 2) hybrid_megakernel(Params p_unused) {
  cg::grid_group grid = cg::this_grid();
  __shared__ __attribute__((aligned(16))) unsigned char smem[SMEM_BYTES];
  __shared__ uint4 xb_words;
  if (threadIdx.x == 0) xb_words = make_uint4(0u, 0u, 0u, 0u);
  __syncthreads();
  XcdBarrier xb = xcd_barrier_post(((unsigned*)(PP().ws + OFF_bar)), (volatile LAS unsigned*)&xb_words);
  phase0(PP(), smem);
  grid.sync();
  _Pragma("unroll 1") for (int l = 0; l < 2; ++l) {
    phaseA0(PP(), l);
    xcd_barrier(xb);
    phaseA1(PP(), l, smem);
    xcd_barrier(xb);
    r1_items(PP(), l, smem);
    xcd_barrier(xb);
    for (int rep = 0; rep < REP_B2; ++rep)
    for (int it = vblock(); it < 1024 + 1024 + 2048 + 256 + 512 + 4096; it += gridDim.x) {
      if (it < 1024) r2_item<false>(PP(), l, it);
      else if (it < 2048) { const int i = it - 1024; attn_item<false>(PP(), l, false, i >> 7, (i >> 6) & 1, i & 63, smem); }
      else if (it < 4096) { const int i = it - 2048; attn_item<true>(PP(), l, false, i >> 8, (i >> 6) & 3, i & 63, smem); }
      else if (it < 4352) { const int i = it - 4096; attn_item<false>(PP(), l, true, i >> 3, (i >> 2) & 1, i & 3, smem); }
      else if (it < 4864) { const int i = it - 4352; attn_item<true>(PP(), l, true, i >> 4, (i >> 2) & 3, i & 3, smem); }
      else r2_item<true>(PP(), l, it - 4864);
    }
    {
      unsigned* ctr = (unsigned*)(PP().ws + OFF_tctr) + l;
      volatile LAS unsigned* slot = (volatile LAS unsigned*)&xb_words + 2;
      for (;;) {
        __syncthreads();
        if (threadIdx.x == 0) *slot = __hip_atomic_fetch_add(ctr, 1u, __ATOMIC_RELAXED, __HIP_MEMORY_SCOPE_AGENT);
        __syncthreads();
        const int it = (int)*slot;
        if (it >= MT * 32 / 256) break;
        conv_item(PP(), l, it);
      }
    }
    xcd_barrier(xb);
    for (int it = vblock(); it < 1280; it += gridDim.x) r3_item(PP(), l, it, smem);
    xcd_barrier(xb);
    phaseC(PP(), l, smem);
    xcd_barrier(xb);
    phaseD(PP(), l, smem);
    xcd_barrier(xb);
  }
  phaseFinal(PP());
}

extern "C" void kernel_launch(void* const* d_in, const int* in_sizes, int n_in, void* d_out, int out_size, void* d_ws, size_t ws_size,
                              hipStream_t stream) {
  static int grid_blocks = 0;
  if (!grid_blocks) {
    int dev = 0, cus = 0, per_cu = 0;
    (void)hipGetDevice(&dev);
    (void)hipDeviceGetAttribute(&cus, hipDeviceAttributeMultiprocessorCount, dev);
    (void)hipOccupancyMaxActiveBlocksPerMultiprocessor(&per_cu, hybrid_megakernel, 256, 0);
    if (per_cu > 2) per_cu = 2;
    if (per_cu < 1) per_cu = 1;
    grid_blocks = cus * per_cu;
  }
  Params p{};
  const float** fin = (const float**)&p.x_prompt;
  for (int i = 0; i < 23; ++i) fin[i] = (const float*)d_in[i];
  p.out = (float*)d_out;
  p.ws = (unsigned char*)d_ws;
  const size_t off = WS_NEED;
  if (off > ws_size) { fprintf(stderr, "workspace too small: need %zu have %zu\n", off, ws_size); return; }
  (void)hipMemsetAsync(p.ws + OFF_bar, 0, XCD_BAR_WORDS * 4, stream);
  (void)hipMemsetAsync(p.ws + OFF_tctr, 0, 256, stream);
  void* args[] = {&p};
  hipError_t e = hipLaunchCooperativeKernel((void*)hybrid_megakernel, dim3(grid_blocks), dim3(256), args, 0, stream);
  if (e != hipSuccess) fprintf(stderr, "cooperative launch failed: %s (grid %d)\n", hipGetErrorString(e), grid_blocks);
}
```

```cpp
#include <hip/hip_runtime.h>
#include <hip/hip_bf16.h>
#include <hip/hip_cooperative_groups.h>
#include <cstdio>
namespace cg = cooperative_groups;

typedef unsigned short u16;
using bf16x8 = __attribute__((ext_vector_type(8))) short;
using f32x16 = __attribute__((ext_vector_type(16))) float;
using u32x4 = __attribute__((ext_vector_type(4))) unsigned;
using u32x2 = __attribute__((ext_vector_type(2))) unsigned;

#define DI __device__ __forceinline__
#define MFMA32(a, b, c) __builtin_amdgcn_mfma_f32_32x32x16_bf16((a), (b), (c), 0, 0, 0)

#ifndef REP_A1
#define REP_A1 1
#endif
#ifndef REP_B2
#define REP_B2 1
#endif
#ifndef PIPE_C
#define PIPE_C true
#endif
constexpr int DM = 1024;
constexpr int INW = 3840;
constexpr int MC = 8192;
constexpr int MT = 40960;
constexpr int NKL = 4608;
constexpr int LSTR = 72;
constexpr float EPSN = 1e-6f;
constexpr int SMEM_BYTES = 2 * 2 * 128 * LSTR * 2;

constexpr size_t OUT_GK = 41943040ull;
constexpr size_t OUT_GV = 44040192ull;
constexpr size_t OUT_DK = 46137344ull;
constexpr size_t OUT_DV = 50331648ull;
constexpr size_t OUT_ST = 54525952ull;

constexpr size_t OFF_WinT = 0ull;
constexpr size_t OFF_WgT = 15728640ull;
constexpr size_t OFF_WbT = 32505856ull;
constexpr size_t OFF_WoT = 36700160ull;
constexpr size_t OFF_mod = 40894464ull;
constexpr size_t OFF_rope = 41115648ull;
constexpr size_t OFF_H = 41123840ull;
constexpr size_t OFF_Z = 125009920ull;
constexpr size_t OFF_KG = 439582720ull;
constexpr size_t OFF_VtG = 449019904ull;
constexpr size_t OFF_KD = 458457088ull;
constexpr size_t OFF_VtD = 477331456ull;
constexpr size_t OFF_VtGc = 496205824ull;
constexpr size_t OFF_VtDc = 498302976ull;
constexpr size_t OFF_VtRc = 502497280ull;
constexpr size_t OFF_VtRl = 506691584ull;
constexpr size_t OFF_U = 523468800ull;
constexpr size_t OFF_SinT = 565411840ull;
constexpr size_t OFF_Y = 586383360ull;
constexpr size_t OFF_bar = 670269440ull;
constexpr size_t OFF_KtRc = 670283264ull;
constexpr size_t OFF_KtRl = 674477568ull;
constexpr size_t OFF_tctr = 691254784ull;
constexpr size_t WS_NEED = 691255040ull;
struct Params {
  const float *x_prompt, *x_sample, *cache_gk, *cache_gv, *cache_dk, *cache_dv, *state_ret, *c, *c_ctx, *w_ada, *b_ada,
      *norm_gain, *w_in, *conv_w, *q_gain, *k_gain, *ret_decay, *diff_lambda, *diff_gain, *w_branch, *w_mgate, *w_out, *final_gain;
  float* out;
  unsigned char* ws;
};

typedef float f32x2 __attribute__((ext_vector_type(2)));
typedef __bf16 bf16x2_t __attribute__((ext_vector_type(2)));
typedef const Params __attribute__((address_space(4))) CPar;
DI CPar& PP() { CPar* q = (CPar*)__builtin_amdgcn_kernarg_segment_ptr(); asm volatile("" : "+s"(q)); return *q; }
DI unsigned pack2(float a, float b) {
  const f32x2 v = {a, b};
  return __builtin_bit_cast(unsigned, __builtin_convertvector(v, bf16x2_t));
}
DI u16 f2bf(float a) { return (u16)(pack2(a, 0.f) & 0xffffu); }
DI float bflo(unsigned v) { return __uint_as_float(v << 16); }
DI float bfhi(unsigned v) { return __uint_as_float(v & 0xffff0000u); }
DI float silu_f(float x) { return x * __builtin_amdgcn_rcpf(1.f + __expf(-x)); }
DI float sigmoid_f(float x) { return __builtin_amdgcn_rcpf(1.f + __expf(-x)); }
DI f32x16 zero16() { f32x16 z; _Pragma("unroll") for (int i = 0; i < 16; ++i) z[i] = 0.f; return z; }
DI int otid() { int t = (int)__builtin_amdgcn_workitem_id_x(); asm volatile("" : "+v"(t)); return t; }
DI int vblock() { const int b = (int)blockIdx.x, g = (int)gridDim.x; return ((g & 7) == 0) ? (b & 7) * (g >> 3) + (b >> 3) : b; }
DI size_t tix(int r, int k, int ksl) { return ((size_t)((r >> 7) * ksl + (k >> 5)) << 12) + ((r & 127) << 5) + (k & 31); }
#define XB_TMO      128
#define XB_XCNT(j)  (256  + 64 * (j))
#define XB_XSUB(j)  (1280 + 64 * (j))
#define XB_XGEN(j)  (2304 + 64 * (j))
#define XB_TOP      3328
#define XB_TOPGEN   3392
#define XCD_BAR_WORDS 3456
#define XB_SPIN_CAP (1u << 18)
#define LAS __attribute__((address_space(3)))

__device__ __forceinline__ unsigned xb_ld(unsigned* p)              { return __hip_atomic_load(p, __ATOMIC_RELAXED, __HIP_MEMORY_SCOPE_AGENT); }
__device__ __forceinline__ unsigned xb_add(unsigned* p, unsigned v) { return __hip_atomic_fetch_add(p, v, __ATOMIC_RELAXED, __HIP_MEMORY_SCOPE_AGENT); }
__device__ __forceinline__ unsigned xb_xcc_id() { return (unsigned)__builtin_amdgcn_s_getreg((3 << 11) | 20) & 0xFu; }
#define XB_SPIN(cond, bar) do { unsigned _sp = 0; while (cond) { __builtin_amdgcn_s_sleep(1); \
    if ((++_sp & 255u) == 0u) { if (xb_ld(&(bar)[XB_TMO])) break; if (_sp > XB_SPIN_CAP) { atomicAdd(&(bar)[XB_TMO], 1u); break; } } } } while (0)

struct XcdBarrier {
    unsigned* bar; unsigned x;
    volatile LAS unsigned* st;
};

__device__ __forceinline__ XcdBarrier xcd_barrier_post(unsigned* bar, volatile LAS unsigned* st) {
    XcdBarrier b; b.bar = bar; b.x = xb_xcc_id(); b.st = st;
    if (threadIdx.x == 0) (void)xb_add(&bar[XB_XCNT(b.x)], 1u);
    return b;
}
__device__ __forceinline__ void xcd_barrier_complete(unsigned* bar, unsigned x, unsigned& nloc, unsigned& nx) {
    const unsigned G = gridDim.x * gridDim.y * gridDim.z;
    unsigned sum, cnt, mine, sp = 0u;
    for (;;) {
        sum = 0u; cnt = 0u; mine = 0u;
#pragma unroll
        for (unsigned j = 0; j < 16; ++j) { const unsigned c = xb_ld(&bar[XB_XCNT(j)]); sum += c; cnt += (c > 0u) ? 1u : 0u; mine = (j == x) ? c : mine; }
        if (sum == G) break;
        __builtin_amdgcn_s_sleep(1);
        if ((++sp & 255u) == 0u) { if (xb_ld(&bar[XB_TMO])) break; if (sp > XB_SPIN_CAP) { atomicAdd(&bar[XB_TMO], 1u); break; } }
    }
    nloc = mine > 0u ? mine : 1u; nx = cnt > 0u ? cnt : 1u;
}

__device__ __forceinline__ void xcd_barrier(const XcdBarrier& b) {
    asm volatile("s_waitcnt vmcnt(0)" ::: "memory");
    __syncthreads();
    if (threadIdx.x == 0) {
        unsigned* bar = b.bar;
        __builtin_amdgcn_s_waitcnt(0);
        unsigned nloc = b.st[0], nx = b.st[1];
        if (nloc == 0u) { xcd_barrier_complete(bar, b.x, nloc, nx); b.st[0] = nloc; b.st[1] = nx; }
        const unsigned old = xb_add(&bar[XB_XSUB(b.x)], 1u);
        const unsigned gen = old / nloc;
        if (old + 1u == (gen + 1u) * nloc) {
            __builtin_amdgcn_fence(__ATOMIC_RELEASE, "agent");
            asm volatile("s_waitcnt vmcnt(0)" ::: "memory");
            const unsigned og = xb_add(&bar[XB_TOP], 1u);
            const unsigned tg = og / nx;
            if (og + 1u == (tg + 1u) * nx) xb_add(&bar[XB_TOPGEN], 1u);
            else XB_SPIN(xb_ld(&bar[XB_TOPGEN]) == tg, bar);
            __builtin_amdgcn_fence(__ATOMIC_ACQUIRE, "agent");
            xb_add(&bar[XB_XGEN(b.x)], 1u);
            asm volatile("s_waitcnt vmcnt(0)" ::: "memory");
        } else {
            XB_SPIN(xb_ld(&bar[XB_XGEN(b.x)]) == gen, bar);
            __builtin_amdgcn_fence(__ATOMIC_ACQUIRE, "agent");
            asm volatile("s_waitcnt vmcnt(0)" ::: "memory");
        }
    }
    __syncthreads();
}


DI int kperm(int t) { return (t & ~12) | ((t & 4) << 1) | ((t & 8) >> 1); }
DI float xhalf_max(float x) {
  const auto r = __builtin_amdgcn_permlane32_swap(__float_as_uint(x), __float_as_uint(x), false, false);
  return fmaxf(__uint_as_float(r[0]), __uint_as_float(r[1]));
}
DI float xhalf_sum(float x) {
  const auto r = __builtin_amdgcn_permlane32_swap(__float_as_uint(x), __float_as_uint(x), false, false);
  return __uint_as_float(r[0]) + __uint_as_float(r[1]);
}
DI float wave_sum(float v) {
  _Pragma("unroll") for (int o = 1; o < 64; o <<= 1) v += __shfl_xor(v, o);
  return v;
}

#define VMWAIT(N) asm volatile("s_waitcnt vmcnt(" #N ")" ::: "memory")
#define RAW_BARRIER() do { asm volatile("s_waitcnt lgkmcnt(0)" ::: "memory"); __builtin_amdgcn_s_barrier(); } while (0)
template <int TB, bool BMAP = false, bool LEAN = false>
DI void gemm_acc(const u16* __restrict__ A, const u16* __restrict__ B, int bstride, int nk, f32x16 (&acc)[2][TB], u16* sm) {
  const int tid = otid(), lane = tid & 63, w = tid >> 6, wn = w >> 1, wt = w & 1, l31 = lane & 31, hf = lane >> 5;
  constexpr int NSTG = (TB == 2) ? 4 : 3;
  constexpr int RB = 64 * TB;
  constexpr int STGB = (128 + RB) * 64;
  constexpr int LPB = RB / 64;
  const int lr = tid >> 2, gsl = (tid & 3) ^ ((lr >> 2) & 3);
  const u16* ga = A + lr * 32 + gsl * 8;
  const u16* gb = B + lr * 32 + gsl * 8;
  char* smb = (char*)sm;
  const int wv = __builtin_amdgcn_readfirstlane(w);
  char* smw = smb + wv * 1024;
  const u16* pa[2];
  const u16* pb[LPB];
  _Pragma("unroll") for (int i = 0; i < 2; ++i) pa[i] = ga + 2048 * i;
  _Pragma("unroll") for (int i = 0; i < LPB; ++i) pb[i] = BMAP ? gb + (size_t)(i & 1) * bstride + 2048 * (i >> 1) : gb + (size_t)(i >> 1) * bstride + 2048 * (i & 1);
#define GEMM_STAGE(ST) do { \
    _Pragma("unroll") for (int i = 0; i < 2; ++i) { \
      __builtin_amdgcn_global_load_lds((const unsigned*)pa[i], (unsigned*)(smw + (ST) * STGB + i * 4096), 16, 0, 0); pa[i] += 4096; } \
    _Pragma("unroll") for (int i = 0; i < LPB; ++i) { \
      __builtin_amdgcn_global_load_lds((const unsigned*)pb[i], (unsigned*)(smw + (ST) * STGB + 8192 + i * 4096), 16, 0, 0); pb[i] += 4096; } \
  } while (0)
  VMWAIT(0);
  _Pragma("unroll") for (int s0 = 0; s0 < NSTG - 1; ++s0) GEMM_STAGE(s0);
  const int sw = (l31 >> 2) & 3;
  const int oa0 = (wn * 64 + l31) * 64 + ((hf ^ sw) << 4), oa1 = (wn * 64 + l31) * 64 + (((2 + hf) ^ sw) << 4);
  const int ob0 = 8192 + (wt * 32 * TB + l31) * 64 + ((hf ^ sw) << 4), ob1 = 8192 + (wt * 32 * TB + l31) * 64 + (((2 + hf) ^ sw) << 4);
  int st = 0, stn = NSTG - 1;
  bf16x8 dfa[2], dfb[TB];
  _Pragma("unroll") for (int a = 0; a < 2; ++a) dfa[a] = bf16x8{0, 0, 0, 0, 0, 0, 0, 0};
  _Pragma("unroll") for (int b = 0; b < TB; ++b) dfb[b] = bf16x8{0, 0, 0, 0, 0, 0, 0, 0};
  for (int kt = 0; kt < nk; ++kt) {
    if (kt + NSTG - 2 < nk) { if (TB == 2) VMWAIT(8); else VMWAIT(6); }
    else if (NSTG == 4 && kt + 1 < nk) VMWAIT(4);
    else VMWAIT(0);
    RAW_BARRIER();
    if (kt + NSTG - 1 < nk) GEMM_STAGE(stn);
    __builtin_amdgcn_sched_barrier(0);
    const char* sb = smb + st * STGB;
    if (!LEAN) {
      bf16x8 fa0[2], fb0[TB], fa1[2], fb1[TB];
      _Pragma("unroll") for (int a = 0; a < 2; ++a) fa0[a] = *(const bf16x8*)(sb + oa0 + a * 2048);
      _Pragma("unroll") for (int b = 0; b < TB; ++b) fb0[b] = *(const bf16x8*)(sb + ob0 + b * 2048);
      _Pragma("unroll") for (int a = 0; a < 2; ++a) fa1[a] = *(const bf16x8*)(sb + oa1 + a * 2048);
      _Pragma("unroll") for (int b = 0; b < TB; ++b) fb1[b] = *(const bf16x8*)(sb + ob1 + b * 2048);
      __builtin_amdgcn_sched_barrier(0);
      _Pragma("unroll") for (int a = 0; a < 2; ++a)
        _Pragma("unroll") for (int b = 0; b < TB; ++b) acc[a][b] = MFMA32(dfa[a], dfb[b], acc[a][b]);
      __builtin_amdgcn_sched_barrier(0);
      _Pragma("unroll") for (int a = 0; a < 2; ++a)
        _Pragma("unroll") for (int b = 0; b < TB; ++b) acc[a][b] = MFMA32(fa0[a], fb0[b], acc[a][b]);
      __builtin_amdgcn_sched_barrier(0);
      _Pragma("unroll") for (int a = 0; a < 2; ++a) dfa[a] = fa1[a];
      _Pragma("unroll") for (int b = 0; b < TB; ++b) dfb[b] = fb1[b];
    } else {
      _Pragma("unroll") for (int ks = 0; ks < 2; ++ks) {
        bf16x8 fa[2], fb[TB];
        _Pragma("unroll") for (int a = 0; a < 2; ++a) fa[a] = *(const bf16x8*)(sb + (ks ? oa1 : oa0) + a * 2048);
        _Pragma("unroll") for (int b = 0; b < TB; ++b) fb[b] = *(const bf16x8*)(sb + (ks ? ob1 : ob0) + b * 2048);
        __builtin_amdgcn_sched_barrier(0);
        _Pragma("unroll") for (int a = 0; a < 2; ++a)
          _Pragma("unroll") for (int b = 0; b < TB; ++b) acc[a][b] = MFMA32(fa[a], fb[b], acc[a][b]);
        __builtin_amdgcn_sched_barrier(0);
      }
    }
    st = (st + 1 == NSTG) ? 0 : st + 1;
    stn = (stn + 1 == NSTG) ? 0 : stn + 1;
  }
  if (!LEAN) {
    _Pragma("unroll") for (int a = 0; a < 2; ++a)
      _Pragma("unroll") for (int b = 0; b < TB; ++b) acc[a][b] = MFMA32(dfa[a], dfb[b], acc[a][b]);
  }
  RAW_BARRIER();
#undef GEMM_STAGE
}

DI void phase0(CPar& p, unsigned char* smem) {
  const int tid = otid();
  float* tile = (float*)smem;
  for (int job = blockIdx.x; job < 4992; job += gridDim.x) {
    const int l = job / 2496;
    int rem = job - l * 2496;
    const float* src; u16* dst; int C;
    if (rem < 960) { src = p.w_in + (size_t)l * 1024 * 3840; dst = ((u16*)(p.ws + OFF_WinT)) + (size_t)l * 3840 * 1024; C = 3840; }
    else if (rem < 1984) { rem -= 960; src = p.w_mgate + (size_t)l * 1024 * 4096; dst = ((u16*)(p.ws + OFF_WgT)) + (size_t)l * 4096 * 1024; C = 4096; }
    else if (rem < 2240) { rem -= 1984; src = p.w_branch + (size_t)l * 1024 * 1024; dst = ((u16*)(p.ws + OFF_WbT)) + (size_t)l * 1024 * 1024; C = 1024; }
    else { rem -= 2240; src = p.w_out + (size_t)l * 1024 * 1024; dst = ((u16*)(p.ws + OFF_WoT)) + (size_t)l * 1024 * 1024; C = 1024; }
    const int tr = rem & 15, tc = rem >> 4;
    const int r0 = tr * 64, c0 = tc * 64;
    __syncthreads();
    _Pragma("unroll") for (int i = 0; i < 4; ++i) {
      const int rr = (tid >> 4) + 16 * i, cc = (tid & 15) * 4;
      const float4 v = *(const float4*)(src + (size_t)(r0 + rr) * C + c0 + cc);
      tile[rr * 65 + cc + 0] = v.x; tile[rr * 65 + cc + 1] = v.y; tile[rr * 65 + cc + 2] = v.z; tile[rr * 65 + cc + 3] = v.w;
    }
    __syncthreads();
    {
      const int n = tid >> 2, kq = (tid & 3) * 16;
      unsigned wv[8];
      _Pragma("unroll") for (int j = 0; j < 8; ++j) wv[j] = pack2(tile[(kq + 2 * j) * 65 + n], tile[(kq + 2 * j + 1) * 65 + n]);
      u16* d = dst + tix(c0 + n, r0 + kq, 32);
      *(uint4*)d = make_uint4(wv[0], wv[1], wv[2], wv[3]);
      *(uint4*)(d + 8) = make_uint4(wv[4], wv[5], wv[6], wv[7]);
    }
  }
  __syncthreads();
  if (blockIdx.x < 384) {
  {
    float* sc = (float*)smem;
    float* red = sc + 9 * 1024;
    for (int i = tid; i < 9 * 1024; i += 256) {
      const int j = i >> 10, k = i & 1023;
      const float cv = (j == 0) ? p.c_ctx[k] : p.c[(j - 1) * 1024 + k];
      sc[i] = silu_f(cv);
    }
    __syncthreads();
    for (int item = blockIdx.x; item < 384; item += gridDim.x) {
    const int lane = tid & 63, w = tid >> 6;
    const int l = item / 192, n = (item % 192) * 16 + (lane & 15);
    const int kbeg = (w * 4 + (lane >> 4)) * 64;
    float acc[9];
    _Pragma("unroll") for (int j = 0; j < 9; ++j) acc[j] = 0.f;
    const float* wp = p.w_ada + (size_t)l * 1024 * 3072 + n;
    for (int k = kbeg; k < kbeg + 64; k += 8) {
      float wv[8];
      _Pragma("unroll") for (int u = 0; u < 8; ++u) wv[u] = wp[(size_t)(k + u) * 3072];
      _Pragma("unroll") for (int u = 0; u < 8; ++u)
        _Pragma("unroll") for (int j = 0; j < 9; ++j) acc[j] += sc[j * 1024 + k + u] * wv[u];
    }
    _Pragma("unroll") for (int j = 0; j < 9; ++j) {
      acc[j] += __shfl_xor(acc[j], 16);
      acc[j] += __shfl_xor(acc[j], 32);
    }
    if (lane < 16) {
      _Pragma("unroll") for (int j = 0; j < 9; ++j) red[(w * 9 + j) * 16 + lane] = acc[j];
    }
    __syncthreads();
    if (tid < 144) {
      const int j = tid >> 4, nn = tid & 15;
      const int n2 = (item % 192) * 16 + nn;
      const float v = red[(0 * 9 + j) * 16 + nn] + red[(1 * 9 + j) * 16 + nn] + red[(2 * 9 + j) * 16 + nn] + red[(3 * 9 + j) * 16 + nn];
      ((float*)(p.ws + OFF_mod))[(l * 9 + j) * 3072 + n2] = v + p.b_ada[l * 3072 + n2];
    }
    __syncthreads();
    }
  }
  }
  if (blockIdx.x == gridDim.x - 1) {
    for (int i = tid; i < 1024; i += 256) {
      const int pos = i >> 4, f = i & 15;
      const float inv = powf(10000.f, -(float)f / 16.f);
      const float ang = (float)pos * inv;
      ((float*)(p.ws + OFF_rope))[2 * i] = cosf(ang);
      ((float*)(p.ws + OFF_rope))[2 * i + 1] = sinf(ang);
    }
  }
}

DI void phaseA0(CPar& p, int l) {
  const int tid = otid(), lane = tid & 63;
  const int gw = blockIdx.x * 4 + (tid >> 6), nw = gridDim.x * 4;
  const float* ng = p.norm_gain + l * 1024;
  for (int row = gw; row < MT; row += nw) {
    const float* xr = (l == 0) ? (row < MC ? p.x_prompt + (size_t)row * 1024 : p.x_sample + (size_t)(row - MC) * 1024)
                               : p.out + (size_t)row * 1024;
    float4 v[4];
    float ss = 0.f;
    _Pragma("unroll") for (int i = 0; i < 4; ++i) {
      v[i] = ((const float4*)xr)[lane + 64 * i];
      ss += v[i].x * v[i].x + v[i].y * v[i].y + v[i].z * v[i].z + v[i].w * v[i].w;
    }
    ss = wave_sum(ss);
    const float rstd = rsqrtf(ss * (1.f / 1024.f) + EPSN);
    const int j = row < MC ? 0 : 1 + ((row - MC) >> 12);
    const float* shift = ((float*)(p.ws + OFF_mod)) + (l * 9 + j) * 3072;
    const float* scale = shift + 1024;
    _Pragma("unroll") for (int i = 0; i < 4; ++i) {
      const int k = 4 * (lane + 64 * i);
      const float4 g = *(const float4*)(ng + k);
      const float4 s = *(const float4*)(scale + k);
      const float4 sh = *(const float4*)(shift + k);
      const float h0 = v[i].x * rstd * g.x * (1.f + s.x) + sh.x;
      const float h1 = v[i].y * rstd * g.y * (1.f + s.y) + sh.y;
      const float h2 = v[i].z * rstd * g.z * (1.f + s.z) + sh.z;
      const float h3 = v[i].w * rstd * g.w * (1.f + s.w) + sh.w;
      *(uint2*)(((u16*)(p.ws + OFF_H)) + tix(row, k, 32)) = make_uint2(pack2(h0, h1), pack2(h2, h3));
    }
  }
  const int gt = blockIdx.x * 256 + tid, nt = gridDim.x * 256;
  for (int idx = gt; idx < 8 * 65536; idx += nt) {
    const int b = idx >> 16, rem = idx & 65535;
    ((u16*)(p.ws + OFF_KG))[(size_t)b * NKL * 128 + rem] = f2bf(p.cache_gk[(size_t)(b * 2 + l) * 65536 + rem]);
  }
  for (int idx = gt; idx < 8 * 131072; idx += nt) {
    const int b = idx >> 17, rem = idx & 131071;
    ((u16*)(p.ws + OFF_KD))[(size_t)b * NKL * 256 + rem] = f2bf(p.cache_dk[(size_t)(b * 2 + l) * 131072 + rem]);
  }
  for (int idx = gt; idx < 8 * 2 * 64 * 512; idx += nt) {
    const int pk = idx & 511, dv = (idx >> 9) & 63, g = (idx >> 15) & 1, b = idx >> 16;
    ((u16*)(p.ws + OFF_VtG))[((size_t)(b * 2 + g) * 64 + dv) * NKL + kperm(pk)] = f2bf(p.cache_gv[((size_t)(b * 2 + l) * 512 + pk) * 128 + g * 64 + dv]);
  }
  for (int idx = gt; idx < 8 * 4 * 64 * 512; idx += nt) {
    const int pk = idx & 511, dv = (idx >> 9) & 63, h = (idx >> 15) & 3, b = idx >> 17;
    ((u16*)(p.ws + OFF_VtD))[((size_t)(b * 4 + h) * 64 + dv) * NKL + kperm(pk)] = f2bf(p.cache_dv[((size_t)(b * 2 + l) * 512 + pk) * 256 + h * 64 + dv]);
  }
}

#define NLOC(a, r) ((a) * 32 + 8 * ((r) >> 2) + 4 * hf + ((r) & 3))

template <int NB>
DI void a1_epilogue(CPar& p, int l, int nbase, int m0w, f32x16 (&acc)[2][NB], unsigned char* smem) {
  const int lane = otid() & 63, l31 = lane & 31, hf = lane >> 5;
  u16* stg = (u16*)smem + (otid() >> 6) * (32 * 72);
  _Pragma("unroll") for (int b = 0; b < NB; ++b) {
    const int m = m0w + b * 32 + l31;
    const bool ctx = m < MC;
    int bb, t;
    if (ctx) { bb = m >> 8; t = m & 255; } else { const int ml = m - MC; bb = ml >> 12; t = ml & 4095; }
    float v[2][16];
    _Pragma("unroll") for (int a = 0; a < 2; ++a)
      _Pragma("unroll") for (int r = 0; r < 16; ++r) v[a][r] = acc[a][b][r];

    auto rmsn = [&](const float* gain) {
      float ss = 0.f;
      _Pragma("unroll") for (int a = 0; a < 2; ++a)
        _Pragma("unroll") for (int r = 0; r < 16; ++r) ss += v[a][r] * v[a][r];
      ss = xhalf_sum(ss);
      const float rinv = rsqrtf(ss * (1.f / 64.f) + EPSN);
      _Pragma("unroll") for (int a = 0; a < 2; ++a)
        _Pragma("unroll") for (int i = 0; i < 4; ++i) {
          const float4 g = *(const float4*)(gain + a * 32 + 8 * i + 4 * hf);
          v[a][4 * i + 0] *= rinv * g.x; v[a][4 * i + 1] *= rinv * g.y; v[a][4 * i + 2] *= rinv * g.z; v[a][4 * i + 3] *= rinv * g.w;
        }
    };
    auto rope64 = [&]() {
      const int trow = t >> 6, tcol = t & 63;
      const float2* rp = (const float2*)((float*)(p.ws + OFF_rope));
      _Pragma("unroll") for (int r = 0; r < 16; ++r) {
        const int j = 8 * (r >> 2) + 4 * hf + (r & 3);
        const int pos = ((r >> 2) < 2) ? trow : tcol;
        const float2 cs = rp[pos * 16 + (j & 15)];
        const float x1 = v[0][r], x2 = v[1][r];
        v[0][r] = x1 * cs.x - x2 * cs.y;
        v[1][r] = x1 * cs.y + x2 * cs.x;
      }
    };
    auto rope32 = [&]() {
      const int trow = t >> 6, tcol = t & 63;
      const float2* rp = (const float2*)((float*)(p.ws + OFF_rope));
      _Pragma("unroll") for (int a = 0; a < 2; ++a)
        _Pragma("unroll") for (int r = 0; r < 8; ++r) {
          const int j = 8 * (r >> 2) + 4 * hf + (r & 3);
          const int pos = ((r >> 2) == 0) ? trow : tcol;
          const float2 cs = rp[pos * 16 + 2 * (j & 7)];
          const float x1 = v[a][r], x2 = v[a][r + 8];
          v[a][r] = x1 * cs.x - x2 * cs.y;
          v[a][r + 8] = x1 * cs.y + x2 * cs.x;
        }
    };
    auto store_nat = [&](u16* dst, int stride) {
      _Pragma("unroll") for (int a = 0; a < 2; ++a)
        _Pragma("unroll") for (int i = 0; i < 4; ++i)
          *(uint2*)(stg + l31 * 72 + a * 32 + 8 * i + 4 * hf) = make_uint2(pack2(v[a][4 * i], v[a][4 * i + 1]), pack2(v[a][4 * i + 2], v[a][4 * i + 3]));
      u16* rp = dst + ((lane >> 3) - l31) * stride + (lane & 7) * 8;
      _Pragma("unroll") for (int j = 0; j < 4; ++j) {
        const uint4 val = *(const uint4*)(stg + ((lane >> 3) + 8 * j) * 72 + (lane & 7) * 8);
        *(uint4*)(rp + (size_t)(8 * j) * stride) = val;
      }
    };
    auto store_f32 = [&](float* dst) {
      _Pragma("unroll") for (int a = 0; a < 2; ++a)
        _Pragma("unroll") for (int i = 0; i < 4; ++i)
          *(float4*)(dst + a * 32 + 8 * i + 4 * hf) = make_float4(v[a][4 * i], v[a][4 * i + 1], v[a][4 * i + 2], v[a][4 * i + 3]);
    };
    auto store_T = [&](u16* dst, int ld) {
      _Pragma("unroll") for (int a = 0; a < 2; ++a)
        _Pragma("unroll") for (int r = 0; r < 16; ++r) dst[(size_t)NLOC(a, r) * ld] = f2bf(v[a][r]);
    };

    u16* zrow = ((u16*)(p.ws + OFF_Z)) + (size_t)m * INW + nbase;
    if (nbase < 1024) {
      store_nat(zrow, INW);
    } else if (nbase < 1280) {
      rmsn(p.q_gain + l * 64);
      if (!ctx) rope64();
      store_nat(zrow, INW);
    } else if (nbase < 1408) {
      const int kvh = (nbase - 1280) >> 6;
      rmsn(p.k_gain + l * 64);
      if (ctx) {
        store_f32(p.out + OUT_GK + ((size_t)(bb * 2 + l) * 256 + t) * 128 + kvh * 64);
        store_nat(zrow, INW);
      } else {
        rope64();
        store_nat(((u16*)(p.ws + OFF_KG)) + ((size_t)bb * NKL + 512 + t) * 128 + kvh * 64, 128);
      }
    } else if (nbase < 1536) {
      const int kvh = (nbase - 1408) >> 6;
      if (ctx) {
        store_f32(p.out + OUT_GV + ((size_t)(bb * 2 + l) * 256 + t) * 128 + kvh * 64);
        store_T(((u16*)(p.ws + OFF_VtGc)) + ((size_t)(bb * 2 + kvh) * 64) * 256 + kperm(t), 256);
      } else {
        store_T(((u16*)(p.ws + OFF_VtG)) + ((size_t)(bb * 2 + kvh) * 64) * NKL + 512 + kperm(t), NKL);
      }
    } else if (nbase < 2048) {
      store_nat(zrow, INW);
    } else if (nbase < 2304) {
      const int hh = (nbase - 2048) >> 6;
      _Pragma("unroll") for (int a = 0; a < 2; ++a)
        _Pragma("unroll") for (int r = 0; r < 16; ++r) v[a][r] *= 0.125f;
      store_nat(zrow, INW);
      if (ctx) store_T(((u16*)(p.ws + OFF_KtRc)) + ((size_t)(bb * 4 + hh) * 64) * 256 + kperm(t), 256);
      else store_T(((u16*)(p.ws + OFF_KtRl)) + ((size_t)(bb * 4 + hh) * 64) * 4096 + kperm(t), 4096);
    } else if (nbase < 2560) {
      const int hh = (nbase - 2304) >> 6;
      store_nat(zrow, INW);
      if (ctx) store_T(((u16*)(p.ws + OFF_VtRc)) + ((size_t)(bb * 4 + hh) * 64) * 256 + kperm(t), 256);
      else store_T(((u16*)(p.ws + OFF_VtRl)) + ((size_t)(bb * 4 + hh) * 64) * 4096 + kperm(t), 4096);
    } else if (nbase < 2816) {
      store_nat(zrow, INW);
    } else if (nbase < 3072) {
      if (!ctx) rope32();
      store_nat(zrow, INW);
    } else if (nbase < 3328) {
      const int cb = nbase - 3072;
      if (ctx) {
        store_f32(p.out + OUT_DK + ((size_t)(bb * 2 + l) * 256 + t) * 256 + cb);
        store_nat(zrow, INW);
      } else {
        rope32();
        store_nat(((u16*)(p.ws + OFF_KD)) + ((size_t)bb * NKL + 512 + t) * 256 + cb, 256);
      }
    } else if (nbase < 3584) {
      const int cb = nbase - 3328, hh = cb >> 6;
      if (ctx) {
        store_f32(p.out + OUT_DV + ((size_t)(bb * 2 + l) * 256 + t) * 256 + cb);
        store_T(((u16*)(p.ws + OFF_VtDc)) + ((size_t)(bb * 4 + hh) * 64) * 256 + kperm(t), 256);
      } else {
        store_T(((u16*)(p.ws + OFF_VtD)) + ((size_t)(bb * 4 + hh) * 64) * NKL + 512 + kperm(t), NKL);
      }
    } else {
      store_nat(zrow, INW);
    }
  }
}

DI void phaseA1(CPar& p, int l, unsigned char* smem) {
  const int w = otid() >> 6, wn = w >> 1, wt = w & 1;
  for (int tile = vblock(); tile < 30 * 160; tile += gridDim.x) {
    const int grp = tile / 800, rem = tile - grp * 800;
    const int tm = rem / 5, tn = grp * 5 + (rem - tm * 5);
    f32x16 acc[2][4];
    _Pragma("unroll") for (int a = 0; a < 2; ++a)
      _Pragma("unroll") for (int b = 0; b < 4; ++b) acc[a][b] = zero16();
    gemm_acc<4>(((u16*)(p.ws + OFF_WinT)) + (size_t)l * 3840 * 1024 + ((size_t)(tn * 32) << 12), ((u16*)(p.ws + OFF_H)) + ((size_t)(tm * 2 * 32) << 12), 32 * 4096, 32, acc, (u16*)smem);
    a1_epilogue<4>(p, l, tn * 128 + wn * 64, tm * 256 + wt * 128, acc, smem);
    __syncthreads();
  }
}

DI void ld8(const u16* ptr, float (&f)[8]) {
  const uint4 v = *(const uint4*)ptr;
  f[0] = bflo(v.x); f[1] = bfhi(v.x); f[2] = bflo(v.y); f[3] = bfhi(v.y);
  f[4] = bflo(v.z); f[5] = bfhi(v.z); f[6] = bflo(v.w); f[7] = bfhi(v.w);
}

DI void conv_item(CPar& p, int l, int item) {
  const int gt = item * 256 + otid(), nt = MT * 32;
  const float* cw = p.conv_w + l * 768;
  for (int idx = gt; idx < MT * 32; idx += nt) {
    const int m = idx >> 5, c8 = (idx & 31) * 8;
    int t, T;
    if (m < MC) { t = m & 255; T = 256; } else { t = (m - MC) & 4095; T = 4096; }
    const u16* zr = ((u16*)(p.ws + OFF_Z)) + (size_t)m * INW + c8;
    float bg[8], gt8[8], cgc[8], uc[8], gp[8], gn[8];
    ld8(zr, bg); ld8(zr + 768, gt8); ld8(zr + 256, cgc); ld8(zr + 512, uc);
    if (t > 0) { float a[8], b[8]; ld8(zr - INW + 256, a); ld8(zr - INW + 512, b); _Pragma("unroll") for (int i = 0; i < 8; ++i) gp[i] = a[i] * b[i]; }
    else { _Pragma("unroll") for (int i = 0; i < 8; ++i) gp[i] = 0.f; }
    if (t < T - 1) { float a[8], b[8]; ld8(zr + INW + 256, a); ld8(zr + INW + 512, b); _Pragma("unroll") for (int i = 0; i < 8; ++i) gn[i] = a[i] * b[i]; }
    else { _Pragma("unroll") for (int i = 0; i < 8; ++i) gn[i] = 0.f; }
    float y[8];
    _Pragma("unroll") for (int i = 0; i < 8; ++i) {
      const float w0 = cw[c8 + i], w1 = cw[256 + c8 + i], w2 = cw[512 + c8 + i];
      const float g = cgc[i] * uc[i];
      y[i] = bg[i] * (w0 * gp[i] + w1 * g + w2 * gn[i]) * silu_f(gt8[i]);
    }
    *(uint4*)(((u16*)(p.ws + OFF_Y)) + tix(m, c8, 32)) = make_uint4(pack2(y[0], y[1]), pack2(y[2], y[3]), pack2(y[4], y[5]), pack2(y[6], y[7]));
  }
}

DI float log_gamma(CPar& p, int l, int dir, int h) {
  const float x = p.ret_decay[(l * 2 + dir) * 4 + h];
  return -log1pf(expf(-x));
}

DI void ret_decode(int item, bool& ctx, int& bb, int& h, int& c, int& m0) {
  if (item < 256) { ctx = true; c = item & 1; h = (item >> 1) & 3; bb = item >> 3; m0 = bb * 256 + c * 128; }
  else { const int it = item - 256; ctx = false; c = it & 31; h = (it >> 5) & 3; bb = it >> 7; m0 = MC + bb * 4096 + c * 128; }
}

DI void r1_items(CPar& p, int l, unsigned char* smem) {
  const int tid = otid(), lane = tid & 63, w = tid >> 6, l31 = lane & 31, hf = lane >> 5;
  const int ti = w >> 1, tj = w & 1;
  const float LOG2E = 1.4426950408889634f;
  for (int item = blockIdx.x; item < 1280; item += gridDim.x) {
    bool ctx; int bb, h, c, m0;
    ret_decode(item, ctx, bb, h, c, m0);
    const float lf2 = log_gamma(p, l, 0, h) * LOG2E, lb2 = log_gamma(p, l, 1, h) * LOG2E;
    const int ld = ctx ? 256 : 4096;
    const size_t hb = ctx ? ((size_t)(bb * 4 + h) * 64) * 256 + c * 128 : ((size_t)(bb * 4 + h) * 64) * 4096 + c * 128;
    const u16* Kt = (ctx ? (const u16*)(p.ws + OFF_KtRc) : (const u16*)(p.ws + OFF_KtRl)) + hb + (size_t)(ti * 32 + l31) * ld + 8 * hf;
    const u16* Vt = (ctx ? (const u16*)(p.ws + OFF_VtRc) : (const u16*)(p.ws + OFF_VtRl)) + hb + (size_t)(tj * 32 + l31) * ld + 8 * hf;
    f32x16 Uf = zero16(), Ub = zero16();
    _Pragma("unroll") for (int s8 = 0; s8 < 8; ++s8) {
      const bf16x8 af = *(const bf16x8*)(Kt + 16 * s8);
      const u32x4 bv = *(const u32x4*)(Vt + 16 * s8);
      u32x4 bfw, bbw;
      _Pragma("unroll") for (int q = 0; q < 4; ++q) {
        const int j0 = 16 * s8 + 8 * ((2 * q) >> 2) + 4 * hf + ((2 * q) & 3);
        const float v0 = bflo(bv[q]), v1 = bfhi(bv[q]);
        const float wf0 = __builtin_amdgcn_exp2f(lf2 * (float)(127 - j0)), wf1 = __builtin_amdgcn_exp2f(lf2 * (float)(126 - j0));
        const float wb0 = __builtin_amdgcn_exp2f(lb2 * (float)j0), wb1 = __builtin_amdgcn_exp2f(lb2 * (float)(j0 + 1));
        bfw[q] = pack2(v0 * wf0, v1 * wf1);
        bbw[q] = pack2(v0 * wb0, v1 * wb1);
      }
      Uf = MFMA32(af, __builtin_bit_cast(bf16x8, bfw), Uf);
      Ub = MFMA32(af, __builtin_bit_cast(bf16x8, bbw), Ub);
    }
    float* uo = ((float*)(p.ws + OFF_U)) + (size_t)item * 2 * 4096 + tj * 32 + l31;
    _Pragma("unroll") for (int r = 0; r < 16; ++r) {
      const int dk = ti * 32 + 8 * (r >> 2) + 4 * hf + (r & 3);
      uo[dk * 64] = Uf[r];
      uo[4096 + dk * 64] = Ub[r];
    }
  }
}

template <bool CTX>
DI void r2_item(CPar& p, int l, int bi) {
  const int tid = otid();
  const int eb = bi & 15, dir = (bi >> 4) & 1, h = (bi >> 5) & 3, bb = bi >> 7;
  const int ep = eb * 256 + tid;
  const int dv = ep >> 6, dk = ep & 63;
  const int e = dk * 64 + dv;
  constexpr int nch = CTX ? 2 : 32;
  const int base = CTX ? (bb * 4 + h) * 2 : 256 + (bb * 4 + h) * 32;
  const float gC = expf(log_gamma(p, l, dir, h) * 128.f);
  float S = CTX ? 0.f : p.state_ret[((((size_t)bb * 2 + l) * 2 + dir) * 4 + h) * 4096 + e];
  float u[nch];
  _Pragma("unroll") for (int i = 0; i < nch; ++i) {
    const int c = dir ? (nch - 1 - i) : i;
    u[i] = ((float*)(p.ws + OFF_U))[((size_t)(base + c) * 2 + dir) * 4096 + e];
  }
  _Pragma("unroll") for (int i = 0; i < nch; ++i) {
    const int c = dir ? (nch - 1 - i) : i;
    ((u16*)(p.ws + OFF_SinT))[((size_t)(base + c) * 2 + dir) * 4096 + ep] = f2bf(S);
    S = S * gC + u[i];
  }
  if (CTX) p.out[OUT_ST + ((((size_t)bb * 2 + l) * 2 + dir) * 4 + h) * 4096 + e] = S;
}

template <bool DIFF>
DI void attn_item(CPar& p, int l, bool ctx, int bb, int unit, int qb, unsigned char* smem) {
  const int tid = otid(), lane = tid & 63, w = tid >> 6, l31 = lane & 31, hf = lane >> 5;
  const int qi = w & 1, qs = w >> 1;
  const int mq = (ctx ? bb * 256 : MC + bb * 4096) + qb * 64 + qs * 32 + l31;
  const int nkeys = ctx ? 256 : NKL;
  const u16* Kp; const u16* Vt; int ldk, ldv;
  if (!DIFF) {
    if (ctx) { Kp = ((u16*)(p.ws + OFF_Z)) + (size_t)(bb * 256) * INW + 1280 + unit * 64; ldk = INW; Vt = ((u16*)(p.ws + OFF_VtGc)) + ((size_t)(bb * 2 + unit) * 64) * 256; ldv = 256; }
    else { Kp = ((u16*)(p.ws + OFF_KG)) + (size_t)bb * NKL * 128 + unit * 64; ldk = 128; Vt = ((u16*)(p.ws + OFF_VtG)) + ((size_t)(bb * 2 + unit) * 64) * NKL; ldv = NKL; }
  } else {
    if (ctx) { Kp = ((u16*)(p.ws + OFF_Z)) + (size_t)(bb * 256) * INW + 3072 + unit * 64; ldk = INW; Vt = ((u16*)(p.ws + OFF_VtDc)) + ((size_t)(bb * 4 + unit) * 64) * 256; ldv = 256; }
    else { Kp = ((u16*)(p.ws + OFF_KD)) + (size_t)bb * NKL * 256 + unit * 64; ldk = 256; Vt = ((u16*)(p.ws + OFF_VtD)) + ((size_t)(bb * 4 + unit) * 64) * NKL; ldv = NKL; }
  }
  constexpr int NS = DIFF ? 2 : 4;
  bf16x8 qf[NS];
  {
    const u16* zq = ((u16*)(p.ws + OFF_Z)) + (size_t)mq * INW + (DIFF ? 2816 + unit * 64 + qi * 32 : 1024 + (unit * 2 + qi) * 64) + hf * 8;
    _Pragma("unroll") for (int s = 0; s < NS; ++s) qf[s] = *(const bf16x8*)(zq + s * 16);
  }
  const float sc = (DIFF ? 0.17677669529663687f : 0.125f) * 1.4426950408889634f;
  f32x16 O[2];
  O[0] = zero16(); O[1] = zero16();
  float mref = -1e30f, lsum = 0.f;

  char* smb = (char*)smem;
  constexpr int STGB = 16384;
  const int lr = tid >> 3, gch = (tid & 7) ^ ((lr >> 1) & 7);
  const u16* gk = Kp + (size_t)lr * ldk + gch * 8;
  const u16* gv = Vt + (size_t)lr * ldv + gch * 8;
  const int wv = __builtin_amdgcn_readfirstlane(w);
  char* smw = smb + wv * 1024;
  const u16* pk0 = gk; const u16* pk1 = gk + (size_t)32 * ldk;
  const u16* pv0 = gv; const u16* pv1 = gv + (size_t)32 * ldv;
  const size_t kstep = (size_t)64 * ldk;
#define ATT_STAGE(ST) do { \
    __builtin_amdgcn_global_load_lds((const unsigned*)pk0, (unsigned*)(smw + (ST) * STGB), 16, 0, 0); pk0 += kstep; \
    __builtin_amdgcn_global_load_lds((const unsigned*)pk1, (unsigned*)(smw + (ST) * STGB + 4096), 16, 0, 0); pk1 += kstep; \
    __builtin_amdgcn_global_load_lds((const unsigned*)pv0, (unsigned*)(smw + (ST) * STGB + 8192), 16, 0, 0); pv0 += 64; \
    __builtin_amdgcn_global_load_lds((const unsigned*)pv1, (unsigned*)(smw + (ST) * STGB + 8192 + 4096), 16, 0, 0); pv1 += 64; \
  } while (0)
  const int nt = nkeys >> 6;
  __syncthreads();
  VMWAIT(0);
  ATT_STAGE(0); ATT_STAGE(1);
  const int sw = (l31 >> 1) & 7;
  const int kq0 = DIFF ? qi * 4 : 0;
  const f32x16 zc = {0.f, 0.f, 0.f, 0.f, 0.f, 0.f, 0.f, 0.f, 0.f, 0.f, 0.f, 0.f, 0.f, 0.f, 0.f, 0.f};
  auto softmax_pv = [&](f32x16 (&S)[2], const char* sV) {
    bf16x8 vfr[2][4];
    _Pragma("unroll") for (int a = 0; a < 2; ++a)
      _Pragma("unroll") for (int s2 = 0; s2 < 4; ++s2)
        vfr[a][s2] = *(const bf16x8*)(sV + (a * 32 + l31) * 128 + (((2 * s2 + hf) ^ sw) << 4));
    const f32x2 sc2 = {sc, sc};
    bf16x8 pf[4];
    f32x2 ps2 = {0.f, 0.f};
    {
      const f32x2 nm2 = {-mref, -mref};
      _Pragma("unroll") for (int k2 = 0; k2 < 2; ++k2)
        _Pragma("unroll") for (int u = 0; u < 2; ++u) {
          u32x4 pk;
          _Pragma("unroll") for (int j = 0; j < 4; ++j) {
            f32x2 v = {S[k2][8 * u + 2 * j], S[k2][8 * u + 2 * j + 1]};
            v = v * sc2 + nm2;
            f32x2 e;
            e.x = __builtin_amdgcn_exp2f(v.x);
            e.y = __builtin_amdgcn_exp2f(v.y);
            ps2 += e;
            pk[j] = pack2(e.x, e.y);
          }
          pf[2 * k2 + u] = __builtin_bit_cast(bf16x8, pk);
        }
    }
    float ps = ps2.x + ps2.y;
    if (__builtin_amdgcn_ballot_w64(!(ps < 1048576.f)) != 0ull) {
      float mx = S[0][0];
      _Pragma("unroll") for (int k2 = 0; k2 < 2; ++k2)
        _Pragma("unroll") for (int r = 0; r < 16; ++r) mx = fmaxf(mx, S[k2][r]);
      mx = xhalf_max(mx);
      const float mnew = fmaxf(mref, mx * sc);
      const float alpha = __builtin_amdgcn_exp2f(mref - mnew);
      mref = mnew;
      lsum *= alpha;
      _Pragma("unroll") for (int a = 0; a < 2; ++a)
        _Pragma("unroll") for (int r = 0; r < 16; ++r) O[a][r] *= alpha;
      const f32x2 nm2 = {-mref, -mref};
      ps2 = f32x2{0.f, 0.f};
      _Pragma("unroll") for (int k2 = 0; k2 < 2; ++k2)
        _Pragma("unroll") for (int u = 0; u < 2; ++u) {
          u32x4 pk;
          _Pragma("unroll") for (int j = 0; j < 4; ++j) {
            f32x2 v = {S[k2][8 * u + 2 * j], S[k2][8 * u + 2 * j + 1]};
            v = v * sc2 + nm2;
            f32x2 e;
            e.x = __builtin_amdgcn_exp2f(v.x);
            e.y = __builtin_amdgcn_exp2f(v.y);
            ps2 += e;
            pk[j] = pack2(e.x, e.y);
          }
          pf[2 * k2 + u] = __builtin_bit_cast(bf16x8, pk);
        }
      ps = ps2.x + ps2.y;
    }
    lsum += ps;
    _Pragma("unroll") for (int a = 0; a < 2; ++a)
      _Pragma("unroll") for (int s2 = 0; s2 < 4; ++s2) O[a] = MFMA32(vfr[a][s2], pf[s2], O[a]);
  };
  for (int kt2 = 0; kt2 < nt; kt2 += 2) {
    VMWAIT(0);
    RAW_BARRIER();
    if (kt2 + 2 < nt) { ATT_STAGE((kt2 + 2) & 3); ATT_STAGE((kt2 + 3) & 3); }
    __builtin_amdgcn_sched_barrier(0);
    const char* sK0 = smb + (kt2 & 3) * STGB;
    const char* sK1 = smb + ((kt2 + 1) & 3) * STGB;
    f32x16 S0[2], S1[2];
    {
      bf16x8 kfa[NS][2], kfb[NS][2];
      _Pragma("unroll") for (int s = 0; s < NS; ++s)
        _Pragma("unroll") for (int k2 = 0; k2 < 2; ++k2)
          kfa[s][k2] = *(const bf16x8*)(sK0 + (k2 * 32 + l31) * 128 + (((kq0 + 2 * s + hf) ^ sw) << 4));
      _Pragma("unroll") for (int s = 0; s < NS; ++s)
        _Pragma("unroll") for (int k2 = 0; k2 < 2; ++k2)
          kfb[s][k2] = *(const bf16x8*)(sK1 + (k2 * 32 + l31) * 128 + (((kq0 + 2 * s + hf) ^ sw) << 4));
      __builtin_amdgcn_sched_barrier(0);
      _Pragma("unroll") for (int s = 0; s < NS; ++s)
        _Pragma("unroll") for (int k2 = 0; k2 < 2; ++k2)
          S0[k2] = MFMA32(kfa[s][k2], qf[s], s == 0 ? zc : S0[k2]);
      _Pragma("unroll") for (int s = 0; s < NS; ++s)
        _Pragma("unroll") for (int k2 = 0; k2 < 2; ++k2)
          S1[k2] = MFMA32(kfb[s][k2], qf[s], s == 0 ? zc : S1[k2]);
    }
    softmax_pv(S0, sK0 + 8192);
    softmax_pv(S1, sK1 + 8192);
  }
  RAW_BARRIER();
#undef ATT_STAGE
  const float inv = __builtin_amdgcn_rcpf(xhalf_sum(lsum));
  const u16* zg = ((u16*)(p.ws + OFF_Z)) + (size_t)mq * INW;
  if (!DIFF) {
    _Pragma("unroll") for (int a = 0; a < 2; ++a)
      _Pragma("unroll") for (int i = 0; i < 4; ++i) {
        const int col = (unit * 2 + qi) * 64 + a * 32 + 8 * i + 4 * hf;
        const uint2 gv2 = *(const uint2*)(zg + 1536 + col);
        const float y0 = O[a][4 * i + 0] * inv * silu_f(bflo(gv2.x));
        const float y1 = O[a][4 * i + 1] * inv * silu_f(bfhi(gv2.x));
        const float y2 = O[a][4 * i + 2] * inv * silu_f(bflo(gv2.y));
        const float y3 = O[a][4 * i + 3] * inv * silu_f(bfhi(gv2.y));
        *(uint2*)(((u16*)(p.ws + OFF_Y)) + tix(mq, 256 + col, 32)) = make_uint2(pack2(y0, y1), pack2(y2, y3));
      }
  } else {
    float* xb = (float*)smem + qs * 32 * 64;
    if (qi == 1) {
      _Pragma("unroll") for (int a = 0; a < 2; ++a)
        _Pragma("unroll") for (int r = 0; r < 16; ++r) xb[(a * 16 + r) * 64 + lane] = O[a][r] * inv;
    }
    __syncthreads();
    if (qi == 0) {
      const float* lp = p.diff_lambda + l * 128;
      float d1 = 0.f, d2 = 0.f;
      for (int i = 0; i < 32; ++i) { d1 += lp[i] * lp[32 + i]; d2 += lp[64 + i] * lp[96 + i]; }
      const float lam_init = 0.8f - 0.6f * expf(-0.3f * (float)l);
      const float lam = expf(d1) - expf(d2) + lam_init;
      float ss = 0.f;
      _Pragma("unroll") for (int a = 0; a < 2; ++a)
        _Pragma("unroll") for (int r = 0; r < 16; ++r) {
          const float o = O[a][r] * inv - lam * xb[(a * 16 + r) * 64 + lane];
          O[a][r] = o;
          ss += o * o;
        }
      ss = xhalf_sum(ss);
      const float rinv = rsqrtf(ss * (1.f / 64.f) + EPSN) * (1.f - lam_init);
      const float* gn = p.diff_gain + l * 64;
      _Pragma("unroll") for (int a = 0; a < 2; ++a)
        _Pragma("unroll") for (int i = 0; i < 4; ++i) {
          const int nl = a * 32 + 8 * i + 4 * hf;
          const int col = unit * 64 + nl;
          const uint2 gv2 = *(const uint2*)(zg + 3584 + col);
          const float4 g4 = *(const float4*)(gn + nl);
          const float y0 = O[a][4 * i + 0] * rinv * g4.x * silu_f(bflo(gv2.x));
          const float y1 = O[a][4 * i + 1] * rinv * g4.y * silu_f(bfhi(gv2.x));
          const float y2 = O[a][4 * i + 2] * rinv * g4.z * silu_f(bflo(gv2.y));
          const float y3 = O[a][4 * i + 3] * rinv * g4.w * silu_f(bfhi(gv2.y));
          *(uint2*)(((u16*)(p.ws + OFF_Y)) + tix(mq, 768 + col, 32)) = make_uint2(pack2(y0, y1), pack2(y2, y3));
        }
    }
  }
}

DI void r3_item(CPar& p, int l, int item, unsigned char* smem) {
  const int tid = otid(), lane = tid & 63, w = tid >> 6, l31 = lane & 31, hf = lane >> 5;
  bool ctx; int bb, h, c, m0;
  ret_decode(item, ctx, bb, h, c, m0);
  const int iq = w * 32 + l31;
  const int mq = m0 + iq;
  const float LOG2E = 1.4426950408889634f;
  const float lf2 = log_gamma(p, l, 0, h) * LOG2E, lb2 = log_gamma(p, l, 1, h) * LOG2E;
  u16* sK = (u16*)smem;
  u16* sV = sK + 128 * LSTR;
  constexpr int VSTR = 136;
  const u16* Vt = ctx ? ((u16*)(p.ws + OFF_VtRc)) + ((size_t)(bb * 4 + h) * 64) * 256 + c * 128 : ((u16*)(p.ws + OFF_VtRl)) + ((size_t)(bb * 4 + h) * 64) * 4096 + c * 128;
  const int ldv = ctx ? 256 : 4096;
  __syncthreads();
  _Pragma("unroll") for (int i = 0; i < 4; ++i) {
    const int cidx = tid + 256 * i;
    { const int row = cidx >> 3, kc = cidx & 7;
      *(uint4*)(sK + row * LSTR + kc * 8) = *(const uint4*)(((u16*)(p.ws + OFF_Z)) + (size_t)(m0 + row) * INW + 2048 + h * 64 + kc * 8); }
    { const int dv = cidx >> 4, kc = cidx & 15;
      *(uint4*)(sV + dv * VSTR + kc * 8) = *(const uint4*)(Vt + (size_t)dv * ldv + kc * 8); }
  }
  bf16x8 qf[4];
  {
    const u16* zq = ((u16*)(p.ws + OFF_Z)) + (size_t)mq * INW + 1792 + h * 64 + hf * 8;
    _Pragma("unroll") for (int s = 0; s < 4; ++s) qf[s] = *(const bf16x8*)(zq + s * 16);
  }
  __syncthreads();
  f32x16 O[2];
  O[0] = zero16(); O[1] = zero16();
  _Pragma("unroll 1") for (int kt = 0; kt < 2; ++kt) {
    f32x16 S[2];
    S[0] = zero16(); S[1] = zero16();
    _Pragma("unroll") for (int s = 0; s < 4; ++s)
      _Pragma("unroll") for (int k2 = 0; k2 < 2; ++k2) {
        const bf16x8 kf = *(const bf16x8*)(sK + (kt * 64 + k2 * 32 + l31) * LSTR + s * 16 + hf * 8);
        S[k2] = MFMA32(kf, qf[s], S[k2]);
      }
    bf16x8 pf[4];
    _Pragma("unroll") for (int k2 = 0; k2 < 2; ++k2) {
      _Pragma("unroll") for (int r = 0; r < 16; ++r) {
        const int jk = kt * 64 + k2 * 32 + 8 * (r >> 2) + 4 * hf + (r & 3);
        const int d = iq - jk;
        float wgt;
        if (d > 0) wgt = __builtin_amdgcn_exp2f(lf2 * (float)d);
        else if (d < 0) wgt = __builtin_amdgcn_exp2f(lb2 * (float)(-d));
        else wgt = 2.f;
        S[k2][r] *= wgt;
      }
      _Pragma("unroll") for (int u = 0; u < 2; ++u) {
        u32x4 pk;
        pk[0] = pack2(S[k2][8 * u + 0], S[k2][8 * u + 1]);
        pk[1] = pack2(S[k2][8 * u + 2], S[k2][8 * u + 3]);
        pk[2] = pack2(S[k2][8 * u + 4], S[k2][8 * u + 5]);
        pk[3] = pack2(S[k2][8 * u + 6], S[k2][8 * u + 7]);
        pf[2 * k2 + u] = __builtin_bit_cast(bf16x8, pk);
      }
    }
    _Pragma("unroll") for (int a = 0; a < 2; ++a)
      _Pragma("unroll") for (int s2 = 0; s2 < 4; ++s2) {
        const bf16x8 vf = *(const bf16x8*)(sV + (a * 32 + l31) * VSTR + kt * 64 + 16 * s2 + 8 * hf);
        O[a] = MFMA32(vf, pf[s2], O[a]);
      }
  }
  _Pragma("unroll") for (int dir = 0; dir < 2; ++dir) {
    const u16* st = ((u16*)(p.ws + OFF_SinT)) + ((size_t)item * 2 + dir) * 4096;
    const float dq = dir == 0 ? __builtin_amdgcn_exp2f(lf2 * (float)(iq + 1)) : __builtin_amdgcn_exp2f(lb2 * (float)(128 - iq));
    _Pragma("unroll") for (int a = 0; a < 2; ++a) {
      f32x16 X = zero16();
      _Pragma("unroll") for (int s = 0; s < 4; ++s) {
        const bf16x8 sf = *(const bf16x8*)(st + (a * 32 + l31) * 64 + s * 16 + hf * 8);
        X = MFMA32(sf, qf[s], X);
      }
      _Pragma("unroll") for (int r = 0; r < 16; ++r) O[a][r] += X[r] * dq;
    }
  }
  float ss = 0.f;
  _Pragma("unroll") for (int a = 0; a < 2; ++a)
    _Pragma("unroll") for (int r = 0; r < 16; ++r) ss += O[a][r] * O[a][r];
  ss = xhalf_sum(ss);
  const float rinv = rsqrtf(ss * (1.f / 64.f) + EPSN);
  const u16* zg = ((u16*)(p.ws + OFF_Z)) + (size_t)mq * INW + 2560 + h * 64;
  _Pragma("unroll") for (int a = 0; a < 2; ++a)
    _Pragma("unroll") for (int i = 0; i < 4; ++i) {
      const int nl = a * 32 + 8 * i + 4 * hf;
      const uint2 gv2 = *(const uint2*)(zg + nl);
      const float y0 = O[a][4 * i + 0] * rinv * silu_f(bflo(gv2.x));
      const float y1 = O[a][4 * i + 1] * rinv * silu_f(bfhi(gv2.x));
      const float y2 = O[a][4 * i + 2] * rinv * silu_f(bflo(gv2.y));
      const float y3 = O[a][4 * i + 3] * rinv * silu_f(bfhi(gv2.y));
      *(uint2*)(((u16*)(p.ws + OFF_Y)) + tix(mq, 512 + h * 64 + nl, 32)) = make_uint2(pack2(y0, y1), pack2(y2, y3));
    }
}

DI void phaseC(CPar& p, int l, unsigned char* smem) {
  const int lane = otid() & 63, w = otid() >> 6, wn = w >> 1, wt = w & 1, l31 = lane & 31, hf = lane >> 5;
  u16* Mg = ((u16*)(p.ws + OFF_Z));
  for (int tile = vblock(); tile < 8 * 320; tile += gridDim.x) {
    const int grp = tile / 640, rem = tile - grp * 640;
    const int tm = rem >> 1, tn = grp * 2 + (rem & 1);
    unsigned mgp[2][2][8];
    _Pragma("unroll") for (int a = 0; a < 2; ++a)
      _Pragma("unroll") for (int b = 0; b < 2; ++b)
        _Pragma("unroll") for (int r = 0; r < 8; ++r) mgp[a][b][r] = 0u;
    const u16* Ht = ((u16*)(p.ws + OFF_H)) + ((size_t)(tm * 32) << 12);
    _Pragma("unroll 1") for (int pr = 0; pr < 2; ++pr) {
      unsigned gp[2][4][8];
      {
        f32x16 acc[2][4];
        _Pragma("unroll") for (int a = 0; a < 2; ++a)
          _Pragma("unroll") for (int b = 0; b < 4; ++b) acc[a][b] = zero16();
        gemm_acc<4, true, true>(Ht, ((u16*)(p.ws + OFF_WgT)) + (size_t)l * 4096 * 1024 + ((size_t)((pr * 16 + tn) * 32) << 12), 8 * 32 * 4096, 32, acc, (u16*)smem);
        _Pragma("unroll") for (int a = 0; a < 2; ++a)
          _Pragma("unroll") for (int b = 0; b < 4; ++b)
            _Pragma("unroll") for (int r = 0; r < 8; ++r) gp[a][b][r] = pack2(sigmoid_f(acc[a][b][2 * r]), sigmoid_f(acc[a][b][2 * r + 1]));
      }
      _Pragma("unroll") for (int bh = 0; bh < 2; ++bh) {
        const int br = pr * 2 + bh;
        f32x16 acc[2][2];
        _Pragma("unroll") for (int a = 0; a < 2; ++a)
          _Pragma("unroll") for (int b = 0; b < 2; ++b) acc[a][b] = zero16();
        gemm_acc<2, false, true>(((u16*)(p.ws + OFF_Y)) + ((size_t)(tm * 32 + br * 8) << 12), ((u16*)(p.ws + OFF_WbT)) + (size_t)l * 1024 * 1024 + ((size_t)(tn * 32 + br * 8) << 12), 0, 8, acc, (u16*)smem);
        _Pragma("unroll") for (int a = 0; a < 2; ++a)
          _Pragma("unroll") for (int b = 0; b < 2; ++b)
            _Pragma("unroll") for (int r = 0; r < 8; ++r)
              mgp[a][b][r] = pack2(bflo(mgp[a][b][r]) + bflo(gp[a][bh * 2 + b][r]) * acc[a][b][2 * r], bfhi(mgp[a][b][r]) + bfhi(gp[a][bh * 2 + b][r]) * acc[a][b][2 * r + 1]);
      }
    }
    _Pragma("unroll") for (int a = 0; a < 2; ++a)
      _Pragma("unroll") for (int b = 0; b < 2; ++b) {
        const int n = tn * 128 + wt * 64 + b * 32 + l31;
        _Pragma("unroll") for (int r = 0; r < 8; ++r) {
          const int t0 = tm * 128 + wn * 64 + a * 32 + 8 * ((2 * r) >> 2) + 4 * hf + ((2 * r) & 3);
          Mg[tix(t0, n, 32)] = (u16)(mgp[a][b][r] & 0xffffu);
          Mg[tix(t0 + 1, n, 32)] = (u16)(mgp[a][b][r] >> 16);
        }
      }
  }
}

template <int TB>
DI void d_epilogue(CPar& p, int l, int tm, int nb0, f32x16 (&acc)[2][TB]) {
  const int lane = otid() & 63, w = otid() >> 6, wn = w >> 1, wt = w & 1, l31 = lane & 31, hf = lane >> 5;
  const int m0 = tm * 128 + wn * 64;
  const int j = m0 < MC ? 0 : 1 + ((m0 - MC) >> 12);
  const float* gate = ((float*)(p.ws + OFF_mod)) + (l * 9 + j) * 3072 + 2048;
  const float* xsrc = (l == 0) ? (m0 < MC ? p.x_prompt : p.x_sample - (size_t)MC * 1024) : p.out;
  _Pragma("unroll") for (int b = 0; b < TB; ++b) {
    const int n = (TB == 2) ? nb0 + wt * 64 + b * 32 + l31 : nb0 + (b >> 1) * 128 + wt * 64 + (b & 1) * 32 + l31;
    const float gv = gate[n];
    const size_t o0 = (size_t)(m0 + 4 * hf) * 1024 + n;
    const float* xp = xsrc + o0;
    float* op = p.out + o0;
    _Pragma("unroll") for (int a = 0; a < 2; ++a)
      _Pragma("unroll") for (int i = 0; i < 4; ++i) {
        float xv[4];
        _Pragma("unroll") for (int q = 0; q < 4; ++q) xv[q] = xp[q * 1024];
        _Pragma("unroll") for (int q = 0; q < 4; ++q) op[q * 1024] = xv[q] + gv * acc[a][b][4 * i + q];
        xp += 8 * 1024; op += 8 * 1024;
        asm volatile("" : "+v"(xp), "+v"(op));
      }
  }
}

DI void phaseD(CPar& p, int l, unsigned char* smem) {
  const u16* Mg = ((u16*)(p.ws + OFF_Z));
  const u16* Wo = ((u16*)(p.ws + OFF_WoT)) + (size_t)l * 1024 * 1024;
  for (int tile = vblock(); tile < 1024 + 512; tile += gridDim.x) {
    if (tile < 1024) {
      const int np = tile & 3, tm = tile >> 2;
      f32x16 acc[2][4];
      _Pragma("unroll") for (int a = 0; a < 2; ++a)
        _Pragma("unroll") for (int b = 0; b < 4; ++b) acc[a][b] = zero16();
      gemm_acc<4, true>(Mg + ((size_t)(tm * 32) << 12), Wo + ((size_t)(np * 2 * 32) << 12), 32 * 4096, 32, acc, (u16*)smem);
      d_epilogue<4>(p, l, tm, np * 256, acc);
    } else {
      const int t2 = tile - 1024, big = 1024 + (t2 >> 1), np = big & 3, tm = big >> 2, tn = np * 2 + (t2 & 1);
      f32x16 acc[2][2];
      _Pragma("unroll") for (int a = 0; a < 2; ++a)
        _Pragma("unroll") for (int b = 0; b < 2; ++b) acc[a][b] = zero16();
      gemm_acc<2>(Mg + ((size_t)(tm * 32) << 12), Wo + ((size_t)(tn * 32) << 12), 0, 32, acc, (u16*)smem);
      d_epilogue<2>(p, l, tm, tn * 128, acc);
    }
  }
}

DI void phaseFinal(CPar& p) {
  const int tid = otid(), lane = tid & 63;
  const int gw = blockIdx.x * 4 + (tid >> 6), nw = gridDim.x * 4;
  for (int row = gw; row < MT; row += nw) {
    float* xr = p.out + (size_t)row * 1024;
    float4 v[4];
    float ss = 0.f;
    _Pragma("unroll") for (int i = 0; i < 4; ++i) {
      v[i] = ((const float4*)xr)[lane + 64 * i];
      ss += v[i].x * v[i].x + v[i].y * v[i].y + v[i].z * v[i].z + v[i].w * v[i].w;
    }
    ss = wave_sum(ss);
    const float rstd = rsqrtf(ss * (1.f / 1024.f) + EPSN);
    _Pragma("unroll") for (int i = 0; i < 4; ++i) {
      const float4 g = *(const float4*)(p.final_gain + 4 * (lane + 64 * i));
      ((float4*)xr)[lane + 64 * i] = make_float4(v[i].x * rstd * g.x, v[i].y * rstd * g.y, v[i].z * rstd * g.z, v[i].w * rstd * g.w);
    }
  }
}

__global__ void __launch_bounds__(256, 2) hybrid_megakernel(Params p_unused) {
  cg::grid_group grid = cg::this_grid();
  __shared__ __attribute__((aligned(16))) unsigned char smem[SMEM_BYTES];
  __shared__ uint4 xb_words;
  if (threadIdx.x == 0) xb_words = make_uint4(0u, 0u, 0u, 0u);
  __syncthreads();
  XcdBarrier xb = xcd_barrier_post(((unsigned*)(PP().ws + OFF_bar)), (volatile LAS unsigned*)&xb_words);
  phase0(PP(), smem);
  grid.sync();
  _Pragma("unroll 1") for (int l = 0; l < 2; ++l) {
    phaseA0(PP(), l);
    xcd_barrier(xb);
    phaseA1(PP(), l, smem);
    xcd_barrier(xb);
    r1_items(PP(), l, smem);
    xcd_barrier(xb);
    for (int rep = 0; rep < REP_B2; ++rep)
    for (int it = vblock(); it < 1024 + 1024 + 2048 + 256 + 512 + 4096; it += gridDim.x) {
      if (it < 1024) r2_item<false>(PP(), l, it);
      else if (it < 2048) { const int i = it - 1024; attn_item<false>(PP(), l, false, i >> 7, (i >> 6) & 1, i & 63, smem); }
      else if (it < 4096) { const int i = it - 2048; attn_item<true>(PP(), l, false, i >> 8, (i >> 6) & 3, i & 63, smem); }
      else if (it < 4352) { const int i = it - 4096; attn_item<false>(PP(), l, true, i >> 3, (i >> 2) & 1, i & 3, smem); }
      else if (it < 4864) { const int i = it - 4352; attn_item<true>(PP(), l, true, i >> 4, (i >> 2) & 3, i & 3, smem); }
      else r2_item<true>(PP(), l, it - 4864);
    }
    {
      unsigned* ctr = (unsigned*)(PP().ws + OFF_tctr) + l;
      volatile LAS unsigned* slot = (volatile LAS unsigned*)&xb_words + 2;
      for (;;) {
        __syncthreads();
        if (threadIdx.x == 0) *slot = __hip_atomic_fetch_add(ctr, 1u, __ATOMIC_RELAXED, __HIP_MEMORY_SCOPE_AGENT);
        __syncthreads();
        const int it = (int)*slot;
        if (it >= MT * 32 / 256) break;
        conv_item(PP(), l, it);
      }
    }
    xcd_barrier(xb);
    for (int it = vblock(); it < 1280; it += gridDim.x) r3_item(PP(), l, it, smem);
    xcd_barrier(xb);
    phaseC(PP(), l, smem);
    xcd_barrier(xb);
    phaseD(PP(), l, smem);
    xcd_barrier(xb);
  }
  phaseFinal(PP());
}

extern "C" void kernel_launch(void* const* d_in, const int* in_sizes, int n_in, void* d_out, int out_size, void* d_ws, size_t ws_size,
                              hipStream_t stream) {
  static int grid_blocks = 0;
  if (!grid_blocks) {
    int dev = 0, cus = 0, per_cu = 0;
    (void)hipGetDevice(&dev);
    (void)hipDeviceGetAttribute(&cus, hipDeviceAttributeMultiprocessorCount, dev);
    (void)hipOccupancyMaxActiveBlocksPerMultiprocessor(&per_cu, hybrid_megakernel, 256, 0);
    if (per_cu > 2) per_cu = 2;
    if (per_cu < 1) per_cu = 1;
    grid_blocks = cus * per_cu;
  }
  Params p{};
  const float** fin = (const float**)&p.x_prompt;
  for (int i = 0; i < 23; ++i) fin[i] = (const float*)d_in[i];
  p.out = (float*)d_out;
  p.ws = (unsigned char*)d_ws;
  const size_t off = WS_NEED;
  if (off > ws_size) { fprintf(stderr, "workspace too small: need %zu have %zu\n", off, ws_size); return; }
  (void)hipMemsetAsync(p.ws + OFF_bar, 0, XCD_BAR_WORDS * 4, stream);
  (void)hipMemsetAsync(p.ws + OFF_tctr, 0, 256, stream);
  void* args[] = {&p};
  hipError_t e = hipLaunchCooperativeKernel((void*)hybrid_megakernel, dim3(grid_blocks), dim3(256), args, 0, stream);
  if (e != hipSuccess) fprintf(stderr, "cooperative launch failed: %s (grid %d)\n", hipGetErrorString(e), grid_blocks);
}
```
